# Optimizing an MI355X kernel written in HIP

```python
import math
import jax, jax.numpy as jnp
from jax import lax
import numpy as np

D_MODEL = 1024
BATCH = 1
SEQ = 16384
DEPTH = 2

HEAD_DIM = 64
MOBA_HEADS = 8
DSA_HEADS = 8
N_HEADS = MOBA_HEADS + DSA_HEADS
MIX_WIDTH = N_HEADS * HEAD_DIM
MOBA_WIDTH = MOBA_HEADS * HEAD_DIM
DSA_WIDTH = DSA_HEADS * HEAD_DIM
MOBA_BLOCK = 256
MOBA_TOPK = 3
IDX_HEADS = 4
IDX_DIM = 64
DSA_TOPK_MAX = 256
N_BUCKETS = 32
MAX_DISTANCE = 4096
PEER_HEADS = 8
PEER_NKEYS = 128
PEER_EXPERTS = PEER_NKEYS * PEER_NKEYS
PEER_DKEY = 256
PEER_TOPK = 16
Q_CHUNK = 128
T_CHUNK = 128
EPS = 1e-6
PROJ_SIZES = (MOBA_WIDTH, MOBA_WIDTH, MOBA_WIDTH, DSA_WIDTH, DSA_WIDTH, DSA_WIDTH,
              IDX_HEADS * IDX_DIM, IDX_DIM, IDX_HEADS)
PROJ_WIDTH = 3 * MOBA_WIDTH + 3 * DSA_WIDTH + IDX_HEADS * IDX_DIM + IDX_DIM + IDX_HEADS

kernel_name = 'hybrid_moba_dsa_peer_adaln'


def rms_norm(x, g):
    xf = x.astype(jnp.float32)
    y = xf * lax.rsqrt(jnp.mean(xf * xf, axis=-1, keepdims=True) + EPS)
    return (y * g).astype(x.dtype)


def modulate(h, shift, scale):
    return h * (1 + scale[:, None, :]) + shift[:, None, :]


def t5_bucket(dist):
    max_exact = N_BUCKETS // 2
    d = jnp.maximum(dist, 0)
    df = jnp.maximum(d, 1).astype(jnp.float32)
    large = max_exact + (jnp.log(df / max_exact) / math.log(MAX_DISTANCE / max_exact)
                         * (N_BUCKETS - max_exact)).astype(jnp.int32)
    return jnp.where(d < max_exact, d, jnp.minimum(large, N_BUCKETS - 1))


def moba_attention(q, k, v, tab):
    B, H, S, Dh = q.shape
    nb = -(-S // MOBA_BLOCK)
    pad = nb * MOBA_BLOCK - S
    kp = jnp.pad(k, ((0, 0), (0, 0), (0, pad), (0, 0))).reshape(B, H, nb, MOBA_BLOCK, Dh)
    vp = jnp.pad(v, ((0, 0), (0, 0), (0, pad), (0, 0))).reshape(B, H, nb, MOBA_BLOCK, Dh)
    k_mean = jnp.mean(kp.astype(jnp.float32), axis=3)
    n_sel = max(min(MOBA_TOPK, nb - 1), 1)
    scale = HEAD_DIM ** -0.5
    bi = jnp.arange(B)[:, None, None, None]
    hi = jnp.arange(H)[None, :, None, None]
    blk = jnp.arange(MOBA_BLOCK)

    def one_chunk(ci):
        t0 = ci * Q_CHUNK
        t = t0 + jnp.arange(Q_CHUNK)
        b0 = t0 // MOBA_BLOCK
        qc = lax.dynamic_slice_in_dim(q, t0, Q_CHUNK, axis=2)
        gate = jnp.einsum('bhqd,bhnd->bhqn', qc.astype(jnp.float32), k_mean)
        gate = jnp.where(jnp.arange(nb) < b0, gate, -jnp.inf)
        _, sel = lax.top_k(gate, n_sel)
        sel_ok = sel < b0
        kg = kp[bi, hi, sel]
        vg = vp[bi, hi, sel]
        s_sel = jnp.einsum('bhqd,bhqjkd->bhqjk', qc, kg).astype(jnp.float32) * scale
        pos_sel = sel[..., None] * MOBA_BLOCK + blk
        s_sel = s_sel + tab[hi[..., None], t5_bucket(t[:, None, None] - pos_sel)]
        s_sel = jnp.where(sel_ok[..., None], s_sel, -jnp.inf).reshape(B, H, Q_CHUNK, n_sel * MOBA_BLOCK)
        ko = lax.dynamic_index_in_dim(kp, b0, axis=2, keepdims=False)
        vo = lax.dynamic_index_in_dim(vp, b0, axis=2, keepdims=False)
        pos_own = b0 * MOBA_BLOCK + blk
        s_own = jnp.einsum('bhqd,bhkd->bhqk', qc, ko).astype(jnp.float32) * scale
        s_own = s_own + jnp.take(tab, t5_bucket(t[:, None] - pos_own[None, :]), axis=1)[None]
        s_own = jnp.where(pos_own[None, :] <= t[:, None], s_own, -jnp.inf)
        p = jax.nn.softmax(jnp.concatenate([s_sel, s_own], axis=-1), axis=-1).astype(v.dtype)
        p_sel = p[..., :n_sel * MOBA_BLOCK].reshape(B, H, Q_CHUNK, n_sel, MOBA_BLOCK)
        p_own = p[..., n_sel * MOBA_BLOCK:]
        return (jnp.einsum('bhqjk,bhqjkd->bhqd', p_sel, vg)
                + jnp.einsum('bhqk,bhkd->bhqd', p_own, vo))

    out = lax.map(one_chunk, jnp.arange(S // Q_CHUNK))
    return jnp.transpose(out, (1, 2, 0, 3, 4)).reshape(B, H, S, Dh)


def dsa_attention(q, k, v, q_idx, k_idx, w_idx, tab):
    B, S, H, Dh = q.shape
    topk = min(DSA_TOPK_MAX, S // 4)
    scale = HEAD_DIM ** -0.5
    keys = jnp.arange(S)
    bi = jnp.arange(B)[:, None, None]

    def one_chunk(ci):
        t0 = ci * Q_CHUNK
        t = t0 + jnp.arange(Q_CHUNK)
        qi = lax.dynamic_slice_in_dim(q_idx, t0, Q_CHUNK, axis=1)
        wi = lax.dynamic_slice_in_dim(w_idx, t0, Q_CHUNK, axis=1)
        qc = lax.dynamic_slice_in_dim(q, t0, Q_CHUNK, axis=1)
        rel = jax.nn.relu(jnp.einsum('bqhd,bsd->bqhs', qi, k_idx).astype(jnp.float32))
        score = jnp.einsum('bqh,bqhs->bqs', wi.astype(jnp.float32), rel)
        score = jnp.where(keys[None, None, :] <= t[None, :, None], score, -jnp.inf)
        _, idx = lax.top_k(score, topk)
        kg = k[bi, idx]
        vg = v[bi, idx]
        s = jnp.einsum('bqhd,bqkhd->bhqk', qc, kg).astype(jnp.float32) * scale
        bias = jnp.moveaxis(jnp.take(tab, t5_bucket(t[None, :, None] - idx), axis=1), 0, 1)
        s = jnp.where((idx <= t[None, :, None])[:, None], s + bias, -jnp.inf)
        p = jax.nn.softmax(s, axis=-1).astype(v.dtype)
        return jnp.einsum('bhqk,bqkhd->bqhd', p, vg)

    out = lax.map(one_chunk, jnp.arange(S // Q_CHUNK))
    return jnp.transpose(out, (1, 0, 2, 3, 4)).reshape(B, S, H * Dh)


def hybrid_mixer(h, w_in, w_out, rel_bias):
    B, S, _ = h.shape
    proj = h @ w_in
    parts = []
    off = 0
    for size in PROJ_SIZES:
        parts.append(proj[..., off:off + size])
        off += size
    mq, mk, mv, dq, dk, dv, iq, ik, iw = parts
    to_bhsd = lambda t, nh: jnp.transpose(t.reshape(B, S, nh, HEAD_DIM), (0, 2, 1, 3))
    to_bshd = lambda t, nh: t.reshape(B, S, nh, HEAD_DIM)
    y_moba = moba_attention(to_bhsd(mq, MOBA_HEADS), to_bhsd(mk, MOBA_HEADS),
                            to_bhsd(mv, MOBA_HEADS), rel_bias[:MOBA_HEADS])
    y_moba = jnp.transpose(y_moba, (0, 2, 1, 3)).reshape(B, S, MOBA_WIDTH)
    ikf = ik.astype(jnp.float32)
    ik_n = (ikf * lax.rsqrt(jnp.mean(ikf * ikf, axis=-1, keepdims=True) + EPS)).astype(ik.dtype)
    y_dsa = dsa_attention(to_bshd(dq, DSA_HEADS), to_bshd(dk, DSA_HEADS), to_bshd(dv, DSA_HEADS),
                          iq.reshape(B, S, IDX_HEADS, IDX_DIM), ik_n, iw * IDX_HEADS ** -0.5,
                          rel_bias[MOBA_HEADS:])
    y = jnp.concatenate([y_moba, y_dsa], axis=-1)
    return y @ w_out


def peer_ffn(h, w_query, sub_keys, u_emb, v_emb):
    B, S, D = h.shape

    def one_chunk(ci):
        hc = lax.dynamic_slice_in_dim(h, ci * T_CHUNK, T_CHUNK, axis=1)
        q = (hc @ w_query).reshape(B, T_CHUNK, PEER_HEADS, 2, PEER_DKEY // 2)
        s = jnp.einsum('bthpd,hpnd->bthpn', q, sub_keys).astype(jnp.float32)
        s_top, i_top = lax.top_k(s, PEER_TOPK)
        cand = (s_top[..., 0, :, None] + s_top[..., 1, None, :]).reshape(B, T_CHUNK, PEER_HEADS, PEER_TOPK * PEER_TOPK)
        cand_idx = (i_top[..., 0, :, None] * PEER_NKEYS + i_top[..., 1, None, :]).reshape(cand.shape)
        g_s, pos = lax.top_k(cand, PEER_TOPK)
        e_idx = jnp.take_along_axis(cand_idx, pos, axis=-1)
        g = jax.nn.softmax(g_s, axis=-1)
        u = u_emb[e_idx]
        act = jax.nn.gelu(jnp.einsum('btd,bthkd->bthk', hc, u).astype(jnp.float32), approximate=False)
        return jnp.einsum('bthk,bthkd->btd', (g * act).astype(h.dtype), v_emb[e_idx])

    out = lax.map(one_chunk, jnp.arange(S // T_CHUNK))
    return jnp.transpose(out, (1, 0, 2, 3)).reshape(B, S, D)


def setup_inputs(seed: int = 0) -> dict:
    key = jax.random.key(seed)
    ks = jax.random.split(key, 14)
    f32 = jnp.float32
    nrm = lambda k, shape, s: jax.random.normal(k, shape, f32) * s
    return {
        'x': nrm(ks[0], (BATCH, SEQ, D_MODEL), 1.0),
        'c': nrm(ks[1], (BATCH, D_MODEL), 1.0),
        'w_ada': nrm(ks[2], (DEPTH, D_MODEL, 6 * D_MODEL), 0.5 * D_MODEL ** -0.5),
        'b_ada': nrm(ks[3], (DEPTH, 6 * D_MODEL), 0.02),
        'norm_attn': 1.0 + nrm(ks[4], (DEPTH, D_MODEL), 0.02),
        'norm_ffn': 1.0 + nrm(ks[5], (DEPTH, D_MODEL), 0.02),
        'w_in': nrm(ks[6], (DEPTH, D_MODEL, PROJ_WIDTH), D_MODEL ** -0.5),
        'w_out': nrm(ks[7], (DEPTH, MIX_WIDTH, D_MODEL), MIX_WIDTH ** -0.5),
        'rel_bias': nrm(ks[8], (N_HEADS, N_BUCKETS), 0.5),
        'peer_wq': nrm(ks[9], (DEPTH, D_MODEL, PEER_HEADS * PEER_DKEY), D_MODEL ** -0.5),
        'peer_subkeys': nrm(ks[10], (DEPTH, PEER_HEADS, 2, PEER_NKEYS, PEER_DKEY // 2), (PEER_DKEY // 2) ** -0.5),
        'peer_u': nrm(ks[11], (DEPTH, PEER_EXPERTS, D_MODEL), D_MODEL ** -0.5),
        'peer_v': nrm(ks[12], (DEPTH, PEER_EXPERTS, D_MODEL), PEER_HEADS ** -0.5),
        'norm_final': 1.0 + nrm(ks[13], (D_MODEL,), 0.02),
    }


def reference(x, c, w_ada, b_ada, norm_attn, norm_ffn, w_in, w_out, rel_bias,
              peer_wq, peer_subkeys, peer_u, peer_v, norm_final):
    mod = jnp.einsum('bd,lde->lbe', jax.nn.silu(c), w_ada) + b_ada[:, None, :]
    for l in range(DEPTH):
        sh1, sc1, g1, sh2, sc2, g2 = jnp.split(mod[l], 6, axis=-1)
        h = modulate(rms_norm(x, norm_attn[l]), sh1, sc1)
        x = x + g1[:, None, :] * hybrid_mixer(h, w_in[l], w_out[l], rel_bias)
        h = modulate(rms_norm(x, norm_ffn[l]), sh2, sc2)
        x = x + g2[:, None, :] * peer_ffn(h, peer_wq[l], peer_subkeys[l], peer_u[l], peer_v[l])
    return rms_norm(x, norm_final)
```

```cpp
#include <hip/hip_runtime.h>
#include <cstdio>
#include <cstdint>

#ifndef DIAG
#define DIAG 0
#endif
#ifdef ONLY_PHASE
#define PH_ON(ph) ((ph) == ONLY_PHASE)
#else
#define PH_ON(ph) true
#endif
#ifndef ONE_LAUNCH
#define ONE_LAUNCH 1
#endif
#ifndef REP_WHAT
#define REP_WHAT 0
#endif
#ifndef FORCE_FAIL
#define FORCE_FAIL 0
#endif
#define REP(k, ...) do { int _nrep = (REP_WHAT == (k)) ? 2 : 1; if (REP_WHAT) asm volatile("" : "+s"(_nrep)); for (int _r = 0; _r < _nrep; ++_r) { __VA_ARGS__; } } while (0)

#define LAS __attribute__((address_space(3)))
typedef _Float16 f16;
typedef _Float16 h8 __attribute__((ext_vector_type(8)));
typedef _Float16 h4 __attribute__((ext_vector_type(4)));
typedef _Float16 h2 __attribute__((ext_vector_type(2)));
typedef float f32x2 __attribute__((ext_vector_type(2)));
typedef float f32x4 __attribute__((ext_vector_type(4)));
typedef float f32x16 __attribute__((ext_vector_type(16)));
typedef unsigned short u16;
typedef unsigned u32x2 __attribute__((ext_vector_type(2)));
typedef unsigned u32x4 __attribute__((ext_vector_type(4)));

constexpr int S = 16384, D = 1024, NPROJ = 3396, NPAD = 3584, NQ = 2048;
constexpr int NTHREADS = 512, NWAVES = 8;
constexpr int LDS_BYTES = 147456;
constexpr float EPS = 1e-6f;
constexpr float DSA_KV_SCALE = 4.0f;
#ifndef DSA_SWEEP
#define DSA_SWEEP 1
#endif
constexpr float PEER_U_SCALE = 64.0f, PEER_V_SCALE = 8.0f;
constexpr size_t MBy = 1ull << 20;
constexpr size_t WS_CTL = 0, WS_LCNT = 16384, WS_MODP = 65536, WS_MOD = 458752, WS_KMEAN = 524288, WS_SEL = 1 * MBy, WS_IW = 2 * MBy, WS_NIDX = 3 * MBy,
    WS_WIN = 4 * MBy, WS_WOUT = 18 * MBy, WS_WQ = 22 * MBy, WS_SUBK = 30 * MBy, WS_U16 = 32 * MBy, WS_V16 = 96 * MBy, WS_H = 160 * MBy, WS_X1 = 192 * MBy,
    WS_QKV = 256 * MBy, WS_IQ = 352 * MBy, WS_IKRAW = 360 * MBy, WS_KN = 364 * MBy, WS_IDX = 366 * MBy, WS_LIST = 374 * MBy, WS_Y = 390 * MBy,
    WS_PQ = 422 * MBy, WS_EIDX = 486 * MBy, WS_EG = 494 * MBy, WS_END = 502 * MBy;
constexpr size_t CTL_ZERO_BYTES = 65536;

struct Params {
    const float* x; const float* c; const float* w_ada; const float* b_ada; const float* norm_attn; const float* norm_ffn; const float* w_in; const float* w_out;
    const float* rel_bias; const float* peer_wq; const float* peer_subkeys; const float* peer_u; const float* peer_v; const float* norm_final;
    float* out; unsigned char* ws; int ph_lo, ph_hi;
};

#define XB_TMO      128
#define XB_XCNT(j)  (256  + 64 * (j))
#define XB_XSUB(j)  (1280 + 64 * (j))
#define XB_XGEN(j)  (2304 + 64 * (j))
#define XB_TOP      3328
#define XB_TOPGEN   3392
#define XCD_BAR_WORDS 3456
#define XB_SPIN_CAP (1u << 25)
__device__ __forceinline__ unsigned xb_ld(unsigned* p)              { return __hip_atomic_load(p, __ATOMIC_RELAXED, __HIP_MEMORY_SCOPE_AGENT); }
__device__ __forceinline__ unsigned xb_add(unsigned* p, unsigned v) { return __hip_atomic_fetch_add(p, v, __ATOMIC_RELAXED, __HIP_MEMORY_SCOPE_AGENT); }
__device__ __forceinline__ unsigned xb_xcc_id() { return (unsigned)__builtin_amdgcn_s_getreg((3 << 11) | 20) & 0xFu; }
#define XB_SPIN(cond, bar) do { unsigned _sp = 0; while (cond) { __builtin_amdgcn_s_sleep(1); \
    if ((++_sp & 255u) == 0u) { if (xb_ld(&(bar)[XB_TMO])) break; if (_sp > XB_SPIN_CAP) { atomicAdd(&(bar)[XB_TMO], 1u); break; } } } } while (0)
struct XcdBarrier { unsigned* bar; unsigned x; volatile LAS unsigned* st; };
__device__ __forceinline__ XcdBarrier xcd_barrier_post(unsigned* bar, volatile LAS unsigned* st) {
    XcdBarrier b; b.bar = bar; b.x = xb_xcc_id(); b.st = st;
    if (threadIdx.x == 0) (void)xb_add(&bar[XB_XCNT(b.x)], 1u);
    return b;
}
__device__ __forceinline__ void xcd_barrier_complete(unsigned* bar, unsigned x, unsigned& nloc, unsigned& nx) {
    const unsigned G = gridDim.x * gridDim.y * gridDim.z;
    unsigned sum, cnt, mine, sp = 0u;
    for (;;) {
        sum = 0u; cnt = 0u; mine = 0u;
#pragma unroll
        for (unsigned j = 0; j < 16; ++j) { const unsigned c = xb_ld(&bar[XB_XCNT(j)]); sum += c; cnt += (c > 0u) ? 1u : 0u; mine = (j == x) ? c : mine; }
        if (sum == G) break;
        __builtin_amdgcn_s_sleep(1);
        if ((++sp & 255u) == 0u) { if (xb_ld(&bar[XB_TMO])) break; if (sp > XB_SPIN_CAP) { atomicAdd(&bar[XB_TMO], 1u); break; } }
    }
    nloc = mine > 0u ? mine : 1u; nx = cnt > 0u ? cnt : 1u;
}
__device__ __forceinline__ void xcd_barrier(const XcdBarrier& b) {
    asm volatile("s_waitcnt vmcnt(0)" ::: "memory");
    __syncthreads();
    if (threadIdx.x == 0) {
        unsigned* bar = b.bar;
        __builtin_amdgcn_s_waitcnt(0);
        unsigned nloc = b.st[0], nx = b.st[1];
        if (nloc == 0u) { xcd_barrier_complete(bar, b.x, nloc, nx); b.st[0] = nloc; b.st[1] = nx; }
        const unsigned old = xb_add(&bar[XB_XSUB(b.x)], 1u);
        const unsigned gen = old / nloc;
        if (old + 1u == (gen + 1u) * nloc) {
            __builtin_amdgcn_fence(__ATOMIC_RELEASE, "agent");
            asm volatile("s_waitcnt vmcnt(0)" ::: "memory");
            const unsigned og = xb_add(&bar[XB_TOP], 1u);
            const unsigned tg = og / nx;
            if (og + 1u == (tg + 1u) * nx) xb_add(&bar[XB_TOPGEN], 1u);
            else XB_SPIN(xb_ld(&bar[XB_TOPGEN]) == tg, bar);
            __builtin_amdgcn_fence(__ATOMIC_ACQUIRE, "agent");
            xb_add(&bar[XB_XGEN(b.x)], 1u);
            asm volatile("s_waitcnt vmcnt(0)" ::: "memory");
        } else {
            XB_SPIN(xb_ld(&bar[XB_XGEN(b.x)]) == gen, bar);
            __builtin_amdgcn_fence(__ATOMIC_ACQUIRE, "agent");
            asm volatile("s_waitcnt vmcnt(0)" ::: "memory");
        }
    }
    __syncthreads();
}

#define LAUNDER_S(x) asm volatile("" : "+s"(x) :: "memory")
#define LAUNDER_V(x) asm volatile("" : "+v"(x) :: "memory")
#define LAUNDER_P(ptr) do { int _z = 0; LAUNDER_S(_z); ptr = (decltype(ptr))((const char*)(ptr) + _z); } while (0)
__device__ __forceinline__ Params load_params() {
#if defined(__HIP_DEVICE_COMPILE__)
    int z = 0; LAUNDER_S(z);
    const Params* kp = (const Params*)((const char*)(const void*)__builtin_amdgcn_kernarg_segment_ptr() + z);
    return *kp;
#else
    return Params{};
#endif
}
__device__ __forceinline__ int phase_tid() { int t = threadIdx.x; LAUNDER_V(t); return t; }
__device__ __forceinline__ unsigned char* phase_ws(const unsigned char* w) { int z = 0; LAUNDER_S(z); return (unsigned char*)w + z; }
__device__ __forceinline__ float wave_sum(float v) {
#pragma unroll
    for (int o = 32; o >= 1; o >>= 1) v += __shfl_xor(v, o);
    return v;
}
__device__ __forceinline__ int t5_bucket(int d) {
    const float x = (float)d * 0.0625f;
    int k = (int)(2.0f * __log2f(x) + 1e-4f);
    k = k > 15 ? 15 : k;
    return d < 16 ? d : 16 + k;
}
__device__ __forceinline__ unsigned f2ord(float f) { const unsigned u = __float_as_uint(f); return (u & 0x80000000u) ? ~u : (u | 0x80000000u); }
__device__ __forceinline__ float ord2f(unsigned k) { const unsigned u = (k & 0x80000000u) ? (k & 0x7FFFFFFFu) : ~k; return __uint_as_float(u); }
__device__ __forceinline__ float dot8(h8 a, h8 b, float acc) {
    acc = __builtin_amdgcn_fdot2((h2){a[0], a[1]}, (h2){b[0], b[1]}, acc, false);
    acc = __builtin_amdgcn_fdot2((h2){a[2], a[3]}, (h2){b[2], b[3]}, acc, false);
    acc = __builtin_amdgcn_fdot2((h2){a[4], a[5]}, (h2){b[4], b[5]}, acc, false);
    acc = __builtin_amdgcn_fdot2((h2){a[6], a[7]}, (h2){b[6], b[7]}, acc, false);
    return acc;
}
__device__ __forceinline__ unsigned pack_fp8x4(float a, float b, float c, float d) {
    int w = __builtin_amdgcn_cvt_pk_fp8_f32(a, b, 0, false);
    w = __builtin_amdgcn_cvt_pk_fp8_f32(c, d, w, true);
    return (unsigned)w;
}
#ifndef CHECKS
#define CHECKS 0
#endif
constexpr size_t WS_FLAG = 32768;
__device__ __forceinline__ float wave_max(float v) {
#pragma unroll
    for (int o = 32; o >= 1; o >>= 1) v = fmaxf(v, __shfl_xor(v, o));
    return v;
}
__device__ __forceinline__ float wave_min(float v) {
#pragma unroll
    for (int o = 32; o >= 1; o >>= 1) v = fminf(v, __shfl_xor(v, o));
    return v;
}
__device__ __forceinline__ int wave_sumi(int v) {
#pragma unroll
    for (int o = 32; o >= 1; o >>= 1) v += __shfl_xor(v, o);
    return v;
}
__device__ __forceinline__ void set_flag(unsigned char* ws, unsigned bit) { atomicOr((unsigned*)(ws + WS_FLAG), bit); }
template <int CTRL> __device__ __forceinline__ float dpp_f(float v) { return __int_as_float(__builtin_amdgcn_update_dpp(0, __float_as_int(v), CTRL, 0xF, 0xF, false)); }
__device__ __forceinline__ float relu_i(float x) { const int b = __float_as_int(x); return __int_as_float(b > 0 ? b : 0); }
__device__ __forceinline__ float gelu_exact(float v) { return 0.5f * v * (1.0f + erff(v * 0.70710678118654752f)); }

namespace pg8 {
constexpr int BM = 256, BK = 64, HALF = 128, HTB = HALF * BK * 2, STAGE_BYTES = 8 * HTB, NXCD = 8, WGM = 8;
__host__ __device__ __forceinline__ int lds_byte(int r, int c) { const int st = (r >> 4) * 2 + (c >> 5), rr = r & 15, cc = c & 31, ob = rr * 64 + cc * 2; return st * 1024 + (ob ^ (((ob >> 9) & 1) << 5)); }
__host__ __device__ __forceinline__ void stage_rc(int b, int& R, int& C) { const int st = b / 1024, sb = b % 1024, swz = sb ^ (((sb >> 9) & 1) << 5); R = (st >> 1) * 16 + swz / 64; C = (st & 1) * 32 + (swz % 64) / 2; }
__host__ __device__ __forceinline__ int perm32(int rho) { const int n = rho >> 4, i = rho & 15; return 8 * (i >> 2) + 4 * n + (i & 3); }
struct Unit { int pm, pn; };
struct Gemm { const f16* A; const f16* Bt; int M, N, K; };
struct StaticOrder {
    int nM, nN, nwg, G, c;
    __device__ void init(int M, int N, int G_, int c_) { nM = M / BM; nN = N / BM; nwg = nM * nN; G = G_; c = c_; }
    __device__ bool next(int i, Unit& u) const {
        const long L = (long)i * G + c; if (L >= nwg) return false;
        int wgid = (int)L; { const int q = nwg / NXCD, r = nwg % NXCD, xcd = wgid % NXCD, off = wgid / NXCD; wgid = (xcd < r ? xcd * (q + 1) : r * (q + 1) + (xcd - r) * q) + off; }
        const int nig = WGM * nN, gid = wgid / nig, fm = gid * WGM, gsz = (nM - fm) < WGM ? (nM - fm) : WGM;
        u.pm = fm + ((wgid % nig) % gsz); u.pn = (wgid % nig) / gsz; return true;
    }
};

template <class Epi>
__device__ __forceinline__ void gemm_phase(LAS unsigned char* lds, const Gemm g, const StaticOrder& S_, const Epi& E) {
    const int tid = phase_tid(), wid = __builtin_amdgcn_readfirstlane(tid >> 6), lane = tid & 63, wr = wid >> 2, wc = wid & 3, fr = lane & 15, fq = lane >> 4;
    const int K = g.K, nt = K / BK;
    unsigned voffA[2], voffB[2];
#pragma unroll
    for (int i = 0; i < 2; ++i) { int R, C; stage_rc(tid * 16 + i * 8192, R, C); const int Rb = Epi::PERM ? ((R & ~31) + perm32(R & 31)) : R;
        voffA[i] = (unsigned)(R * K + C) * 2u; voffB[i] = (unsigned)(Rb * K + C) * 2u; }
    const size_t kstep = (size_t)(BK * 2);
    const size_t hstep = (size_t)HALF * K * 2;
    const size_t tstep = 2 * hstep;
    const unsigned ldsw = (unsigned)wid * 1024u;
    const int aoff = lds_byte(wr * 64 + fr, fq * 8), boff = lds_byte(wc * 32 + fr, fq * 8);
#define PG8_SA(b, h) (((b) * 2 + (h)) * HTB)
#define PG8_SB(b, h) ((4 + (b) * 2 + (h)) * HTB)
#define PG8_STAGE(bufoff, gbase, voff) do { _Pragma("unroll") for (int _i = 0; _i < 2; ++_i) \
        __builtin_amdgcn_global_load_lds((const unsigned*)((const char*)(gbase) + (voff)[_i]), (LAS unsigned*)(lds + (bufoff) + ldsw + _i * 8192), 16, 0, 0); } while (0)
#define PG8_LDA(dst, b, h) do { _Pragma("unroll") for (int m = 0; m < 4; ++m) _Pragma("unroll") for (int k = 0; k < 2; ++k) dst[m][k] = *(const LAS h8*)(lds + PG8_SA(b, h) + aoff + m * 2048 + k * 1024); } while (0)
#define PG8_LDB(dst, b, h) do { _Pragma("unroll") for (int n = 0; n < 2; ++n) _Pragma("unroll") for (int k = 0; k < 2; ++k) dst[n][k] = *(const LAS h8*)(lds + PG8_SB(b, h) + boff + n * 2048 + k * 1024); } while (0)
#define PG8_MMA(ai, bj, At, Bt) do { __builtin_amdgcn_s_setprio(1); _Pragma("unroll") for (int m = 0; m < 4; ++m) _Pragma("unroll") for (int n = 0; n < 2; ++n) _Pragma("unroll") for (int k = 0; k < 2; ++k) \
        acc[ai][bj][m][n] = __builtin_amdgcn_mfma_f32_16x16x32_f16(Bt[n][k], At[m][k], acc[ai][bj][m][n], 0, 0, 0); __builtin_amdgcn_s_setprio(0); } while (0)
#define PG8_WAIT_V(n) asm volatile("s_waitcnt vmcnt(" #n ")" ::: "memory")
#define PG8_WAIT_L(n) asm volatile("s_waitcnt lgkmcnt(" #n ")" ::: "memory")
#define PG8_BAR __builtin_amdgcn_s_barrier()
#define PG8_SCHED __builtin_amdgcn_sched_barrier(0)
    Unit cur, nxt; int ui = 0;
    if (!S_.next(0, cur)) return;
    f32x4 acc[2][2][4][2];
#pragma unroll
    for (int a = 0; a < 2; ++a)
#pragma unroll
        for (int b = 0; b < 2; ++b)
#pragma unroll
            for (int m = 0; m < 4; ++m)
#pragma unroll
                for (int n = 0; n < 2; ++n) acc[a][b][m][n] = (f32x4){0.f, 0.f, 0.f, 0.f};
    h8 At[4][2], B0[2][2], B1[2][2];
    const char* cA = (const char*)g.A + (size_t)cur.pm * tstep; const char* cB = (const char*)g.Bt + (size_t)cur.pn * tstep;
    PG8_STAGE(PG8_SB(0, 0), cB, voffB); PG8_STAGE(PG8_SA(0, 0), cA, voffA); PG8_STAGE(PG8_SB(0, 1), cB + hstep, voffB); PG8_STAGE(PG8_SA(0, 1), cA + hstep, voffA);
    if (wr == 1) PG8_BAR;
    PG8_WAIT_V(4); PG8_BAR;
    PG8_STAGE(PG8_SB(1, 0), cB + kstep, voffB); PG8_STAGE(PG8_SA(1, 0), cA + kstep, voffA); PG8_STAGE(PG8_SB(1, 1), cB + hstep + kstep, voffB);
    PG8_WAIT_V(6); PG8_BAR;
    for (;;) {
        const bool has_next = S_.next(ui + 1, nxt);
        const char* nA = has_next ? (const char*)g.A + (size_t)nxt.pm * tstep : cA; const char* nB = has_next ? (const char*)g.Bt + (size_t)nxt.pn * tstep : cB;
        for (int t = 0; t < nt; t += 2) {
            const bool last = (t == nt - 2);
            const char* a1 = cA + (size_t)(t + 1) * kstep;
            const char* a2 = last ? nA : cA + (size_t)(t + 2) * kstep; const char* b2 = last ? nB : cB + (size_t)(t + 2) * kstep;
            const char* a3 = a2 + kstep; const char* b3 = b2 + kstep;
            PG8_LDB(B0, 0, 0); PG8_SCHED; PG8_LDA(At, 0, 0); PG8_STAGE(PG8_SA(1, 1), a1 + hstep, voffA);
            PG8_WAIT_L(8); PG8_BAR; PG8_WAIT_L(0); PG8_MMA(0, 0, At, B0); PG8_BAR; PG8_SCHED;
            PG8_LDB(B1, 0, 1); PG8_STAGE(PG8_SB(0, 0), b2, voffB);
            PG8_BAR; PG8_WAIT_L(0); PG8_MMA(0, 1, At, B1); PG8_BAR;
            PG8_LDA(At, 0, 1); PG8_STAGE(PG8_SA(0, 0), a2, voffA);
            PG8_BAR; PG8_WAIT_L(0); PG8_MMA(1, 0, At, B0); PG8_BAR; PG8_SCHED;
            PG8_STAGE(PG8_SB(0, 1), b2 + hstep, voffB);
            PG8_WAIT_V(6); PG8_BAR; PG8_MMA(1, 1, At, B1); PG8_BAR;
            PG8_LDB(B0, 1, 0); PG8_SCHED; PG8_LDA(At, 1, 0); PG8_STAGE(PG8_SA(0, 1), a2 + hstep, voffA);
            PG8_WAIT_L(8); PG8_BAR; PG8_WAIT_L(0); PG8_MMA(0, 0, At, B0); PG8_BAR; PG8_SCHED;
            PG8_LDB(B1, 1, 1); PG8_STAGE(PG8_SB(1, 0), b3, voffB);
            PG8_BAR; PG8_WAIT_L(0); PG8_MMA(0, 1, At, B1); PG8_BAR;
            PG8_LDA(At, 1, 1); PG8_STAGE(PG8_SA(1, 0), a3, voffA);
            PG8_BAR; PG8_WAIT_L(0); PG8_MMA(1, 0, At, B0); PG8_BAR; PG8_SCHED;
            PG8_STAGE(PG8_SB(1, 1), b3 + hstep, voffB);
            PG8_WAIT_V(6); PG8_BAR; PG8_MMA(1, 1, At, B1); PG8_BAR;
        }
        E(acc, cur, wr, wc, fr, fq);
        if (!has_next) break;
#pragma unroll
        for (int a = 0; a < 2; ++a)
#pragma unroll
            for (int b = 0; b < 2; ++b)
#pragma unroll
                for (int m = 0; m < 4; ++m)
#pragma unroll
                    for (int n = 0; n < 2; ++n) acc[a][b][m][n] = (f32x4){0.f, 0.f, 0.f, 0.f};
        cur = nxt; cA = nA; cB = nB; ++ui;
    }
    PG8_WAIT_V(0);
    if (wr == 0) PG8_BAR;
    PG8_BAR;
#undef PG8_SA
#undef PG8_SB
#undef PG8_STAGE
#undef PG8_LDA
#undef PG8_LDB
#undef PG8_MMA
#undef PG8_WAIT_V
#undef PG8_WAIT_L
#undef PG8_BAR
#undef PG8_SCHED
}
}

struct EpiIn {
    static constexpr bool PERM = true;
    f16* QKV; f16* IQ; float* IKRAW; float* IW;
    __device__ __forceinline__ void operator()(const f32x4 (&acc)[2][2][4][2], const pg8::Unit& u, int wr, int wc, int fr, int fq) const {
#pragma unroll
        for (int bj = 0; bj < 2; ++bj) {
            const int cb = u.pn * 256 + bj * 128 + wc * 32;
            if (cb >= NPROJ) continue;
            const int c0 = cb + 8 * fq;
#pragma unroll
            for (int ai = 0; ai < 2; ++ai)
#pragma unroll
                for (int m = 0; m < 4; ++m) {
                    const int r = u.pm * 256 + ai * 128 + wr * 64 + m * 16 + fr;
                    const f32x4 v0 = acc[ai][bj][m][0], v1 = acc[ai][bj][m][1];
                    if (cb < 3072) {
                        const int g = cb >> 9, hh = (cb & 511) >> 6, d = (c0 & 63);
                        if (g >= 4) {
                            unsigned char* dst = (unsigned char*)(QKV + (size_t)4 * 8 * S * 64) + ((size_t)hh * S + r) * 128 + (g - 4) * 64 + d;
                            u32x2 o; o[0] = pack_fp8x4(v0[0] * DSA_KV_SCALE, v0[1] * DSA_KV_SCALE, v0[2] * DSA_KV_SCALE, v0[3] * DSA_KV_SCALE);
                            o[1] = pack_fp8x4(v1[0] * DSA_KV_SCALE, v1[1] * DSA_KV_SCALE, v1[2] * DSA_KV_SCALE, v1[3] * DSA_KV_SCALE);
                            *(u32x2*)dst = o;
                        } else if (g != 2) {
                            h8 o; o[0] = (f16)v0[0]; o[1] = (f16)v0[1]; o[2] = (f16)v0[2]; o[3] = (f16)v0[3]; o[4] = (f16)v1[0]; o[5] = (f16)v1[1]; o[6] = (f16)v1[2]; o[7] = (f16)v1[3];
                            *(h8*)(QKV + ((size_t)(g * 8 + hh) * S + r) * 64 + d) = o;
                        } else {
                            f16* base = QKV + ((size_t)(2 * 8 + hh) * 64 + d) * S + r;
#pragma unroll
                            for (int i = 0; i < 4; ++i) { base[(size_t)i * S] = (f16)v0[i]; base[(size_t)(i + 4) * S] = (f16)v1[i]; }
                        }
                    } else if (cb < 3328) {
                        h8 o; o[0] = (f16)v0[0]; o[1] = (f16)v0[1]; o[2] = (f16)v0[2]; o[3] = (f16)v0[3]; o[4] = (f16)v1[0]; o[5] = (f16)v1[1]; o[6] = (f16)v1[2]; o[7] = (f16)v1[3];
                        *(h8*)(IQ + (size_t)r * 256 + (c0 - 3072)) = o;
                    } else if (cb < 3392) {
                        float* dst = IKRAW + (size_t)r * 64 + (c0 - 3328);
                        *(f32x4*)dst = v0; *(f32x4*)(dst + 4) = v1;
                    } else {
                        if (fq == 0) *(f32x4*)(IW + (size_t)r * 4) = v0 * 0.5f;
                    }
                }
        }
    }
};
struct EpiOut {
    static constexpr bool PERM = false;
    const float* Xin; float* X1; const float* g1;
    __device__ __forceinline__ void operator()(const f32x4 (&acc)[2][2][4][2], const pg8::Unit& u, int wr, int wc, int fr, int fq) const {
#pragma unroll
        for (int bj = 0; bj < 2; ++bj)
#pragma unroll
            for (int n = 0; n < 2; ++n) {
                const int c = u.pn * 256 + bj * 128 + wc * 32 + 16 * n + 4 * fq;
                const f32x4 gv = *(const f32x4*)(g1 + c);
#pragma unroll
                for (int ai = 0; ai < 2; ++ai)
#pragma unroll
                    for (int m = 0; m < 4; ++m) {
                        const int r = u.pm * 256 + ai * 128 + wr * 64 + m * 16 + fr;
                        const f32x4 xv = *(const f32x4*)(Xin + (size_t)r * D + c);
                        *(f32x4*)(X1 + (size_t)r * D + c) = (DIAG == 1) ? xv : (xv + gv * acc[ai][bj][m][n]);
                    }
            }
    }
};
struct EpiPQ {
    static constexpr bool PERM = true;
    f16* PQ;
    __device__ __forceinline__ void operator()(const f32x4 (&acc)[2][2][4][2], const pg8::Unit& u, int wr, int wc, int fr, int fq) const {
#pragma unroll
        for (int bj = 0; bj < 2; ++bj) {
            const int c0 = u.pn * 256 + bj * 128 + wc * 32 + 8 * fq;
#pragma unroll
            for (int ai = 0; ai < 2; ++ai)
#pragma unroll
                for (int m = 0; m < 4; ++m) {
                    const int r = u.pm * 256 + ai * 128 + wr * 64 + m * 16 + fr;
                    const f32x4 v0 = acc[ai][bj][m][0], v1 = acc[ai][bj][m][1];
                    h8 o; o[0] = (f16)v0[0]; o[1] = (f16)v0[1]; o[2] = (f16)v0[2]; o[3] = (f16)v0[3]; o[4] = (f16)v1[0]; o[5] = (f16)v1[1]; o[6] = (f16)v1[2]; o[7] = (f16)v1[3];
                    *(h8*)(PQ + (size_t)r * NQ + c0) = o;
                }
        }
    }
};

__device__ __forceinline__ void transpose_tile(const float* __restrict__ src, int K, int N, f16* __restrict__ dst, int k0, int n0, LAS f16* tile) {
    const int tid = phase_tid();
    { const int kk = tid >> 4, n4 = (tid & 15) * 4;
#pragma unroll
      for (int p = 0; p < 2; ++p) { const int k = k0 + kk + 32 * p, n = n0 + n4;
          f32x4 v = (f32x4){0.f, 0.f, 0.f, 0.f}; if (n < N) v = *(const f32x4*)(src + (size_t)k * N + n);
#pragma unroll
          for (int i = 0; i < 4; ++i) tile[(n4 + i) * 72 + kk + 32 * p] = (f16)v[i]; } }
    __syncthreads();
    { const int nn = tid >> 3, k8 = (tid & 7) * 8;
      const h8 v = *(const LAS h8*)(tile + nn * 72 + k8);
      *(h8*)(dst + (size_t)(n0 + nn) * K + k0 + k8) = v; }
    __syncthreads();
}
__device__ __forceinline__ void convert_chunk(const float* __restrict__ src, f16* __restrict__ dst, size_t base, int ptid) {
    const size_t o = base + (size_t)ptid * 8;
    const f32x4 a = *(const f32x4*)(src + o), b = *(const f32x4*)(src + o + 4);
    h8 v; v[0] = (f16)a[0]; v[1] = (f16)a[1]; v[2] = (f16)a[2]; v[3] = (f16)a[3]; v[4] = (f16)b[0]; v[5] = (f16)b[1]; v[6] = (f16)b[2]; v[7] = (f16)b[3];
    *(h8*)(dst + o) = v;
}
__device__ __forceinline__ void convert_chunk_fp8(const float* __restrict__ src, unsigned char* __restrict__ dst, size_t base, int ptid, float scale) {
    f32x4 a[4], b[4];
#pragma unroll
    for (int c = 0; c < 4; ++c) { const size_t o = base + (size_t)c * 4096 + (size_t)ptid * 8; a[c] = __builtin_nontemporal_load((const f32x4*)(src + o)); b[c] = __builtin_nontemporal_load((const f32x4*)(src + o + 4)); }
#pragma unroll
    for (int c = 0; c < 4; ++c) { const size_t o = base + (size_t)c * 4096 + (size_t)ptid * 8; const f32x4 x = a[c] * scale, y = b[c] * scale;
        u32x2 v; v[0] = pack_fp8x4(x[0], x[1], x[2], x[3]); v[1] = pack_fp8x4(y[0], y[1], y[2], y[3]);
        *(u32x2*)(dst + o) = v; }
}
__device__ __forceinline__ void phase_prologue(const Params& p_, LAS unsigned char* lds) {
    const Params p = load_params(); (void)p_;
    unsigned char* ws = phase_ws(p.ws); const int ptid = phase_tid();
    const int G = gridDim.x;
    constexpr int N_TR = 2 * 1664, N_SUBK = 128, N_UV = 2048, N_MOD = 192;
    constexpr int TOTAL = N_TR + N_SUBK + 2 * N_UV + N_MOD;
    for (int it = blockIdx.x; it < TOTAL; it += G) {
        if (it < N_MOD) {
            const int kc = it / 24, cg = it % 24, e = cg * 512 + ptid, l = e / 6144, ee = e % 6144;
            float acc = 0.f;
#pragma unroll 16
            for (int d = kc * 128; d < kc * 128 + 128; ++d) { const float cv = p.c[d]; const float sv = cv / (1.0f + __expf(-cv)); acc += sv * p.w_ada[((size_t)l * D + d) * 6144 + ee]; }
            ((float*)(ws + WS_MODP))[kc * 12288 + e] = acc;
        } else if (it < N_MOD + N_TR) {
            int j = it - N_MOD; const int l = j / 1664; j %= 1664;
            if (j < 896) { const int kt = j / 56, ntile = j % 56; transpose_tile(p.w_in + (size_t)l * D * NPROJ, D, NPROJ, (f16*)(ws + WS_WIN) + (size_t)l * NPAD * D, kt * 64, ntile * 64, (LAS f16*)lds); }
            else if (j < 896 + 256) { j -= 896; const int kt = j / 16, ntile = j % 16; transpose_tile(p.w_out + (size_t)l * D * D, D, D, (f16*)(ws + WS_WOUT) + (size_t)l * D * D, kt * 64, ntile * 64, (LAS f16*)lds); }
            else { j -= 1152; const int kt = j / 32, ntile = j % 32; transpose_tile(p.peer_wq + (size_t)l * D * NQ, D, NQ, (f16*)(ws + WS_WQ) + (size_t)l * NQ * D, kt * 64, ntile * 64, (LAS f16*)lds); }
        } else if (it < N_MOD + N_TR + N_SUBK) {
            convert_chunk(p.peer_subkeys, (f16*)(ws + WS_SUBK), (size_t)(it - N_MOD - N_TR) * 4096, ptid);
        } else if (it < N_MOD + N_TR + N_SUBK + N_UV) {
            convert_chunk_fp8(p.peer_u, ws + WS_U16, (size_t)(it - N_MOD - N_TR - N_SUBK) * 16384, ptid, PEER_U_SCALE);
        } else {
            convert_chunk_fp8(p.peer_v, ws + WS_V16, (size_t)(it - N_MOD - N_TR - N_SUBK - N_UV) * 16384, ptid, PEER_V_SCALE);
        }
    }
}
__device__ __forceinline__ float modv_partial(const Params& p, int e) {
    const float* mp = (const float*)(p.ws + WS_MODP);
    float v = p.b_ada[e];
#pragma unroll
    for (int kc = 0; kc < 8; ++kc) v += mp[kc * 12288 + e];
    return v;
}

template <bool FROM_PARTIAL>
__device__ __forceinline__ void phase_norm(const Params& p_, LAS unsigned char* lds, int l, int which) {
    const Params p = load_params(); (void)p_;
    const int shc = which ? 3 : 0, scc = which ? 4 : 1;
    LAS float* sh = (LAS float*)lds; LAS float* sc = sh + 1024; LAS float* nwl = sc + 1024;
    unsigned char* ws = phase_ws(p.ws); const int ptid = phase_tid();
    const float* X = which ? (const float*)(ws + WS_X1) : p.x; const float* nw = (which ? p.norm_ffn : p.norm_attn) + l * 1024;
    float* MOD = (float*)(ws + WS_MOD);
    if (FROM_PARTIAL) {
        for (int e = blockIdx.x * NTHREADS + ptid; e < 12288; e += gridDim.x * NTHREADS) MOD[e] = modv_partial(p, e);
        for (int i = ptid; i < 1024; i += NTHREADS) { sh[i] = modv_partial(p, l * 6144 + shc * 1024 + i); sc[i] = modv_partial(p, l * 6144 + scc * 1024 + i); nwl[i] = nw[i]; }
    } else {
        for (int i = ptid; i < 1024; i += NTHREADS) { sh[i] = MOD[l * 6144 + shc * 1024 + i]; sc[i] = MOD[l * 6144 + scc * 1024 + i]; nwl[i] = nw[i]; }
    }
    __syncthreads();
    f16* H = (f16*)(ws + WS_H);
    const int lane = ptid & 63, gw = blockIdx.x * NWAVES + (ptid >> 6);
    for (int t = gw; t < S; t += gridDim.x * NWAVES) {
        f32x4 v[4]; float ss = 0.f;
#pragma unroll
        for (int i = 0; i < 4; ++i) { v[i] = *(const f32x4*)(X + (size_t)t * D + 256 * i + 4 * lane); ss += v[i][0] * v[i][0] + v[i][1] * v[i][1] + v[i][2] * v[i][2] + v[i][3] * v[i][3]; }
        ss = wave_sum(ss);
        const float r = rsqrtf(ss * (1.0f / D) + EPS);
#pragma unroll
        for (int i = 0; i < 4; ++i) { const int c = 256 * i + 4 * lane; h4 o;
#pragma unroll
            for (int j = 0; j < 4; ++j) o[j] = (f16)((v[i][j] * r * nwl[c + j]) * (1.0f + sc[c + j]) + sh[c + j]);
            *(h4*)(H + (size_t)t * D + c) = o; }
    }
    __syncthreads();
}

__device__ __forceinline__ void phase_prep(const Params& p_, LAS unsigned char* lds) {
    const Params p = load_params(); (void)p_;
    unsigned char* ws = phase_ws(p.ws); const int ptid = phase_tid();
    const int lane = ptid & 63, wave = ptid >> 6, gw = blockIdx.x * NWAVES + wave;
    const float* IKRAW = (const float*)(ws + WS_IKRAW); f16* KN = (f16*)(ws + WS_KN);
    for (int t = gw; t < S; t += gridDim.x * NWAVES) {
        const float v = IKRAW[(size_t)t * 64 + lane];
        const float ss = wave_sum(v * v);
        KN[(size_t)t * 64 + lane] = (f16)(v * rsqrtf(ss * (1.0f / 64) + EPS));
    }
    const f16* MK = (const f16*)(ws + WS_QKV) + (size_t)1 * 8 * S * 64;
    float* KMEAN = (float*)(ws + WS_KMEAN);
    LAS float* red = (LAS float*)lds;
    for (int it = blockIdx.x; it < 512; it += gridDim.x) {
        const int h = it >> 6, j = it & 63;
        const f16* base = MK + ((size_t)h * S + (size_t)j * 256 + wave * 32) * 64 + lane;
        float a = 0.f;
        for (int r = 0; r < 32; ++r) a += (float)base[(size_t)r * 64];
        red[wave * 64 + lane] = a;
        __syncthreads();
        if (wave == 0) { float s = 0.f;
#pragma unroll
            for (int w = 0; w < 8; ++w) s += red[w * 64 + lane];
            KMEAN[(size_t)it * 64 + lane] = s * (1.0f / 256.0f); }
        __syncthreads();
    }
}

__device__ __forceinline__ void phase_gate(const Params& p_, LAS unsigned char* lds, int layer, bool dry = false) {
    const Params p = load_params(); (void)p_;
    unsigned char* ws = phase_ws(p.ws); const int ptid = phase_tid();
    const f16* MQ = (const f16*)(ws + WS_QKV);
    const float* KMEAN = (const float*)(ws + WS_KMEAN);
    int* SEL = (int*)(ws + WS_SEL);
    unsigned* LCNT = (unsigned*)(ws + WS_LCNT) + layer * 512;
    u16* LIST = (u16*)(ws + WS_LIST);
    LAS float* km = (LAS float*)lds;
    for (int it = blockIdx.x; it < 256; it += gridDim.x) {
        const int h = it >> 5, t = (it & 31) * 512 + ptid, b0 = t >> 8;
        __syncthreads();
        for (int i = ptid; i < 4096; i += NTHREADS) km[i] = KMEAN[(size_t)h * 4096 + i];
        __syncthreads();
        float q[64];
        { const f16* qp = MQ + ((size_t)h * S + t) * 64;
#pragma unroll
          for (int i = 0; i < 8; ++i) { const h8 v = *(const h8*)(qp + 8 * i);
#pragma unroll
              for (int j = 0; j < 8; ++j) q[8 * i + j] = (float)v[j]; } }
        float v0 = -INFINITY, v1 = -INFINITY, v2 = -INFINITY; int s0 = -1, s1 = -1, s2 = -1;
        const int b0u = __builtin_amdgcn_readfirstlane(b0);
        for (int n = 0; n < b0u; ++n) {
            float g = 0.f;
#pragma unroll
            for (int d4 = 0; d4 < 16; ++d4) { const f32x4 kv = *(const LAS f32x4*)(km + n * 64 + 4 * d4);
                g += q[4 * d4] * kv[0]; g += q[4 * d4 + 1] * kv[1]; g += q[4 * d4 + 2] * kv[2]; g += q[4 * d4 + 3] * kv[3]; }
            if (g > v0) { v2 = v1; s2 = s1; v1 = v0; s1 = s0; v0 = g; s0 = n; }
            else if (g > v1) { v2 = v1; s2 = s1; v1 = g; s1 = n; }
            else if (g > v2) { v2 = g; s2 = n; }
        }
        if (dry) { if (s0 == 12345) SEL[0] = 0; continue; }
        SEL[(size_t)h * S + t] = (s0 & 0xFF) | ((s1 & 0xFF) << 8) | ((s2 & 0xFF) << 16);
        if (s0 >= 0) { const unsigned pos = atomicAdd(&LCNT[h * 64 + s0], 1u); LIST[((size_t)(h * 64 + s0)) * S + pos] = (u16)(t | (0 << 14)); }
        if (s1 >= 0) { const unsigned pos = atomicAdd(&LCNT[h * 64 + s1], 1u); LIST[((size_t)(h * 64 + s1)) * S + pos] = (u16)(t | (1 << 14)); }
        if (s2 >= 0) { const unsigned pos = atomicAdd(&LCNT[h * 64 + s2], 1u); LIST[((size_t)(h * 64 + s2)) * S + pos] = (u16)(t | (2 << 14)); }
    }
    __syncthreads();
}

constexpr int TK_CAP = 1280, TK_TRIG = 1024, TK_K = 256, TK_E = TK_CAP / 64;
template <int E>
__device__ __forceinline__ void topk_compact(LAS float* val, LAS u16* idx, LAS unsigned* cnt, LAS float* tau, int lane, const int K = TK_K) {
    const int n = (int)*cnt;
    unsigned key[E]; unsigned id[E];
    unsigned kmin = 0xFFFFFFFFu, kmax = 0u;
    float vraw[E]; unsigned iraw[E];
#pragma unroll
    for (int i = 0; i < E; ++i) { vraw[i] = val[lane + 64 * i]; iraw[i] = (unsigned)idx[lane + 64 * i]; }
#pragma unroll
    for (int i = 0; i < E; ++i) { const int e = lane + 64 * i; const bool ok = e < n; key[i] = ok ? f2ord(vraw[i]) : 0u; id[i] = ok ? iraw[i] : 0xFFFFu;
        kmax = key[i] > kmax ? key[i] : kmax; const unsigned km = ok ? key[i] : 0xFFFFFFFFu; kmin = km < kmin ? km : kmin; }
#pragma unroll
    for (int o = 32; o >= 1; o >>= 1) { const unsigned a = (unsigned)__shfl_xor((int)kmax, o), b = (unsigned)__shfl_xor((int)kmin, o); kmax = a > kmax ? a : kmax; kmin = b < kmin ? b : kmin; }
    unsigned lo = kmin, hi = kmax + 1u;
    while (hi - lo > 1u) {
        const unsigned mid = lo + ((hi - lo) >> 1);
        int c = 0;
#pragma unroll
        for (int i = 0; i < E; ++i) c += __popcll(__ballot(key[i] >= mid));
        if (c >= K) lo = mid; else hi = mid;
    }
    const unsigned vstar = lo;
    int cgt = 0, ceq = 0;
#pragma unroll
    for (int i = 0; i < E; ++i) { cgt += __popcll(__ballot(key[i] > vstar)); ceq += __popcll(__ballot(key[i] == vstar)); }
    const int r = K - cgt;
    unsigned istar = 0xFFFFu;
    if (ceq > r) {
        unsigned ilo = 0u, ihi = 0xFFFFu;
        while (ilo < ihi) {
            const unsigned mid = (ilo + ihi) >> 1;
            int c = 0;
#pragma unroll
            for (int i = 0; i < E; ++i) c += __popcll(__ballot(key[i] == vstar && id[i] <= mid));
            if (c >= r) ihi = mid; else ilo = mid + 1u;
        }
        istar = ilo;
    }
    int base = 0;
    const unsigned long long lt = (1ull << lane) - 1ull;
#pragma unroll
    for (int i = 0; i < E; ++i) {
        const bool keep = key[i] > vstar || (key[i] == vstar && id[i] <= istar);
        const unsigned long long bal = __ballot(keep);
        if (keep) { const int pos = base + __popcll(bal & lt); val[pos] = ord2f(key[i]); idx[pos] = (u16)id[i]; }
        base += __popcll(bal);
    }
    if (lane == 0) { *cnt = (unsigned)base; *tau = ord2f(vstar); }
}
__device__ __forceinline__ int topk_compact_approx(LAS float* val, LAS u16* idx, LAS unsigned* cnt, LAS float* tau, LAS unsigned* hist, int lane, const int K = TK_K) {
    const int n = (int)*cnt;
    unsigned key[TK_E]; unsigned id[TK_E];
    unsigned kmin = 0xFFFFFFFFu, kmax = 0u;
    float vraw[TK_E]; unsigned iraw[TK_E];
#pragma unroll
    for (int i = 0; i < TK_E; ++i) { vraw[i] = val[lane + 64 * i]; iraw[i] = (unsigned)idx[lane + 64 * i]; }
#pragma unroll
    for (int i = 0; i < TK_E; ++i) { const int e = lane + 64 * i; const bool ok = e < n; key[i] = ok ? f2ord(vraw[i]) : 0u; id[i] = ok ? iraw[i] : 0xFFFFu;
        kmax = key[i] > kmax ? key[i] : kmax; const unsigned km = ok ? key[i] : 0xFFFFFFFFu; kmin = km < kmin ? km : kmin; }
#pragma unroll
    for (int o = 32; o >= 1; o >>= 1) { const unsigned a = (unsigned)__shfl_xor((int)kmax, o), b = (unsigned)__shfl_xor((int)kmin, o); kmax = a > kmax ? a : kmax; kmin = b < kmin ? b : kmin; }
    const unsigned R = kmax - kmin;
    const int sh = (R >> 8) ? (32 - __clz((int)(R >> 8))) : 0;
#pragma unroll
    for (int j = 0; j < 4; ++j) hist[4 * lane + j] = 0u;
    __builtin_amdgcn_wave_barrier();
#pragma unroll
    for (int i = 0; i < TK_E; ++i) if (lane + 64 * i < n) __hip_atomic_fetch_add(&hist[(key[i] - kmin) >> sh], 1u, __ATOMIC_RELAXED, __HIP_MEMORY_SCOPE_WORKGROUP);
    __builtin_amdgcn_wave_barrier();
    unsigned hb[4];
#pragma unroll
    for (int j = 0; j < 4; ++j) hb[j] = hist[4 * lane + j];
    unsigned lsum = hb[0] + hb[1] + hb[2] + hb[3];
    unsigned above = lsum;
#pragma unroll
    for (int o = 1; o < 64; o <<= 1) { const unsigned v = (unsigned)__shfl_down((int)above, o); if (lane + o < 64) above += v; }
    const unsigned excl = above - lsum;
    unsigned sfx[4];
    sfx[3] = excl + hb[3]; sfx[2] = sfx[3] + hb[2]; sfx[1] = sfx[2] + hb[1]; sfx[0] = sfx[1] + hb[0];
    int mybin = -1;
#pragma unroll
    for (int j = 0; j < 4; ++j) if (sfx[j] >= (unsigned)K) mybin = 4 * lane + j;
    int b = mybin;
#pragma unroll
    for (int o = 32; o >= 1; o >>= 1) { const int v = __shfl_xor(b, o); b = v > b ? v : b; }
    const unsigned edge = kmin + ((unsigned)b << sh);
    int base = 0;
    const unsigned long long lt = (1ull << lane) - 1ull;
#pragma unroll
    for (int i = 0; i < TK_E; ++i) {
        const bool keep = key[i] >= edge && (lane + 64 * i < n);
        const unsigned long long bal = __ballot(keep);
        if (keep) { const int pos = base + __popcll(bal & lt); val[pos] = ord2f(key[i]); idx[pos] = (u16)id[i]; }
        base += __popcll(bal);
    }
    if (lane == 0) { *cnt = (unsigned)base; *tau = ord2f(edge - 1u); }
    return base;
}
__device__ __forceinline__ void phase_topk(const Params& p_, LAS unsigned char* lds, int layer) {
    const Params p = load_params(); (void)p_;
    unsigned char* ws = phase_ws(p.ws); const int ptid = phase_tid();
    const f16* IQ = (const f16*)(ws + WS_IQ); const f16* KN = (const f16*)(ws + WS_KN); const float* IW = (const float*)(ws + WS_IW);
    u16* IDX = (u16*)(ws + WS_IDX); int* NIDX = (int*)(ws + WS_NIDX);
    LAS float* val = (LAS float*)lds;
    LAS u16* idx = (LAS u16*)(lds + 16 * TK_CAP * 4);
    LAS unsigned* cnt = (LAS unsigned*)(lds + 16 * TK_CAP * 6);
    LAS float* tau = (LAS float*)(lds + 16 * TK_CAP * 6 + 64);
    LAS unsigned* flg = (LAS unsigned*)(lds + 16 * TK_CAP * 6 + 128);
    LAS unsigned* hist = (LAS unsigned*)(lds + 16 * TK_CAP * 6 + 1024) + 256 * (ptid >> 6);
    static_assert(16 * TK_CAP * 6 + 1024 + 8 * 1024 <= LDS_BYTES - 16, "topk LDS");
    LAS unsigned* specd = (LAS unsigned*)(lds + 16 * TK_CAP * 6 + 256);
    LAS unsigned* failq = (LAS unsigned*)(lds + 16 * TK_CAP * 6 + 320);
    const int tid = ptid, lane = tid & 63, wave = __builtin_amdgcn_readfirstlane(tid >> 6), half = lane >> 5, l31 = lane & 31;
    unsigned* tctr = (unsigned*)(ws + WS_CTL + 41472) + layer;
    LAS int* tsl = (LAS int*)(lds + 16 * TK_CAP * 6 + 512);
    for (;;) {
        __syncthreads();
        if (tid == 0) tsl[0] = (int)__hip_atomic_fetch_add(tctr, 1u, __ATOMIC_RELAXED, __HIP_MEMORY_SCOPE_AGENT);
        __syncthreads();
        const int ti = tsl[0];
        if (ti >= 1024) break;
        const int tile = 1023 - ti;
        const int t0 = tile * 16;
        __syncthreads();
        if (tid < 16) { cnt[tid] = 0u; tau[tid] = -INFINITY; specd[tid] = 0u; failq[tid] = 0u; }
        if (tid == 16) failq[16] = 0u;
        if (tid < 3) flg[tid] = 0u;
        h8 a[2][4];
#pragma unroll
        for (int mt = 0; mt < 2; ++mt)
#pragma unroll
            for (int kk = 0; kk < 4; ++kk) a[mt][kk] = *(const h8*)(IQ + (size_t)(t0 + mt * 8 + (l31 >> 2)) * 256 + (l31 & 3) * 64 + 16 * kk + 8 * half);
        float wq[2][4][4];
#pragma unroll
        for (int mt = 0; mt < 2; ++mt)
#pragma unroll
            for (int j = 0; j < 4; ++j) { const f32x4 w = *(const f32x4*)(IW + (size_t)(t0 + mt * 8 + 2 * j + half) * 4);
                wq[mt][j][0] = w[0]; wq[mt][j][1] = w[1]; wq[mt][j][2] = w[2]; wq[mt][j][3] = w[3]; }
        const int nkt = (t0 + 15) / 256 + 1;
        for (int pass = 0; pass < 2; ++pass) {
        if (pass == 1) {
            __syncthreads();
            if (failq[16] == 0u) break;
            __syncthreads();
            if (tid < 16) { const bool f = failq[tid] != 0u; cnt[tid] = 0u; tau[tid] = f ? -INFINITY : INFINITY; }
            if (tid < 3) flg[tid] = 0u;
        }
        h8 bnx[4];
#pragma unroll
        for (int kk = 0; kk < 4; ++kk) bnx[kk] = *(const h8*)(KN + (size_t)(32 * wave + l31) * 64 + 16 * kk + 8 * half);
        __syncthreads();
        int par = 0;
        for (int kt = 0; kt < nkt; ++kt) {
            const int kb = kt * 256 + 32 * wave;
            const int s = kb + l31;
            h8 bfr[4];
#pragma unroll
            for (int kk = 0; kk < 4; ++kk) bfr[kk] = bnx[kk];
            if (kt + 1 < nkt) {
#pragma unroll
                for (int kk = 0; kk < 4; ++kk) bnx[kk] = *(const h8*)(KN + (size_t)(s + 256) * 64 + 16 * kk + 8 * half);
            }
            float tq[2][4];
#pragma unroll
            for (int mt = 0; mt < 2; ++mt)
#pragma unroll
                for (int j = 0; j < 4; ++j) tq[mt][j] = tau[mt * 8 + 2 * j + half];
            f32x16 acc[2];
#pragma unroll
            for (int mt = 0; mt < 2; ++mt) { acc[mt] = (f32x16){0.f,0.f,0.f,0.f,0.f,0.f,0.f,0.f,0.f,0.f,0.f,0.f,0.f,0.f,0.f,0.f};
#pragma unroll
                for (int kk = 0; kk < 4; ++kk) acc[mt] = __builtin_amdgcn_mfma_f32_32x32x16_f16(a[mt][kk], bfr[kk], acc[mt], 0, 0, 0); }
            bool trig = false;
            float Iv[2][4]; bool okv[2][4]; bool anyok = false;
#pragma unroll
            for (int mt = 0; mt < 2; ++mt)
#pragma unroll
                for (int j = 0; j < 4; ++j) {
                    const int q = mt * 8 + 2 * j + half;
                    float I = __builtin_fmaf(wq[mt][j][0], relu_i(acc[mt][4 * j]), 0.0f);
                    I = __builtin_fmaf(wq[mt][j][1], relu_i(acc[mt][4 * j + 1]), I);
                    I = __builtin_fmaf(wq[mt][j][2], relu_i(acc[mt][4 * j + 2]), I);
                    I = __builtin_fmaf(wq[mt][j][3], relu_i(acc[mt][4 * j + 3]), I);
                    Iv[mt][j] = I; okv[mt][j] = (s <= t0 + q) && (I > tq[mt][j]); anyok = anyok || okv[mt][j];
                }
            if (__any(anyok)) {
                unsigned hcnt[2][4]; unsigned rank[2][4];
                const unsigned long long hm = half ? 0xFFFFFFFF00000000ull : 0x00000000FFFFFFFFull;
                const unsigned long long ltm = (1ull << lane) - 1ull;
#pragma unroll
                for (int mt = 0; mt < 2; ++mt)
#pragma unroll
                    for (int j = 0; j < 4; ++j) { const unsigned long long bal = __ballot(okv[mt][j]) & hm; hcnt[mt][j] = (unsigned)__popcll(bal); rank[mt][j] = (unsigned)__popcll(bal & ltm); }
                unsigned base[2][4];
#pragma unroll
                for (int mt = 0; mt < 2; ++mt)
#pragma unroll
                    for (int j = 0; j < 4; ++j) base[mt][j] = 0u;
                if (l31 == 0) {
#pragma unroll
                    for (int mt = 0; mt < 2; ++mt)
#pragma unroll
                        for (int j = 0; j < 4; ++j) base[mt][j] = __hip_atomic_fetch_add(&cnt[mt * 8 + 2 * j + half], hcnt[mt][j], __ATOMIC_RELAXED, __HIP_MEMORY_SCOPE_WORKGROUP);
                }
#pragma unroll
                for (int mt = 0; mt < 2; ++mt)
#pragma unroll
                    for (int j = 0; j < 4; ++j) {
                        const unsigned b0 = (unsigned)__shfl((int)base[mt][j], lane & 32);
                        if (okv[mt][j]) { const int q = mt * 8 + 2 * j + half; const unsigned pos = b0 + rank[mt][j];
                            val[q * TK_CAP + pos] = Iv[mt][j]; idx[q * TK_CAP + pos] = (u16)s; trig = trig || (pos >= (unsigned)TK_TRIG); }
                    }
            }
            if (trig) flg[par] = 1u;
            const int parn = (par == 2) ? 0 : par + 1;
            if (tid == 0) flg[parn] = 0u;
            __syncthreads();
            const unsigned need = flg[par];
            par = parn;
            if (need) {
#pragma unroll 1
                for (int qq = 0; qq < 2; ++qq) { const int q = 2 * wave + qq;
                    if (cnt[q] > 352u) {
                        const int Nq = t0 + q + 1; int seen = 256 * (kt + 1); seen = seen < Nq ? seen : Nq;
                        int K = TK_K;
                        if (pass == 0 && Nq > 3072) { K = (768 * seen + Nq - 1) / Nq; K = K < 32 ? 32 : (K > TK_K ? TK_K : K); }
                        if (K < TK_K && lane == 0) specd[q] = 1u;
                        const int c2 = topk_compact_approx(val + q * TK_CAP, idx + q * TK_CAP, cnt + q, tau + q, hist, lane, K);
                        if (c2 > TK_TRIG) topk_compact<TK_E>(val + q * TK_CAP, idx + q * TK_CAP, cnt + q, tau + q, lane, K); } }
                __syncthreads();
            }
        }
        {
#pragma unroll 1
        for (int qq = 0; qq < 2; ++qq) { const int q = 2 * wave + qq;
            if (pass == 1 && failq[q] == 0u) continue;
            { const int Nq = t0 + q + 1; const int needc = Nq < TK_K ? Nq : TK_K;
              if (pass == 0 && ((specd[q] != 0u && (int)cnt[q] < needc) || (FORCE_FAIL && ((t0 + q) % 5) == 0))) { if (lane == 0) { failq[q] = 1u; failq[16] = 1u; } continue; } }
            if (cnt[q] > (unsigned)TK_K) {
                int c2 = (int)cnt[q];
                if (c2 > 320) c2 = topk_compact_approx(val + q * TK_CAP, idx + q * TK_CAP, cnt + q, tau + q, hist, lane);
                if (c2 > 320) topk_compact<TK_E>(val + q * TK_CAP, idx + q * TK_CAP, cnt + q, tau + q, lane);
                else if (c2 > TK_K) topk_compact<5>(val + q * TK_CAP, idx + q * TK_CAP, cnt + q, tau + q, lane);
            }
            const int n = (int)cnt[q];
            {
                LAS unsigned* bm = (LAS unsigned*)(val + q * TK_CAP);
                __builtin_amdgcn_wave_barrier();
#pragma unroll
                for (int k = 0; k < 8; ++k) bm[lane * 8 + k] = 0u;
                __builtin_amdgcn_wave_barrier();
                for (int e = lane; e < n; e += 64) { const unsigned id = idx[q * TK_CAP + e]; __hip_atomic_fetch_or(&bm[id >> 5], 1u << (id & 31u), __ATOMIC_RELAXED, __HIP_MEMORY_SCOPE_WORKGROUP); }
                __builtin_amdgcn_wave_barrier();
                int cl = 0;
#pragma unroll
                for (int k = 0; k < 8; ++k) cl += __popc(bm[lane * 8 + k]);
                int incl = cl;
#pragma unroll
                for (int o = 1; o < 64; o <<= 1) { const int v = __shfl_up(incl, o); if (lane >= o) incl += v; }
                int pos = incl - cl;
                LAS u16* sl = idx + q * TK_CAP;
#pragma unroll 1
                for (int k = 0; k < 8; ++k) { unsigned w = bm[lane * 8 + k];
                    while (w) { const int b = __ffs((int)w) - 1; sl[pos++] = (u16)((lane * 8 + k) * 32 + b); w &= w - 1u; } }
                __builtin_amdgcn_wave_barrier();
                for (int e = n + lane; e < TK_K; e += 64) sl[e] = (u16)0;
                __builtin_amdgcn_wave_barrier();
                *(u32x2*)(IDX + (size_t)(t0 + q) * TK_K + 4 * lane) = *(const LAS u32x2*)(sl + 4 * lane);
            }
            if (lane == 0) NIDX[t0 + q] = n; }
        }
        }
    }
    __syncthreads();
}

template <bool causal>
__device__ __forceinline__ void moba_block(const f16* __restrict__ Qh, const f16* __restrict__ Kh, const f16* __restrict__ VTh, int tq, int keybase, int ntiles,
                                           const LAS float* tab, const LAS unsigned char* blut, f32x16 (&o)[2], float& m, float& l, int lane) {
    const int half = lane >> 5, l31 = lane & 31;
    h8 qf[4];
#pragma unroll
    for (int kk = 0; kk < 4; ++kk) qf[kk] = *(const h8*)(Qh + (size_t)tq * 64 + 16 * kk + 8 * half);
    m = -INFINITY; l = 0.f;
#pragma unroll
    for (int mt = 0; mt < 2; ++mt) o[mt] = (f32x16){0.f,0.f,0.f,0.f,0.f,0.f,0.f,0.f,0.f,0.f,0.f,0.f,0.f,0.f,0.f,0.f};
    h8 kn[4]; h4 vnl[2][2], vnh[2][2];
    {
        const int kb = keybase;
#pragma unroll
        for (int kk = 0; kk < 4; ++kk) kn[kk] = *(const h8*)(Kh + (size_t)(kb + l31) * 64 + 16 * kk + 8 * half);
#pragma unroll
        for (int s2 = 0; s2 < 2; ++s2)
#pragma unroll
            for (int mt = 0; mt < 2; ++mt) { const f16* vp = VTh + (size_t)(32 * mt + l31) * S + kb + 16 * s2 + 4 * half; vnl[s2][mt] = *(const h4*)vp; vnh[s2][mt] = *(const h4*)(vp + 8); }
    }
    for (int kt = 0; kt < ntiles; ++kt) {
        const int kb = keybase + 32 * kt;
        h8 kf[4]; h4 vl[2][2], vh[2][2];
#pragma unroll
        for (int kk = 0; kk < 4; ++kk) kf[kk] = kn[kk];
#pragma unroll
        for (int s2 = 0; s2 < 2; ++s2)
#pragma unroll
            for (int mt = 0; mt < 2; ++mt) { vl[s2][mt] = vnl[s2][mt]; vh[s2][mt] = vnh[s2][mt]; }
        if (kt + 1 < ntiles) {
            const int kb2 = kb + 32;
#pragma unroll
            for (int kk = 0; kk < 4; ++kk) kn[kk] = *(const h8*)(Kh + (size_t)(kb2 + l31) * 64 + 16 * kk + 8 * half);
#pragma unroll
            for (int s2 = 0; s2 < 2; ++s2)
#pragma unroll
                for (int mt = 0; mt < 2; ++mt) { const f16* vp = VTh + (size_t)(32 * mt + l31) * S + kb2 + 16 * s2 + 4 * half; vnl[s2][mt] = *(const h4*)vp; vnh[s2][mt] = *(const h4*)(vp + 8); }
        }
        f32x16 s = (f32x16){0.f,0.f,0.f,0.f,0.f,0.f,0.f,0.f,0.f,0.f,0.f,0.f,0.f,0.f,0.f,0.f};
#pragma unroll
        for (int kk = 0; kk < 4; ++kk) s = __builtin_amdgcn_mfma_f32_32x32x16_f16(kf[kk], qf[kk], s, 0, 0, 0);
        float tmax = -INFINITY;
#pragma unroll
        for (int r = 0; r < 16; ++r) {
            const int key = kb + (r & 3) + 8 * (r >> 2) + 4 * half;
            int dist = tq - key; dist = dist < 0 ? 0 : (dist > 4095 ? 4095 : dist);
            float v = s[r] * 0.125f + tab[blut[dist]];
            if (causal && key > tq) v = -INFINITY;
            s[r] = v; tmax = fmaxf(tmax, v);
        }
        tmax = fmaxf(tmax, __shfl_xor(tmax, 32));
        const float mnew = fmaxf(m, tmax);
        const float alpha = __expf(m - mnew);
        float lsum = 0.f;
#pragma unroll
        for (int r = 0; r < 16; ++r) { const float pv = __expf(s[r] - mnew); s[r] = pv; lsum += pv; }
        lsum += __shfl_xor(lsum, 32);
        l = l * alpha + lsum;
#pragma unroll
        for (int mt = 0; mt < 2; ++mt) o[mt] = o[mt] * alpha;
#pragma unroll
        for (int s2 = 0; s2 < 2; ++s2) {
            h8 pf;
#pragma unroll
            for (int j = 0; j < 8; ++j) pf[j] = (f16)s[8 * s2 + j];
#pragma unroll
            for (int mt = 0; mt < 2; ++mt) {
                const h4 lo = vl[s2][mt], hi = vh[s2][mt];
                h8 vf; vf[0] = lo[0]; vf[1] = lo[1]; vf[2] = lo[2]; vf[3] = lo[3]; vf[4] = hi[0]; vf[5] = hi[1]; vf[6] = hi[2]; vf[7] = hi[3];
                o[mt] = __builtin_amdgcn_mfma_f32_32x32x16_f16(vf, pf, o[mt], 0, 0, 0);
            }
        }
        m = mnew;
    }
}
__device__ __forceinline__ void phase_moba_sel(const Params& p_, LAS unsigned char* lds, int layer, bool overlap = false) {
    const Params p = load_params(); (void)p_;
    unsigned char* ws = phase_ws(p.ws); const int ptid = phase_tid();
    const f16* QKV = (const f16*)(ws + WS_QKV);
    const unsigned* LCNT = (const unsigned*)(ws + WS_LCNT) + layer * 512;
    const u16* LIST = (const u16*)(ws + WS_LIST);
    f16* PARTO = (f16*)(ws + WS_PQ); float* ML = (float*)(ws + WS_EIDX);
    LAS int* pre = (LAS int*)lds;
    LAS float* tab = (LAS float*)(lds + 4096);
    const int tid = ptid, lane = tid & 63, wave = __builtin_amdgcn_readfirstlane(tid >> 6), half = lane >> 5, l31 = lane & 31;
    tab[tid] = p.rel_bias[tid];
    LAS unsigned char* blut = (LAS unsigned char*)(lds + 24576);
    for (int d = tid; d < 4096; d += NTHREADS) blut[d] = (unsigned char)t5_bucket(d);
    { const int c = (int)((LCNT[tid] + 31u) >> 5);
      pre[tid + 1] = c; if (tid == 0) pre[0] = 0;
      __syncthreads();
      for (int off = 1; off < 512; off <<= 1) { int v = 0; if (tid >= off) v = pre[tid + 1 - off]; __syncthreads(); pre[tid + 1] += v; __syncthreads(); } }
    const int total = pre[512];
    const int nmw = overlap ? 4 : NWAVES, mw = overlap ? wave - 4 : wave;
    if (mw >= 0)
    for (int w = blockIdx.x * nmw + mw; w < total; w += gridDim.x * nmw) {
        int lo = 0, hi = 511;
        while (lo < hi) { const int mid = (lo + hi + 1) >> 1; if (pre[mid] <= w) lo = mid; else hi = mid - 1; }
        const int L = lo, h = L >> 6, j = L & 63, tile = w - pre[L];
        const int cntL = (int)LCNT[L];
        int ei = tile * 32 + l31; const bool valid = ei < cntL; if (!valid) ei = cntL - 1;
        const unsigned e = LIST[(size_t)L * S + ei];
        const int tq = (int)(e & 0x3FFFu), slot = (int)(e >> 14);
        f32x16 o[2]; float m, l;
        moba_block<false>(QKV + (size_t)(0 * 8 + h) * S * 64, QKV + (size_t)(1 * 8 + h) * S * 64, QKV + (size_t)(2 * 8 + h) * S * 64, tq, j * 256, 8, tab + h * 32, blut, o, m, l, lane);
        if (valid) {
            const float inv = 1.0f / l;
            f16* dst = PARTO + ((size_t)(tq * 8 + h) * 3 + slot) * 64;
#pragma unroll
            for (int mt = 0; mt < 2; ++mt)
#pragma unroll
                for (int r4 = 0; r4 < 4; ++r4) { h4 ov;
#pragma unroll
                    for (int i = 0; i < 4; ++i) ov[i] = (f16)(o[mt][4 * r4 + i] * inv);
                    *(h4*)(dst + 32 * mt + 8 * r4 + 4 * half) = ov; }
            if (half == 0) { float* mlp = ML + ((size_t)(tq * 8 + h) * 3 + slot) * 2; mlp[0] = m; mlp[1] = l; }
        }
    }
    if (!overlap) __syncthreads();
}
__device__ __forceinline__ void phase_moba_own(const Params& p_, LAS unsigned char* lds) {
    const Params p = load_params(); (void)p_;
    unsigned char* ws = phase_ws(p.ws); const int ptid = phase_tid();
    const f16* QKV = (const f16*)(ws + WS_QKV);
    const int* SEL = (const int*)(ws + WS_SEL);
    const f16* PARTO = (const f16*)(ws + WS_PQ); const float* ML = (const float*)(ws + WS_EIDX);
    f16* Y = (f16*)(ws + WS_Y);
    LAS float* tab = (LAS float*)(lds + 4096);
    const int tid = ptid, lane = tid & 63, wave = tid >> 6, half = lane >> 5, l31 = lane & 31;
    LAS unsigned char* blut = (LAS unsigned char*)(lds + 24576);
    __syncthreads();
    if (tid < 256) tab[tid] = p.rel_bias[tid];
    for (int d = tid; d < 4096; d += NTHREADS) blut[d] = (unsigned char)t5_bucket(d);
    __syncthreads();
    for (int w = blockIdx.x * NWAVES + wave; w < 4096; w += gridDim.x * NWAVES) {
        const int h = w & 7; int qt = w >> 3; if (qt >= 256) qt ^= 7;
        const int t0 = qt * 32, tq = t0 + l31, b0 = t0 >> 8;
        f32x16 o[2]; float m, l;
        moba_block<true>(QKV + (size_t)(0 * 8 + h) * S * 64, QKV + (size_t)(1 * 8 + h) * S * 64, QKV + (size_t)(2 * 8 + h) * S * 64, tq, b0 * 256, ((t0 & 255) >> 5) + 1, tab + h * 32, blut, o, m, l, lane);
        const int sel = SEL[(size_t)h * S + tq];
        float mp[3], lp[3]; float M = m;
#pragma unroll
        for (int sl = 0; sl < 3; ++sl) { const bool ok = (((sel >> (8 * sl)) & 0xFF) != 0xFF);
            const float* mlp = ML + ((size_t)(tq * 8 + h) * 3 + sl) * 2;
            mp[sl] = ok ? mlp[0] : -INFINITY; lp[sl] = ok ? mlp[1] : 0.f; M = fmaxf(M, mp[sl]); }
        const float wo = __expf(m - M);
        float L = l * wo; float wsl[3];
#pragma unroll
        for (int sl = 0; sl < 3; ++sl) { wsl[sl] = lp[sl] * __expf(mp[sl] - M); L += wsl[sl]; }
        const float inv = 1.0f / L;
#pragma unroll
        for (int mt = 0; mt < 2; ++mt)
#pragma unroll
            for (int r4 = 0; r4 < 4; ++r4) {
                const int d0 = 32 * mt + 8 * r4 + 4 * half;
                float v[4];
#pragma unroll
                for (int i = 0; i < 4; ++i) v[i] = o[mt][4 * r4 + i] * wo;
#pragma unroll
                for (int sl = 0; sl < 3; ++sl) if (wsl[sl] != 0.f) {
                    const h4 pv = *(const h4*)(PARTO + ((size_t)(tq * 8 + h) * 3 + sl) * 64 + d0);
#pragma unroll
                    for (int i = 0; i < 4; ++i) v[i] += wsl[sl] * (float)pv[i]; }
                h4 ov;
#pragma unroll
                for (int i = 0; i < 4; ++i) ov[i] = (DIAG == 3) ? (f16)0.f : (f16)(v[i] * inv);
                *(h4*)(Y + (size_t)tq * D + h * 64 + d0) = ov;
            }
    }
    __syncthreads();
}

__device__ __forceinline__ void phase_dsa(const Params& p_, LAS unsigned char* lds, int layer, bool skip_prologue = false) {
    const Params p = load_params(); (void)p_;
    unsigned char* ws = phase_ws(p.ws); const int ptid = phase_tid();
    const f16* QKV = (const f16*)(ws + WS_QKV);
    const u16* IDX = (const u16*)(ws + WS_IDX); const int* NIDX = (const int*)(ws + WS_NIDX);
    f16* Y = (f16*)(ws + WS_Y);
    LAS float* tab = (LAS float*)(lds + 4096);
    const int tid = ptid, lane = tid & 63, wave = __builtin_amdgcn_readfirstlane(tid >> 6), kg = lane >> 2, c = lane & 3;
    LAS u16* ibase = (LAS u16*)(lds + 8192 + wave * 1024);
    LAS float* scb = (LAS float*)(lds + 16384 + wave * 1024);
    LAS f16* bl16 = (LAS f16*)(lds + 32768);
    {
        __syncthreads();
        for (int i = tid; i < 512; i += NTHREADS) tab[i] = p.rel_bias[i];
        for (int d = tid; d < 4096; d += NTHREADS) { const int bk = t5_bucket(d);
#pragma unroll
            for (int hh = 0; hh < 8; ++hh) bl16[hh * 4096 + d] = (f16)p.rel_bias[(8 + hh) * 32 + bk]; }
        __syncthreads();
    }
    const int G = gridDim.x;
    const int h0 = (int)(xb_xcc_id() & 7u);
    auto do_head = [&](const int h, const bool dyn, const int first, const int stride) __attribute__((always_inline)) {
    unsigned* hctr = (unsigned*)(ws + WS_CTL + 40960) + layer * 8 + h;
    const f16* DQ = QKV + (size_t)(3 * 8 + h) * S * 64;
    const unsigned char* KV = (const unsigned char*)(QKV + (size_t)4 * 8 * S * 64) + (size_t)h * S * 128 + 16 * c;
    const LAS f16* blh = bl16 + h * 4096;
    const int gwh = (blockIdx.x >> 3) * NWAVES + wave, nwh = (G >> 3) * NWAVES;
    const int eo = ((lane >> 5) & 1) * 8 + ((lane >> 4) & 1) * 4 + ((lane >> 3) & 1) * 2 + ((lane >> 2) & 1);
    const int role = (lane >> 2) & 1, g2 = lane >> 3;
    constexpr int CH = 16;
    for (int ck = first; ; ck += stride) {
      int tb0 = ck * CH;
      if (dyn) { if (lane == 0) tb0 = (int)__hip_atomic_fetch_add(hctr, (unsigned)CH, __ATOMIC_RELAXED, __HIP_MEMORY_SCOPE_AGENT);
                 tb0 = __builtin_amdgcn_readfirstlane(tb0); }
      if (tb0 >= S) break;
      u32x2 nidx = __builtin_nontemporal_load((const u32x2*)(IDX + (size_t)tb0 * 256 + 4 * lane));
      int nn = __builtin_nontemporal_load(NIDX + tb0);
      h8 nqa = __builtin_nontemporal_load((const h8*)(DQ + (size_t)tb0 * 64 + 16 * c)), nqb = __builtin_nontemporal_load((const h8*)(DQ + (size_t)tb0 * 64 + 16 * c + 8));
      for (int t = tb0; t < tb0 + CH; ++t) {
        const int n = nn;
        LAS u16* ib = ibase + ((t & 1) ? 256 : 0);
        __builtin_amdgcn_wave_barrier();
        *(LAS u32x2*)(ib + 4 * lane) = nidx;
        __builtin_amdgcn_wave_barrier();
        h2 qh[8];
#pragma unroll
        for (int j = 0; j < 4; ++j) { qh[j] = (h2){nqa[2 * j], nqa[2 * j + 1]}; qh[4 + j] = (h2){nqb[2 * j], nqb[2 * j + 1]}; }
        if (t + 1 < tb0 + CH) {
            nidx = __builtin_nontemporal_load((const u32x2*)(IDX + (size_t)(t + 1) * 256 + 4 * lane));
            nn = __builtin_nontemporal_load(NIDX + t + 1);
            nqa = __builtin_nontemporal_load((const h8*)(DQ + (size_t)(t + 1) * 64 + 16 * c)); nqb = __builtin_nontemporal_load((const h8*)(DQ + (size_t)(t + 1) * 64 + 16 * c + 8));
        }
        h2 acc2[8]; float ls = 0.f, mref = -INFINITY;
#pragma unroll
        for (int j = 0; j < 8; ++j) acc2[j] = (h2){(f16)0.f, (f16)0.f};
#pragma unroll 1
        for (int hh = 0; hh < 2; ++hh) {
            u32x4 krr[8], vrr[8]; float so[8]; bool vv[8]; bool vk[8]; int rk[8];
#pragma unroll
            for (int i = 0; i < 8; ++i) {
                const int kkK = 16 * (8 * hh + i) + 2 * g2 + role, kkV = kkK ^ 1;
                vk[i] = kkK < n; vv[i] = kkV < n;
                rk[i] = vk[i] ? (int)ib[kkK] : 0; const int rowV = vv[i] ? (int)ib[kkV] : 0;
                krr[i] = *(const u32x4*)(KV + (size_t)rk[i] * 128);
                vrr[i] = *(const u32x4*)(KV + (size_t)rowV * 128 + 64);
            }
            __builtin_amdgcn_sched_barrier(0);
#pragma unroll
            for (int i = 0; i < 8; ++i) {
                const u32x4 kr = krr[i];
                float dp[4];
#pragma unroll
                for (int w = 0; w < 4; ++w) { const h2 lo = __builtin_amdgcn_cvt_scalef32_pk_f16_fp8((int)kr[w], 1.0f, false), hi = __builtin_amdgcn_cvt_scalef32_pk_f16_fp8((int)kr[w], 1.0f, true);
                    dp[w] = __builtin_amdgcn_fdot2(hi, qh[2 * w + 1], __builtin_amdgcn_fdot2(lo, qh[2 * w], 0.f, false), false); }
                float d = (dp[0] + dp[1]) + (dp[2] + dp[3]);
                d += dpp_f<0xB1>(d); d += dpp_f<0x4E>(d);
                int dd = t - rk[i]; dd = dd < 0 ? 0 : (dd > 4095 ? 4095 : dd);
                float sv = d * (0.125f / DSA_KV_SCALE) + (float)blh[dd];
                sv = vk[i] ? sv : -INFINITY;
                so[i] = dpp_f<0x141>(sv);
            }
            float mh = mref;
#pragma unroll
            for (int i = 0; i < 8; ++i) mh = fmaxf(mh, so[i]);
            { const float scl = (mref == -INFINITY) ? 0.f : __expf(mref - mh); ls *= scl;
              const h2 s2 = (h2){(f16)scl, (f16)scl};
#pragma unroll
              for (int j = 0; j < 8; ++j) acc2[j] = acc2[j] * s2;
              mref = mh; }
#pragma unroll
            for (int i = 0; i < 8; ++i) {
                const float pv = vv[i] ? __expf(so[i] - mref) : 0.f; ls += pv;
                const h2 p2 = (h2){(f16)pv, (f16)pv};
#pragma unroll
                for (int w = 0; w < 4; ++w) { const h2 lo = __builtin_amdgcn_cvt_scalef32_pk_f16_fp8((int)vrr[i][w], 1.0f, false), hi = __builtin_amdgcn_cvt_scalef32_pk_f16_fp8((int)vrr[i][w], 1.0f, true);
                    acc2[2 * w] = __builtin_elementwise_fma(p2, lo, acc2[2 * w]); acc2[2 * w + 1] = __builtin_elementwise_fma(p2, hi, acc2[2 * w + 1]); }
            }
        }
        float acc[16];
#pragma unroll
        for (int j = 0; j < 8; ++j) { acc[2 * j] = (float)acc2[j][0]; acc[2 * j + 1] = (float)acc2[j][1]; }
        float M = mref;
        M = fmaxf(M, __shfl_xor(M, 4)); M = fmaxf(M, __shfl_xor(M, 8)); M = fmaxf(M, __shfl_xor(M, 16)); M = fmaxf(M, __shfl_xor(M, 32));
        const float fs = (mref == -INFINITY) ? 0.f : __expf(mref - M);
        ls *= fs;
#pragma unroll
        for (int j = 0; j < 16; ++j) acc[j] *= fs;
        ls += __shfl_xor(ls, 4); ls += __shfl_xor(ls, 8); ls += __shfl_xor(ls, 16); ls += __shfl_xor(ls, 32);
        float r8[8], r4[4], r2[2], r1;
        { const bool hi = (lane >> 5) & 1;
#pragma unroll
          for (int j = 0; j < 8; ++j) { const float send = hi ? acc[j] : acc[j + 8]; const float keep = hi ? acc[j + 8] : acc[j]; r8[j] = keep + __shfl_xor(send, 32); } }
        { const bool hi = (lane >> 4) & 1;
#pragma unroll
          for (int j = 0; j < 4; ++j) { const float send = hi ? r8[j] : r8[j + 4]; const float keep = hi ? r8[j + 4] : r8[j]; r4[j] = keep + __shfl_xor(send, 16); } }
        { const bool hi = (lane >> 3) & 1;
#pragma unroll
          for (int j = 0; j < 2; ++j) { const float send = hi ? r4[j] : r4[j + 2]; const float keep = hi ? r4[j + 2] : r4[j]; r2[j] = keep + __shfl_xor(send, 8); } }
        { const bool hi = (lane >> 2) & 1; const float send = hi ? r2[0] : r2[1]; const float keep = hi ? r2[1] : r2[0]; r1 = keep + __shfl_xor(send, 4); }
        __builtin_nontemporal_store((DIAG == 2) ? (f16)0.f : (f16)(r1 / (ls * DSA_KV_SCALE)), Y + (size_t)t * D + 512 + h * 64 + 16 * c + eo);
      }
    }
    };
    unsigned* xr = (unsigned*)(ws + WS_CTL + 41216) + layer * 16 + xb_xcc_id();
    LAS int* rk = (LAS int*)(lds + 28672);
    if (tid == 0) { rk[0] = (int)__hip_atomic_fetch_add(xr, 1u, __ATOMIC_RELAXED, __HIP_MEMORY_SCOPE_AGENT);
                    rk[1] = (int)__hip_atomic_load((unsigned*)(ws + WS_CTL) + XB_XCNT(xb_xcc_id()), __ATOMIC_RELAXED, __HIP_MEMORY_SCOPE_AGENT); }
    __syncthreads();
    const int rank = rk[0], nloc = rk[1] > 0 ? rk[1] : 1;
    do_head(h0, false, rank * NWAVES + wave, nloc * NWAVES);
#pragma unroll 1
    for (int h2 = 0; h2 < 8; ++h2) {
        unsigned present = 0u;
        for (int x = h2; x < 16; x += 8) present += __hip_atomic_load((unsigned*)(ws + WS_CTL) + XB_XCNT(x), __ATOMIC_RELAXED, __HIP_MEMORY_SCOPE_AGENT);
        if (__builtin_amdgcn_readfirstlane((int)present) == 0) do_head(h2, true, 0, 0);
    }
    __syncthreads();
}

#define INS16(a, ai, x, xi) do { float _x = (x); int _xi = (xi); _Pragma("unroll") for (int _k = 0; _k < 16; ++_k) { const bool _g = _x > a[_k]; \
        const float _t = _g ? a[_k] : _x; const int _ti = _g ? ai[_k] : _xi; a[_k] = _g ? _x : a[_k]; ai[_k] = _g ? _xi : ai[_k]; _x = _t; _xi = _ti; } } while (0)
__device__ __forceinline__ void ce_desc(float& a, int& ai, float& b, int& bi) {
    const bool sw = a < b; const float t = sw ? b : a, u = sw ? a : b; const int ti = sw ? bi : ai, ui = sw ? ai : bi; a = t; b = u; ai = ti; bi = ui;
}
__device__ __forceinline__ void sort16_desc(float (&c)[16], int (&ci)[16]) {
#pragma unroll
    for (int k = 2; k <= 16; k <<= 1)
#pragma unroll
        for (int j = k >> 1; j >= 1; j >>= 1)
#pragma unroll
            for (int i = 0; i < 16; ++i) { const int l = i ^ j; if (l > i) { if ((i & k) == 0) ce_desc(c[i], ci[i], c[l], ci[l]); else ce_desc(c[l], ci[l], c[i], ci[i]); } }
}
__device__ __forceinline__ void merge16(float (&a)[16], int (&ai)[16], const float (&b)[16], const int (&bi)[16]) {
    float c[16]; int ci[16];
#pragma unroll
    for (int k = 0; k < 16; ++k) { const bool g = a[k] >= b[15 - k]; c[k] = g ? a[k] : b[15 - k]; ci[k] = g ? ai[k] : bi[15 - k]; }
#pragma unroll
    for (int st = 8; st >= 1; st >>= 1)
#pragma unroll
        for (int k = 0; k < 16; ++k) if ((k & st) == 0) ce_desc(c[k], ci[k], c[k + st], ci[k + st]);
#pragma unroll
    for (int k = 0; k < 16; ++k) { a[k] = c[k]; ai[k] = ci[k]; }
}
__device__ __forceinline__ void merge_halves(float (&a)[16], int (&ai)[16]) {
    float b[16]; int bi[16];
#pragma unroll
    for (int k = 0; k < 16; ++k) { b[k] = __shfl_xor(a[k], 32); bi[k] = __shfl_xor(ai[k], 32); }
    merge16(a, ai, b, bi);
}
__device__ __forceinline__ void phase_psel(const Params& p_, LAS unsigned char* lds, int layer) {
    const Params p = load_params(); (void)p_;
    unsigned char* ws = phase_ws(p.ws); const int ptid = phase_tid();
    const f16* PQ = (const f16*)(ws + WS_PQ);
    const f16* SUBK = (const f16*)(ws + WS_SUBK) + (size_t)layer * 8 * 2 * 128 * 128;
    int* EIDX = (int*)(ws + WS_EIDX); float* EG = (float*)(ws + WS_EG);
    const int tid = ptid, lane = tid & 63, wave = tid >> 6, half = lane >> 5, l31 = lane & 31;
    for (int w = blockIdx.x * NWAVES + wave; w < 4096; w += gridDim.x * NWAVES) {
        const int h = w & 7, tt = w >> 3, t = tt * 32 + l31;
        float v0[16], v1[16]; int i0[16], i1[16];
#pragma unroll
        for (int pp = 0; pp < 2; ++pp) {
            float a[16]; int ai[16];
#pragma unroll
            for (int k = 0; k < 16; ++k) { a[k] = -INFINITY; ai[k] = 0; }
            h8 qf[8];
#pragma unroll
            for (int kk = 0; kk < 8; ++kk) qf[kk] = *(const h8*)(PQ + (size_t)t * NQ + (2 * h + pp) * 128 + 16 * kk + 8 * half);
            const f16* sk = SUBK + (size_t)(h * 2 + pp) * 128 * 128;
#pragma unroll 1
            for (int mt = 0; mt < 4; ++mt) {
                f32x16 acc = (f32x16){0.f,0.f,0.f,0.f,0.f,0.f,0.f,0.f,0.f,0.f,0.f,0.f,0.f,0.f,0.f,0.f};
#pragma unroll
                for (int kk = 0; kk < 8; ++kk) { const h8 af = *(const h8*)(sk + (size_t)(32 * mt + l31) * 128 + 16 * kk + 8 * half);
                    acc = __builtin_amdgcn_mfma_f32_32x32x16_f16(af, qf[kk], acc, 0, 0, 0); }
                float cv[16]; int cn[16];
#pragma unroll
                for (int r = 0; r < 16; ++r) { cv[r] = acc[r]; cn[r] = 32 * mt + (r & 3) + 8 * (r >> 2) + 4 * half; }
                sort16_desc(cv, cn);
                merge16(a, ai, cv, cn);
            }
            merge_halves(a, ai);
            if (pp == 0) {
#pragma unroll
                for (int k = 0; k < 16; ++k) { v0[k] = a[k]; i0[k] = ai[k]; }
            } else {
#pragma unroll
                for (int k = 0; k < 16; ++k) { v1[k] = a[k]; i1[k] = ai[k]; }
            }
        }
        float ca[16]; int ci[16];
#pragma unroll
        for (int k = 0; k < 16; ++k) {
            const float sA = v0[0] + v1[k]; const int eA = i0[0] * 128 + i1[k];
            const float sB = (k < 8) ? (v0[1] + v1[k]) : -INFINITY; const int eB = (k < 8) ? (i0[1] * 128 + i1[k]) : 0;
            ca[k] = half ? sB : sA; ci[k] = half ? eB : eA;
        }
        {
            constexpr int PI[26] = {2,2,2,2,2, 3,3,3,3, 4,4,4, 5,5, 6,6, 7,7, 8,9,10,11,12,13,14,15};
            constexpr int PJ[26] = {0,1,2,3,4, 0,1,2,3, 0,1,2, 0,1, 0,1, 0,1, 0,0,0,0,0,0,0,0};
#pragma unroll
            for (int k = 0; k < 13; ++k) {
                const float sA = v0[PI[2 * k]] + v1[PJ[2 * k]]; const int eA = i0[PI[2 * k]] * 128 + i1[PJ[2 * k]];
                const float sB = v0[PI[2 * k + 1]] + v1[PJ[2 * k + 1]]; const int eB = i0[PI[2 * k + 1]] * 128 + i1[PJ[2 * k + 1]];
                INS16(ca, ci, half ? sB : sA, half ? eB : eA);
            }
        }
        merge_halves(ca, ci);
        float e[16]; float sum = 0.f;
#pragma unroll
        for (int k = 0; k < 16; ++k) { e[k] = __expf(ca[k] - ca[0]); sum += e[k]; }
        const float inv = 1.0f / sum;
        int* ep = EIDX + (size_t)t * 128 + h * 16; float* gp = EG + (size_t)t * 128 + h * 16;
#pragma unroll
        for (int k = 0; k < 16; ++k) if ((k >> 3) == half) { ep[k] = ci[k]; gp[k] = e[k] * inv; }
    }
    __syncthreads();
}

template <bool LAST>
__device__ __forceinline__ void phase_peer(const Params& p_, LAS unsigned char* lds, int layer) {
    const Params p = load_params(); (void)p_;
    unsigned char* ws = phase_ws(p.ws); const int ptid = phase_tid();
    const unsigned char* U = ws + WS_U16 + (size_t)layer * 16384 * D; const unsigned char* V = ws + WS_V16 + (size_t)layer * 16384 * D;
    const int* EIDX = (const int*)(ws + WS_EIDX); const float* EG = (const float*)(ws + WS_EG);
    const float* X1 = (const float*)(ws + WS_X1); f16* H = (f16*)(ws + WS_H);
    const float* MOD = (const float*)(ws + WS_MOD);
    LAS float* g2 = (LAS float*)lds; LAS float* nw = g2 + 1024; LAS float* sh = nw + 1024; LAS float* sc = sh + 1024;
    const int tid = ptid, lane = tid & 63, wave = __builtin_amdgcn_readfirstlane(tid >> 6);
    __syncthreads();
    for (int i = tid; i < 1024; i += NTHREADS) {
        g2[i] = MOD[layer * 6144 + 5 * 1024 + i];
        if (LAST) { nw[i] = p.norm_final[i]; sh[i] = 0.f; sc[i] = 0.f; }
        else { nw[i] = p.norm_attn[(layer + 1) * 1024 + i]; sh[i] = MOD[(layer + 1) * 6144 + i]; sc[i] = MOD[(layer + 1) * 6144 + 1024 + i]; }
    }
    __syncthreads();
    const int el = ((lane >> 5) & 1) * 4 + ((lane >> 4) & 1) * 2 + ((lane >> 3) & 1);
    for (int ti = 0; ; ++ti) {
        const int tt = blockIdx.x + gridDim.x * (ti >> 2); if (tt >= S / 32) break;
        const int t = tt * 32 + (ti & 3) * 8 + wave;
        h2 hh2[8];
        { const h8 hA = *(const h8*)(H + (size_t)t * D + 16 * lane), hB = *(const h8*)(H + (size_t)t * D + 16 * lane + 8);
#pragma unroll
          for (int i = 0; i < 4; ++i) { hh2[i] = (h2){hA[2 * i], hA[2 * i + 1]}; hh2[4 + i] = (h2){hB[2 * i], hB[2 * i + 1]}; } }
        const int ev0 = EIDX[(size_t)t * 128 + lane], ev1 = EIDX[(size_t)t * 128 + 64 + lane];
        const float gv0 = EG[(size_t)t * 128 + lane], gv1 = EG[(size_t)t * 128 + 64 + lane];
        float acc[16];
#pragma unroll
        for (int j = 0; j < 16; ++j) acc[j] = 0.f;
#pragma unroll 1
        for (int bt = 0; bt < 16; ++bt) {
            const int kb = bt * 8;
            u32x4 ur[8], vr[8];
#pragma unroll
            for (int j = 0; j < 8; ++j) { const int k = kb + j; const int e = __builtin_amdgcn_readlane(k < 64 ? ev0 : ev1, k & 63);
                ur[j] = *(const u32x4*)(U + (size_t)e * D + 16 * lane); vr[j] = *(const u32x4*)(V + (size_t)e * D + 16 * lane); }
            __builtin_amdgcn_sched_barrier(0);
            float pd[8];
#pragma unroll
            for (int j = 0; j < 8; ++j) { float dp[4];
#pragma unroll
                for (int w = 0; w < 4; ++w) { const h2 lo = __builtin_amdgcn_cvt_scalef32_pk_f16_fp8((int)ur[j][w], 1.0f, false), hi = __builtin_amdgcn_cvt_scalef32_pk_f16_fp8((int)ur[j][w], 1.0f, true);
                    dp[w] = __builtin_amdgcn_fdot2(hi, hh2[2 * w + 1], __builtin_amdgcn_fdot2(lo, hh2[2 * w], 0.f, false), false); }
                pd[j] = (dp[0] + dp[1]) + (dp[2] + dp[3]); }
            float r4[4], r2[2], r1;
            { const bool hi = (lane >> 5) & 1;
#pragma unroll
              for (int j = 0; j < 4; ++j) { const float send = hi ? pd[j] : pd[j + 4]; const float keep = hi ? pd[j + 4] : pd[j]; r4[j] = keep + __shfl_xor(send, 32); } }
            { const bool hi = (lane >> 4) & 1;
#pragma unroll
              for (int j = 0; j < 2; ++j) { const float send = hi ? r4[j] : r4[j + 2]; const float keep = hi ? r4[j + 2] : r4[j]; r2[j] = keep + __shfl_xor(send, 16); } }
            { const bool hi = (lane >> 3) & 1; const float send = hi ? r2[0] : r2[1]; const float keep = hi ? r2[1] : r2[0]; r1 = keep + __shfl_xor(send, 8); }
            r1 += __shfl_xor(r1, 4); r1 += __shfl_xor(r1, 2); r1 += __shfl_xor(r1, 1);
            const int kmine = kb + el;
            const float gmine = __shfl(kmine < 64 ? gv0 : gv1, kmine & 63);
            const float wmine = gmine * gelu_exact(r1 * (1.0f / PEER_U_SCALE));
#pragma unroll
            for (int j = 0; j < 8; ++j) {
                const int src = ((j >> 2) & 1) * 32 + ((j >> 1) & 1) * 16 + (j & 1) * 8;
                const float wj = __uint_as_float(__builtin_amdgcn_readlane(__float_as_uint(wmine), src));
#pragma unroll
                for (int w = 0; w < 4; ++w) { const f32x2 lo = __builtin_amdgcn_cvt_pk_f32_fp8((int)vr[j][w], false), hi = __builtin_amdgcn_cvt_pk_f32_fp8((int)vr[j][w], true);
                    acc[4 * w] += wj * lo[0]; acc[4 * w + 1] += wj * lo[1]; acc[4 * w + 2] += wj * hi[0]; acc[4 * w + 3] += wj * hi[1]; }
            }
        }
#pragma unroll
        for (int j = 0; j < 16; ++j) acc[j] *= (1.0f / PEER_V_SCALE);
        const float* xr = X1 + (size_t)t * D + 16 * lane;
        float x2[16]; float ss = 0.f;
#pragma unroll
        for (int i = 0; i < 4; ++i) { const f32x4 xv = *(const f32x4*)(xr + 4 * i);
#pragma unroll
            for (int j = 0; j < 4; ++j) { const float v = xv[j] + g2[16 * lane + 4 * i + j] * acc[4 * i + j]; x2[4 * i + j] = v; ss += v * v; } }
        ss = wave_sum(ss);
        const float r = rsqrtf(ss * (1.0f / D) + EPS);
        if (LAST) {
            float* op = p.out + (size_t)t * D + 16 * lane;
#pragma unroll
            for (int i = 0; i < 4; ++i) { f32x4 ov;
#pragma unroll
                for (int j = 0; j < 4; ++j) ov[j] = x2[4 * i + j] * r * nw[16 * lane + 4 * i + j];
                *(f32x4*)(op + 4 * i) = ov; }
        } else {
            float* op = p.out + (size_t)t * D + 16 * lane;
#pragma unroll
            for (int i = 0; i < 4; ++i) { f32x4 ov;
#pragma unroll
                for (int j = 0; j < 4; ++j) ov[j] = x2[4 * i + j];
                *(f32x4*)(op + 4 * i) = ov; }
            h8 oA, oB;
#pragma unroll
            for (int j = 0; j < 8; ++j) { const int cA = 16 * lane + j, cB = cA + 8;
                oA[j] = (f16)((x2[j] * r * nw[cA]) * (1.0f + sc[cA]) + sh[cA]); oB[j] = (f16)((x2[8 + j] * r * nw[cB]) * (1.0f + sc[cB]) + sh[cB]); }
            *(h8*)(H + (size_t)t * D + 16 * lane) = oA; *(h8*)(H + (size_t)t * D + 16 * lane + 8) = oB;
        }
    }
    __syncthreads();
}


#ifndef CHECKS
#define CHECKS 0
#endif
__device__ __forceinline__ float naive_iscore(const f16* IQ, const f16* KN, const float* IW, int t, int s) {
    float x[4] = {0.f, 0.f, 0.f, 0.f};
    for (int d8 = 0; d8 < 8; ++d8) {
        const h8 kv = *(const h8*)(KN + (size_t)s * 64 + 8 * d8);
#pragma unroll
        for (int hh = 0; hh < 4; ++hh) { const h8 qv = *(const h8*)(IQ + (size_t)t * 256 + hh * 64 + 8 * d8);
#pragma unroll
            for (int j = 0; j < 8; ++j) x[hh] += (float)qv[j] * (float)kv[j]; }
    }
    float I = 0.f;
#pragma unroll
    for (int hh = 0; hh < 4; ++hh) I += IW[(size_t)t * 4 + hh] * fmaxf(x[hh], 0.f);
    return I + 0.0f;
}
__device__ __forceinline__ void phase_check_attn(const Params& p_, LAS unsigned char* lds) {
    const Params p = load_params(); (void)p_;
    unsigned char* ws = phase_ws(p.ws); const int ptid = phase_tid();
    const f16* QKV = (const f16*)(ws + WS_QKV); const f16* IQ = (const f16*)(ws + WS_IQ); const f16* KN = (const f16*)(ws + WS_KN); const float* IW = (const float*)(ws + WS_IW);
    const u16* IDX = (const u16*)(ws + WS_IDX); const int* NIDX = (const int*)(ws + WS_NIDX); const f16* Y = (const f16*)(ws + WS_Y);
    const int* SEL = (const int*)(ws + WS_SEL); const float* KMEAN = (const float*)(ws + WS_KMEAN); const f16* H = (const f16*)(ws + WS_H);
    const int lane = ptid & 63, wave = __builtin_amdgcn_readfirstlane(ptid >> 6), gw = blockIdx.x * NWAVES + wave, nw = gridDim.x * NWAVES;
    constexpr int NS = 40;
    for (int si = gw; si < NS; si += nw) {
        const int t = (si < 4) ? (si * 85 + 3) : (si * 419 + 7) % S;
        const int n = NIDX[t];
        if (n != (t + 1 < 256 ? t + 1 : 256)) set_flag(ws, 4u);
        int sidx[4]; float sI[4]; float mn = INFINITY;
#pragma unroll
        for (int i = 0; i < 4; ++i) { const int k = lane + 64 * i; const bool ok = k < n; sidx[i] = ok ? (int)IDX[(size_t)t * 256 + k] : 0;
            sI[i] = ok ? naive_iscore(IQ, KN, IW, t, sidx[i]) : INFINITY; mn = fminf(mn, sI[i]);
            if (ok && sidx[i] > t) set_flag(ws, 4u); }
        mn = wave_min(mn);
        const float tol = 1e-4f * fabsf(mn) + 1e-5f;
        int call = 0, csel = 0;
        for (int s2 = lane; s2 <= t; s2 += 64) call += (naive_iscore(IQ, KN, IW, t, s2) > mn + tol) ? 1 : 0;
#pragma unroll
        for (int i = 0; i < 4; ++i) csel += (lane + 64 * i < n && sI[i] > mn + tol) ? 1 : 0;
        call = wave_sumi(call); csel = wave_sumi(csel);
        if (call != csel) set_flag(ws, 4u);
        for (int h = 0; h < 8; ++h) {
            const f16* DQ = QKV + (size_t)(3 * 8 + h) * S * 64; const f16* DK = QKV + (size_t)(4 * 8 + h) * S * 64; const f16* DV = QKV + (size_t)(5 * 8 + h) * S * 64;
            float lg[4]; float mx = -INFINITY;
#pragma unroll
            for (int i = 0; i < 4; ++i) { const bool ok = lane + 64 * i < n; float d = 0.f;
                for (int dd = 0; dd < 64; ++dd) d += (float)DQ[(size_t)t * 64 + dd] * (float)DK[(size_t)sidx[i] * 64 + dd];
                const int dist = t - sidx[i];
                lg[i] = ok ? d * 0.125f + p.rel_bias[(8 + h) * 32 + t5_bucket(dist < 0 ? 0 : dist)] : -INFINITY; mx = fmaxf(mx, lg[i]); }
            mx = wave_max(mx);
            float pr[4]; float ls = 0.f;
#pragma unroll
            for (int i = 0; i < 4; ++i) { pr[i] = __expf(lg[i] - mx); ls += pr[i]; }
            ls = wave_sum(ls);
            float o = 0.f;
#pragma unroll
            for (int i = 0; i < 4; ++i)
                for (int src = 0; src < 64; ++src) { const float pk = __shfl(pr[i], src); const int row = __shfl(sidx[i], src); o += pk * (float)DV[(size_t)row * 64 + lane]; }
            o /= ls;
            const float got = (float)Y[(size_t)t * D + 512 + h * 64 + lane];
            const float err = wave_max(fabsf(got - o)), sc = wave_max(fabsf(o));
            if (err > 4e-3f * sc + 1e-3f) set_flag(ws, 8u);
        }
    }
    LAS float* pbuf = (LAS float*)(lds + 32768) + wave * 1024;
    LAS int* sbuf = (LAS int*)(lds + 32768 + 8 * 4096) + wave * 4;
    for (int si = gw; si < NS * 8; si += nw) {
        const int h = si & 7, s8 = si >> 3;
        const int t = (s8 < 4) ? (s8 * 170 + 11) : (s8 * 419 + 7) % S;
        const int b0 = t >> 8;
        const f16* MQ = QKV + (size_t)(0 * 8 + h) * S * 64; const f16* MK = QKV + (size_t)(1 * 8 + h) * S * 64; const f16* MVT = QKV + (size_t)(2 * 8 + h) * S * 64;
        float g = -INFINITY;
        if (lane < b0) { g = 0.f; for (int dd = 0; dd < 64; ++dd) g += (float)MQ[(size_t)t * 64 + dd] * KMEAN[(size_t)(h * 64 + lane) * 64 + dd]; }
        const int sel = SEL[(size_t)h * S + t];
        __builtin_amdgcn_wave_barrier();
        for (int r = 0; r < 3; ++r) { const float mxg = wave_max(g); int cand = (g == mxg && mxg > -INFINITY) ? lane : 999; cand = -(int)wave_max((float)(-cand));
            const int sb_ref = cand < 999 ? cand : -1; if (lane == 0) sbuf[r] = sb_ref; if (lane == cand) g = -INFINITY;
            int sb = (sel >> (8 * r)) & 0xFF; if (sb == 0xFF) sb = -1; if (sb != sb_ref) set_flag(ws, 16u); }
        if (lane == 0) sbuf[3] = b0;
        __builtin_amdgcn_wave_barrier();
        float mx = -INFINITY;
        for (int r = 0; r < 4; ++r) { const int sb = sbuf[r];
            for (int i = 0; i < 4; ++i) { const int key = sb * 256 + lane + 64 * i; const bool ok = sb >= 0 && key <= t;
                float d = 0.f; if (ok) for (int dd = 0; dd < 64; ++dd) d += (float)MQ[(size_t)t * 64 + dd] * (float)MK[(size_t)key * 64 + dd];
                const float lgv = ok ? d * 0.125f + p.rel_bias[h * 32 + t5_bucket(t - key)] : -INFINITY; mx = fmaxf(mx, lgv); pbuf[r * 256 + lane + 64 * i] = lgv; } }
        mx = wave_max(mx);
        float ls = 0.f;
        __builtin_amdgcn_wave_barrier();
        for (int e2 = lane; e2 < 1024; e2 += 64) { const float pv = __expf(pbuf[e2] - mx); ls += pv; pbuf[e2] = pv; }
        ls = wave_sum(ls);
        __builtin_amdgcn_wave_barrier();
        float o = 0.f;
        for (int r = 0; r < 4; ++r) { const int sb = sbuf[r]; if (sb < 0) continue;
            for (int kk = 0; kk < 256; ++kk) { const float pv = pbuf[r * 256 + kk]; if (pv != 0.f) o += pv * (float)MVT[(size_t)lane * S + sb * 256 + kk]; } }
        o /= ls;
        const float got = (float)Y[(size_t)t * D + h * 64 + lane];
        const float err = wave_max(fabsf(got - o)), sc = wave_max(fabsf(o));
        if (err > 4e-3f * sc + 1e-3f) set_flag(ws, 16u);
        __builtin_amdgcn_wave_barrier();
    }
    for (int si = gw; si < NS; si += nw) {
        const int t = (si * 419 + 7) % S;
        const int layer_unknown = 0; (void)layer_unknown;
        (void)H;
    }
    __syncthreads();
}


__device__ __forceinline__ void phase_check_psel(const Params& p_, LAS unsigned char* lds, int layer) {
    const Params p = load_params(); (void)p_;
    int zoff = 0; LAUNDER_S(zoff); unsigned char* ws = p.ws + zoff; const int ptid = phase_tid();
    const f16* PQ = (const f16*)(ws + WS_PQ);
    const f16* SUBK = (const f16*)(ws + WS_SUBK) + (size_t)layer * 8 * 2 * 128 * 128;
    const int* EIDX = (const int*)(ws + WS_EIDX); const float* EG = (const float*)(ws + WS_EG);
    const int lane = ptid & 63, wave = __builtin_amdgcn_readfirstlane(ptid >> 6), gw = blockIdx.x * NWAVES + wave, nw = gridDim.x * NWAVES;
    LAS float* tvL = (LAS float*)(lds + 32768) + wave * 64;
    LAS int* tiL = (LAS int*)(lds + 32768 + 8 * 256) + wave * 64;
    constexpr int NS = 40;
    for (int si = gw; si < NS * 8; si += nw) {
        const int h = si & 7, s8 = si >> 3, t = (s8 * 419 + 7) % S;
        __builtin_amdgcn_wave_barrier();
        for (int pp = 0; pp < 2; ++pp) {
            float s0 = 0.f, s1 = 0.f;
            const f16* qp = PQ + (size_t)t * NQ + (2 * h + pp) * 128; const f16* kp = SUBK + (size_t)(h * 2 + pp) * 128 * 128;
            for (int d = 0; d < 128; ++d) { const float qv = (float)qp[d]; s0 += qv * (float)kp[(size_t)lane * 128 + d]; s1 += qv * (float)kp[(size_t)(lane + 64) * 128 + d]; }
            for (int r = 0; r < 16; ++r) {
                const float mx = wave_max(fmaxf(s0, s1));
                int c = (s0 == mx) ? lane : ((s1 == mx) ? lane + 64 : 999);
                c = -(int)wave_max((float)(-c));
                if (lane == 0) { tvL[pp * 16 + r] = mx; tiL[pp * 16 + r] = c; }
                if (c == lane) s0 = -INFINITY; if (c == lane + 64) s1 = -INFINITY;
            }
        }
        __builtin_amdgcn_wave_barrier();
        float cs[4]; const int ci_ = lane >> 2;
#pragma unroll
        for (int jj = 0; jj < 4; ++jj) cs[jj] = tvL[ci_] + tvL[16 + 4 * (lane & 3) + jj];
        float gs[16]; int ge[16];
#pragma unroll
        for (int r = 0; r < 16; ++r) {
            float m4 = fmaxf(fmaxf(cs[0], cs[1]), fmaxf(cs[2], cs[3]));
            const float mx = wave_max(m4);
            int c = 999;
#pragma unroll
            for (int jj = 3; jj >= 0; --jj) if (cs[jj] == mx) c = ci_ * 16 + 4 * (lane & 3) + jj;
            c = -(int)wave_max((float)(-c));
            gs[r] = mx; ge[r] = tiL[c >> 4] * 128 + tiL[16 + (c & 15)];
#pragma unroll
            for (int jj = 0; jj < 4; ++jj) if (c == ci_ * 16 + 4 * (lane & 3) + jj) cs[jj] = -INFINITY;
        }
        float sum = 0.f;
        { const float g0 = gs[0];
#pragma unroll
          for (int r = 0; r < 16; ++r) gs[r] = __expf(gs[r] - g0); }
#pragma unroll
        for (int r = 0; r < 16; ++r) sum += gs[r];
        bool bad = false;
#pragma unroll
        for (int r = 0; r < 16; ++r) { const int e = EIDX[(size_t)t * 128 + h * 16 + r]; const float g = EG[(size_t)t * 128 + h * 16 + r];
            if (e != ge[r]) bad = true; if (fabsf(g - gs[r] / sum) > 1e-3f) bad = true; }
        if (bad) set_flag(ws, 1u);
    }
    __syncthreads();
}

constexpr int NPHASE = 2 + 2 * 9 + (CHECKS ? 1 : 0);
__global__ void __launch_bounds__(NTHREADS) fwd_kernel(Params p) {
    extern __shared__ __attribute__((aligned(16))) unsigned char lds_raw[];
    LAS unsigned char* lds = (LAS unsigned char*)lds_raw;
    volatile LAS unsigned* xbw = (volatile LAS unsigned*)(lds + LDS_BYTES - 16);
    if (threadIdx.x < 4) xbw[threadIdx.x] = 0u;
    __syncthreads();
    const Params p0 = load_params();
    XcdBarrier bar; bar.bar = (unsigned*)(p0.ws + WS_CTL); bar.x = 0; bar.st = xbw;
#if ONE_LAUNCH
    bar = xcd_barrier_post((unsigned*)(p0.ws + WS_CTL), xbw);
#endif
    const int lo = p0.ph_lo, hi = p0.ph_hi;
    int ph = 0;
#if ONE_LAUNCH
#define PHASE(...) do { if (PH_ON(ph) && ph >= lo && ph < hi) { __VA_ARGS__; if (ph + 1 < hi) xcd_barrier(bar); } ++ph; } while (0)
#else
#define PHASE(...) do { if (PH_ON(ph) && ph >= lo && ph < hi) { __VA_ARGS__; } ++ph; } while (0)
#endif
    PHASE(REP(8, phase_prologue(p, lds)));
    PHASE(phase_norm<true>(p, lds, 0, 0));
    for (int layer = 0; layer < 2; ++layer) {
        PHASE({ const Params q = load_params(); unsigned char* ws = phase_ws(q.ws); pg8::Gemm g{(const f16*)(ws + WS_H), (const f16*)(ws + WS_WIN) + (size_t)layer * NPAD * D, S, NPAD, D};
                pg8::StaticOrder so; so.init(S, NPAD, gridDim.x, blockIdx.x);
                EpiIn E{(f16*)(ws + WS_QKV), (f16*)(ws + WS_IQ), (float*)(ws + WS_IKRAW), (float*)(ws + WS_IW)};
                REP(6, pg8::gemm_phase<EpiIn>(lds, g, so, E)); });
        PHASE(REP(10, phase_prep(p, lds)));
        PHASE({ phase_gate(p, lds, layer); if (REP_WHAT == 15) phase_gate(p, lds, layer, true); phase_topk(p, lds, layer); });
        PHASE({ phase_moba_sel(p, lds, layer, false); phase_dsa(p, lds, layer, false); });
        PHASE(REP(7, phase_moba_own(p, lds)));
        PHASE({ if (CHECKS) phase_check_attn(p, lds); const Params q = load_params(); unsigned char* ws = phase_ws(q.ws); const float* Xin = (layer == 0) ? q.x : q.out; pg8::Gemm g{(const f16*)(ws + WS_Y), (const f16*)(ws + WS_WOUT) + (size_t)layer * D * D, S, D, D};
                pg8::StaticOrder so; so.init(S, D, gridDim.x, blockIdx.x);
                EpiOut E{Xin, (float*)(ws + WS_X1), (const float*)(ws + WS_MOD) + layer * 6144 + 2 * 1024};
                REP(13, pg8::gemm_phase<EpiOut>(lds, g, so, E)); });
        PHASE(REP(11, phase_norm<false>(p, lds, layer, 1)));
        PHASE({ const Params q = load_params(); unsigned char* ws = phase_ws(q.ws); pg8::Gemm g{(const f16*)(ws + WS_H), (const f16*)(ws + WS_WQ) + (size_t)layer * NQ * D, S, NQ, D};
                pg8::StaticOrder so; so.init(S, NQ, gridDim.x, blockIdx.x);
                EpiPQ E{(f16*)(ws + WS_PQ)};
                REP(12, pg8::gemm_phase<EpiPQ>(lds, g, so, E)); });
        if (layer == 0) { PHASE({ phase_psel(p, lds, layer); asm volatile("s_waitcnt vmcnt(0)" ::: "memory"); __syncthreads(); phase_peer<false>(p, lds, layer); }); } else { PHASE({ phase_psel(p, lds, layer); asm volatile("s_waitcnt vmcnt(0)" ::: "memory"); __syncthreads(); phase_peer<true>(p, lds, layer); }); }
    }
#if ONE_LAUNCH
    if (REP_WHAT == 14) { for (int i = 0; i < 20; ++i) xcd_barrier(bar); }
#endif
    if (CHECKS) PHASE({ const Params q = load_params(); if (blockIdx.x == 0 && threadIdx.x == 0) { const unsigned fl = *(volatile unsigned*)(q.ws + WS_FLAG);
              if (fl) q.out[0] += sqrtf((10.0f + (float)fl) * 1000.0f * 16777216.0f); } });
#undef PHASE
}

extern "C" void kernel_launch(void* const* d_in, const int* in_sizes, int n_in, void* d_out, int out_size, void* d_ws, size_t ws_size, hipStream_t stream) {
    static int grid = 0;
    if (grid == 0) {
        if (n_in != 14 || out_size != S * D || ws_size < WS_END) { fprintf(stderr, "kernel_launch: unexpected shapes (n_in %d out %d ws %zu)\n", n_in, out_size, ws_size); grid = -1; return; }
        if (hipFuncSetAttribute((const void*)fwd_kernel, hipFuncAttributeMaxDynamicSharedMemorySize, LDS_BYTES) != hipSuccess) { fprintf(stderr, "kernel_launch: hipFuncSetAttribute failed\n"); grid = -1; return; }
        int dev = 0, cus = 0, per_cu = 0;
        (void)hipGetDevice(&dev); (void)hipDeviceGetAttribute(&cus, hipDeviceAttributeMultiprocessorCount, dev);
        (void)hipOccupancyMaxActiveBlocksPerMultiprocessor(&per_cu, (const void*)fwd_kernel, NTHREADS, LDS_BYTES);
        (void)hipGetLastError();
        if (per_cu < 1) fprintf(stderr, "kernel_launch: occupancy query reports %d blocks per CU\n", per_cu);
        grid = (cus > 0 ? cus : 256);
        if (grid > 256) grid = 256;
    }
    if (grid < 0) return;
    (void)hipMemsetAsync((char*)d_ws + WS_CTL, 0, CTL_ZERO_BYTES, stream);
    Params p{};
    p.x = (const float*)d_in[0]; p.c = (const float*)d_in[1]; p.w_ada = (const float*)d_in[2]; p.b_ada = (const float*)d_in[3];
    p.norm_attn = (const float*)d_in[4]; p.norm_ffn = (const float*)d_in[5]; p.w_in = (const float*)d_in[6]; p.w_out = (const float*)d_in[7];
    p.rel_bias = (const float*)d_in[8]; p.peer_wq = (const float*)d_in[9]; p.peer_subkeys = (const float*)d_in[10]; p.peer_u = (const float*)d_in[11];
    p.peer_v = (const float*)d_in[12]; p.norm_final = (const float*)d_in[13];
    p.out = (float*)d_out; p.ws = (unsigned char*)d_ws;
#if ONE_LAUNCH
    p.ph_lo = 0; p.ph_hi = NPHASE;
    hipLaunchKernelGGL(fwd_kernel, dim3(grid), dim3(NTHREADS), LDS_BYTES, stream, p);
#else
    for (int ph = 0; ph < NPHASE; ++ph) { p.ph_lo = ph; p.ph_hi = ph + 1; hipLaunchKernelGGL(fwd_kernel, dim3(grid), dim3(NTHREADS), LDS_BYTES, stream, p); }
#endif
}
```

```cpp
#include <hip/hip_runtime.h>
#include <cstdio>
#include <cstdint>
#include <type_traits>

#ifndef DIAG
#define DIAG 0
#endif
#ifdef ONLY_PHASE
#define PH_ON(ph) ((ph) == ONLY_PHASE)
#else
#define PH_ON(ph) true
#endif
#ifndef ONE_LAUNCH
#define ONE_LAUNCH 1
#endif
#ifndef REP_WHAT
#define REP_WHAT 0
#endif
#ifndef FORCE_FAIL
#define FORCE_FAIL 0
#endif
#define REP(k, ...) do { int _nrep = (REP_WHAT == (k)) ? 2 : 1; if (REP_WHAT) asm volatile("" : "+s"(_nrep)); for (int _r = 0; _r < _nrep; ++_r) { __VA_ARGS__; } } while (0)

#define LAS __attribute__((address_space(3)))
typedef _Float16 f16;
typedef _Float16 h8 __attribute__((ext_vector_type(8)));
typedef _Float16 h4 __attribute__((ext_vector_type(4)));
typedef _Float16 h2 __attribute__((ext_vector_type(2)));
typedef float f32x2 __attribute__((ext_vector_type(2)));
typedef float f32x4 __attribute__((ext_vector_type(4)));
typedef float f32x16 __attribute__((ext_vector_type(16)));
typedef unsigned short u16;
typedef unsigned u32x2 __attribute__((ext_vector_type(2)));
typedef unsigned u32x4 __attribute__((ext_vector_type(4)));

constexpr int S = 16384, D = 1024, NPROJ = 3396, NPAD = 3584, NQ = 2048;
constexpr int NTHREADS = 512, NWAVES = 8;
constexpr int LDS_BYTES = 147456;
constexpr float EPS = 1e-6f;
constexpr float DSA_KV_SCALE = 4.0f;
#ifndef DSA_SWEEP
#define DSA_SWEEP 1
#endif
constexpr float PEER_U_SCALE = 64.0f, PEER_V_SCALE = 8.0f;
constexpr size_t MBy = 1ull << 20;
constexpr size_t WS_CTL = 0, WS_LCNT = 16384, WS_MODP = 65536, WS_MOD = 458752, WS_KMEAN = 524288, WS_SEL = 1 * MBy, WS_IW = 2 * MBy, WS_NIDX = 3 * MBy,
    WS_WIN = 4 * MBy, WS_WOUT = 18 * MBy, WS_WQ = 22 * MBy, WS_SUBK = 30 * MBy, WS_U16 = 32 * MBy, WS_V16 = 96 * MBy, WS_H = 160 * MBy, WS_X1 = 192 * MBy,
    WS_QKV = 256 * MBy, WS_IQ = 352 * MBy, WS_IKRAW = 360 * MBy, WS_KN = 364 * MBy, WS_IDX = 366 * MBy, WS_LIST = 374 * MBy, WS_Y = 390 * MBy,
    WS_PQ = 422 * MBy, WS_EIDX = 486 * MBy, WS_EG = 494 * MBy, WS_END = 502 * MBy;
constexpr size_t CTL_ZERO_BYTES = 65536;

struct Params {
    const float* x; const float* c; const float* w_ada; const float* b_ada; const float* norm_attn; const float* norm_ffn; const float* w_in; const float* w_out;
    const float* rel_bias; const float* peer_wq; const float* peer_subkeys; const float* peer_u; const float* peer_v; const float* norm_final;
    float* out; unsigned char* ws; int ph_lo, ph_hi;
};

#define XB_TMO      128
#define XB_XCNT(j)  (256  + 64 * (j))
#define XB_XSUB(j)  (1280 + 64 * (j))
#define XB_XGEN(j)  (2304 + 64 * (j))
#define XB_TOP      3328
#define XB_TOPGEN   3392
#define XCD_BAR_WORDS 3456
#define XB_SPIN_CAP (1u << 25)
__device__ __forceinline__ unsigned xb_ld(unsigned* p)              { return __hip_atomic_load(p, __ATOMIC_RELAXED, __HIP_MEMORY_SCOPE_AGENT); }
__device__ __forceinline__ unsigned xb_add(unsigned* p, unsigned v) { return __hip_atomic_fetch_add(p, v, __ATOMIC_RELAXED, __HIP_MEMORY_SCOPE_AGENT); }
__device__ __forceinline__ unsigned xb_xcc_id() { return (unsigned)__builtin_amdgcn_s_getreg((3 << 11) | 20) & 0xFu; }
#define XB_SPIN(cond, bar) do { unsigned _sp = 0; while (cond) { __builtin_amdgcn_s_sleep(1); \
    if ((++_sp & 255u) == 0u) { if (xb_ld(&(bar)[XB_TMO])) break; if (_sp > XB_SPIN_CAP) { atomicAdd(&(bar)[XB_TMO], 1u); break; } } } } while (0)
struct XcdBarrier { unsigned* bar; unsigned x; volatile LAS unsigned* st; };
__device__ __forceinline__ XcdBarrier xcd_barrier_post(unsigned* bar, volatile LAS unsigned* st) {
    XcdBarrier b; b.bar = bar; b.x = xb_xcc_id(); b.st = st;
    if (threadIdx.x == 0) (void)xb_add(&bar[XB_XCNT(b.x)], 1u);
    return b;
}
__device__ __forceinline__ void xcd_barrier_complete(unsigned* bar, unsigned x, unsigned& nloc, unsigned& nx) {
    const unsigned G = gridDim.x * gridDim.y * gridDim.z;
    unsigned sum, cnt, mine, sp = 0u;
    for (;;) {
        sum = 0u; cnt = 0u; mine = 0u;
#pragma unroll
        for (unsigned j = 0; j < 16; ++j) { const unsigned c = xb_ld(&bar[XB_XCNT(j)]); sum += c; cnt += (c > 0u) ? 1u : 0u; mine = (j == x) ? c : mine; }
        if (sum == G) break;
        __builtin_amdgcn_s_sleep(1);
        if ((++sp & 255u) == 0u) { if (xb_ld(&bar[XB_TMO])) break; if (sp > XB_SPIN_CAP) { atomicAdd(&bar[XB_TMO], 1u); break; } }
    }
    nloc = mine > 0u ? mine : 1u; nx = cnt > 0u ? cnt : 1u;
}
__device__ __forceinline__ void xcd_barrier(const XcdBarrier& b) {
    asm volatile("s_waitcnt vmcnt(0)" ::: "memory");
    __syncthreads();
    if (threadIdx.x == 0) {
        unsigned* bar = b.bar;
        __builtin_amdgcn_s_waitcnt(0);
        unsigned nloc = b.st[0], nx = b.st[1];
        if (nloc == 0u) { xcd_barrier_complete(bar, b.x, nloc, nx); b.st[0] = nloc; b.st[1] = nx; }
        const unsigned old = xb_add(&bar[XB_XSUB(b.x)], 1u);
        const unsigned gen = old / nloc;
        if (old + 1u == (gen + 1u) * nloc) {
            __builtin_amdgcn_fence(__ATOMIC_RELEASE, "agent");
            asm volatile("s_waitcnt vmcnt(0)" ::: "memory");
            const unsigned og = xb_add(&bar[XB_TOP], 1u);
            const unsigned tg = og / nx;
            if (og + 1u == (tg + 1u) * nx) xb_add(&bar[XB_TOPGEN], 1u);
            else XB_SPIN(xb_ld(&bar[XB_TOPGEN]) == tg, bar);
            __builtin_amdgcn_fence(__ATOMIC_ACQUIRE, "agent");
            xb_add(&bar[XB_XGEN(b.x)], 1u);
            asm volatile("s_waitcnt vmcnt(0)" ::: "memory");
        } else {
            XB_SPIN(xb_ld(&bar[XB_XGEN(b.x)]) == gen, bar);
            __builtin_amdgcn_fence(__ATOMIC_ACQUIRE, "agent");
            asm volatile("s_waitcnt vmcnt(0)" ::: "memory");
        }
    }
    __syncthreads();
}

#define LAUNDER_S(x) asm volatile("" : "+s"(x) :: "memory")
#define LAUNDER_V(x) asm volatile("" : "+v"(x) :: "memory")
#define LAUNDER_P(ptr) do { int _z = 0; LAUNDER_S(_z); ptr = (decltype(ptr))((const char*)(ptr) + _z); } while (0)
__device__ __forceinline__ Params load_params() {
#if defined(__HIP_DEVICE_COMPILE__)
    int z = 0; LAUNDER_S(z);
    const Params* kp = (const Params*)((const char*)(const void*)__builtin_amdgcn_kernarg_segment_ptr() + z);
    return *kp;
#else
    return Params{};
#endif
}
__device__ __forceinline__ int phase_tid() { int t = threadIdx.x; LAUNDER_V(t); return t; }
__device__ __forceinline__ unsigned char* phase_ws(const unsigned char* w) { int z = 0; LAUNDER_S(z); return (unsigned char*)w + z; }
__device__ __forceinline__ float wave_sum(float v) {
#pragma unroll
    for (int o = 32; o >= 1; o >>= 1) v += __shfl_xor(v, o);
    return v;
}
__device__ __forceinline__ int t5_bucket(int d) {
    const float x = (float)d * 0.0625f;
    int k = (int)(2.0f * __log2f(x) + 1e-4f);
    k = k > 15 ? 15 : k;
    return d < 16 ? d : 16 + k;
}
__device__ __forceinline__ unsigned f2ord(float f) { const unsigned u = __float_as_uint(f); return (u & 0x80000000u) ? ~u : (u | 0x80000000u); }
__device__ __forceinline__ float ord2f(unsigned k) { const unsigned u = (k & 0x80000000u) ? (k & 0x7FFFFFFFu) : ~k; return __uint_as_float(u); }
__device__ __forceinline__ float dot8(h8 a, h8 b, float acc) {
    acc = __builtin_amdgcn_fdot2((h2){a[0], a[1]}, (h2){b[0], b[1]}, acc, false);
    acc = __builtin_amdgcn_fdot2((h2){a[2], a[3]}, (h2){b[2], b[3]}, acc, false);
    acc = __builtin_amdgcn_fdot2((h2){a[4], a[5]}, (h2){b[4], b[5]}, acc, false);
    acc = __builtin_amdgcn_fdot2((h2){a[6], a[7]}, (h2){b[6], b[7]}, acc, false);
    return acc;
}
__device__ __forceinline__ unsigned pack_fp8x4(float a, float b, float c, float d) {
    int w = __builtin_amdgcn_cvt_pk_fp8_f32(a, b, 0, false);
    w = __builtin_amdgcn_cvt_pk_fp8_f32(c, d, w, true);
    return (unsigned)w;
}
#ifndef CHECKS
#define CHECKS 0
#endif
constexpr size_t WS_FLAG = 32768;
__device__ __forceinline__ float wave_max(float v) {
#pragma unroll
    for (int o = 32; o >= 1; o >>= 1) v = fmaxf(v, __shfl_xor(v, o));
    return v;
}
__device__ __forceinline__ float wave_min(float v) {
#pragma unroll
    for (int o = 32; o >= 1; o >>= 1) v = fminf(v, __shfl_xor(v, o));
    return v;
}
__device__ __forceinline__ int wave_sumi(int v) {
#pragma unroll
    for (int o = 32; o >= 1; o >>= 1) v += __shfl_xor(v, o);
    return v;
}
__device__ __forceinline__ void set_flag(unsigned char* ws, unsigned bit) { atomicOr((unsigned*)(ws + WS_FLAG), bit); }
template <int CTRL> __device__ __forceinline__ float dpp_f(float v) { return __int_as_float(__builtin_amdgcn_update_dpp(0, __float_as_int(v), CTRL, 0xF, 0xF, false)); }
typedef __fp16 fp16x2_t __attribute__((ext_vector_type(2)));
__device__ __forceinline__ h2 pkrtz2(float a, float b) { const fp16x2_t r = __builtin_amdgcn_cvt_pkrtz(a, b); h2 o; __builtin_memcpy(&o, &r, 4); return o; }
__device__ __forceinline__ float relu_i(float x) { const int b = __float_as_int(x); return __int_as_float(b > 0 ? b : 0); }
__device__ __forceinline__ float gelu_exact(float v) { return 0.5f * v * (1.0f + erff(v * 0.70710678118654752f)); }

namespace pg8 {
constexpr int BM = 256, BK = 64, HALF = 128, HTB = HALF * BK * 2, STAGE_BYTES = 8 * HTB, NXCD = 8, WGM = 8;
__host__ __device__ __forceinline__ int lds_byte(int r, int c) { const int st = (r >> 4) * 2 + (c >> 5), rr = r & 15, cc = c & 31, ob = rr * 64 + cc * 2; return st * 1024 + (ob ^ (((ob >> 9) & 1) << 5)); }
__host__ __device__ __forceinline__ void stage_rc(int b, int& R, int& C) { const int st = b / 1024, sb = b % 1024, swz = sb ^ (((sb >> 9) & 1) << 5); R = (st >> 1) * 16 + swz / 64; C = (st & 1) * 32 + (swz % 64) / 2; }
__host__ __device__ __forceinline__ int perm32(int rho) { const int n = rho >> 4, i = rho & 15; return 8 * (i >> 2) + 4 * n + (i & 3); }
struct Unit { int pm, pn; };
struct Gemm { const f16* A; const f16* Bt; int M, N, K; };
struct StaticOrder {
    int nM, nN, nwg, G, c;
    __device__ void init(int M, int N, int G_, int c_) { nM = M / BM; nN = N / BM; nwg = nM * nN; G = G_; c = c_; }
    __device__ bool next(int i, Unit& u) const {
        const long L = (long)i * G + c; if (L >= nwg) return false;
        int wgid = (int)L; { const int q = nwg / NXCD, r = nwg % NXCD, xcd = wgid % NXCD, off = wgid / NXCD; wgid = (xcd < r ? xcd * (q + 1) : r * (q + 1) + (xcd - r) * q) + off; }
        const int nig = WGM * nN, gid = wgid / nig, fm = gid * WGM, gsz = (nM - fm) < WGM ? (nM - fm) : WGM;
        u.pm = fm + ((wgid % nig) % gsz); u.pn = (wgid % nig) / gsz; return true;
    }
};

template <class Epi>
__device__ __forceinline__ void gemm_phase(LAS unsigned char* lds, const Gemm g, const StaticOrder& S_, const Epi& E) {
    const int tid = phase_tid(), wid = __builtin_amdgcn_readfirstlane(tid >> 6), lane = tid & 63, wr = wid >> 2, wc = wid & 3, fr = lane & 15, fq = lane >> 4;
    const int K = g.K, nt = K / BK;
    unsigned voffA[2], voffB[2];
#pragma unroll
    for (int i = 0; i < 2; ++i) { int R, C; stage_rc(tid * 16 + i * 8192, R, C); const int Rb = Epi::PERM ? ((R & ~31) + perm32(R & 31)) : R;
        voffA[i] = (unsigned)(R * K + C) * 2u; voffB[i] = (unsigned)(Rb * K + C) * 2u; }
    const size_t kstep = (size_t)(BK * 2);
    const size_t hstep = (size_t)HALF * K * 2;
    const size_t tstep = 2 * hstep;
    const unsigned ldsw = (unsigned)wid * 1024u;
    const int aoff = lds_byte(wr * 64 + fr, fq * 8), boff = lds_byte(wc * 32 + fr, fq * 8);
#define PG8_SA(b, h) (((b) * 2 + (h)) * HTB)
#define PG8_SB(b, h) ((4 + (b) * 2 + (h)) * HTB)
#define PG8_STAGE(bufoff, gbase, voff) do { _Pragma("unroll") for (int _i = 0; _i < 2; ++_i) \
        __builtin_amdgcn_global_load_lds((const unsigned*)((const char*)(gbase) + (voff)[_i]), (LAS unsigned*)(lds + (bufoff) + ldsw + _i * 8192), 16, 0, 0); } while (0)
#define PG8_LDA(dst, b, h) do { _Pragma("unroll") for (int m = 0; m < 4; ++m) _Pragma("unroll") for (int k = 0; k < 2; ++k) dst[m][k] = *(const LAS h8*)(lds + PG8_SA(b, h) + aoff + m * 2048 + k * 1024); } while (0)
#define PG8_LDB(dst, b, h) do { _Pragma("unroll") for (int n = 0; n < 2; ++n) _Pragma("unroll") for (int k = 0; k < 2; ++k) dst[n][k] = *(const LAS h8*)(lds + PG8_SB(b, h) + boff + n * 2048 + k * 1024); } while (0)
#define PG8_MMA(ai, bj, At, Bt) do { __builtin_amdgcn_s_setprio(1); _Pragma("unroll") for (int m = 0; m < 4; ++m) _Pragma("unroll") for (int n = 0; n < 2; ++n) _Pragma("unroll") for (int k = 0; k < 2; ++k) \
        acc[ai][bj][m][n] = __builtin_amdgcn_mfma_f32_16x16x32_f16(Bt[n][k], At[m][k], acc[ai][bj][m][n], 0, 0, 0); __builtin_amdgcn_s_setprio(0); } while (0)
#define PG8_WAIT_V(n) asm volatile("s_waitcnt vmcnt(" #n ")" ::: "memory")
#define PG8_WAIT_L(n) asm volatile("s_waitcnt lgkmcnt(" #n ")" ::: "memory")
#define PG8_BAR __builtin_amdgcn_s_barrier()
#define PG8_SCHED __builtin_amdgcn_sched_barrier(0)
    Unit cur, nxt; int ui = 0;
    if (!S_.next(0, cur)) return;
    f32x4 acc[2][2][4][2];
#pragma unroll
    for (int a = 0; a < 2; ++a)
#pragma unroll
        for (int b = 0; b < 2; ++b)
#pragma unroll
            for (int m = 0; m < 4; ++m)
#pragma unroll
                for (int n = 0; n < 2; ++n) acc[a][b][m][n] = (f32x4){0.f, 0.f, 0.f, 0.f};
    h8 At[4][2], B0[2][2], B1[2][2];
    const char* cA = (const char*)g.A + (size_t)cur.pm * tstep; const char* cB = (const char*)g.Bt + (size_t)cur.pn * tstep;
    PG8_STAGE(PG8_SB(0, 0), cB, voffB); PG8_STAGE(PG8_SA(0, 0), cA, voffA); PG8_STAGE(PG8_SB(0, 1), cB + hstep, voffB); PG8_STAGE(PG8_SA(0, 1), cA + hstep, voffA);
    if (wr == 1) PG8_BAR;
    PG8_WAIT_V(4); PG8_BAR;
    PG8_STAGE(PG8_SB(1, 0), cB + kstep, voffB); PG8_STAGE(PG8_SA(1, 0), cA + kstep, voffA); PG8_STAGE(PG8_SB(1, 1), cB + hstep + kstep, voffB);
    PG8_WAIT_V(6); PG8_BAR;
    for (;;) {
        const bool has_next = S_.next(ui + 1, nxt);
        const char* nA = has_next ? (const char*)g.A + (size_t)nxt.pm * tstep : cA; const char* nB = has_next ? (const char*)g.Bt + (size_t)nxt.pn * tstep : cB;
        for (int t = 0; t < nt; t += 2) {
            const bool last = (t == nt - 2);
            const char* a1 = cA + (size_t)(t + 1) * kstep;
            const char* a2 = last ? nA : cA + (size_t)(t + 2) * kstep; const char* b2 = last ? nB : cB + (size_t)(t + 2) * kstep;
            const char* a3 = a2 + kstep; const char* b3 = b2 + kstep;
            PG8_LDB(B0, 0, 0); PG8_SCHED; PG8_LDA(At, 0, 0); PG8_STAGE(PG8_SA(1, 1), a1 + hstep, voffA);
            PG8_WAIT_L(8); PG8_BAR; PG8_WAIT_L(0); PG8_MMA(0, 0, At, B0); PG8_BAR; PG8_SCHED;
            PG8_LDB(B1, 0, 1); PG8_STAGE(PG8_SB(0, 0), b2, voffB);
            PG8_BAR; PG8_WAIT_L(0); PG8_MMA(0, 1, At, B1); PG8_BAR;
            PG8_LDA(At, 0, 1); PG8_STAGE(PG8_SA(0, 0), a2, voffA);
            PG8_BAR; PG8_WAIT_L(0); PG8_MMA(1, 0, At, B0); PG8_BAR; PG8_SCHED;
            PG8_STAGE(PG8_SB(0, 1), b2 + hstep, voffB);
            PG8_WAIT_V(6); PG8_BAR; PG8_MMA(1, 1, At, B1); PG8_BAR;
            PG8_LDB(B0, 1, 0); PG8_SCHED; PG8_LDA(At, 1, 0); PG8_STAGE(PG8_SA(0, 1), a2 + hstep, voffA);
            PG8_WAIT_L(8); PG8_BAR; PG8_WAIT_L(0); PG8_MMA(0, 0, At, B0); PG8_BAR; PG8_SCHED;
            PG8_LDB(B1, 1, 1); PG8_STAGE(PG8_SB(1, 0), b3, voffB);
            PG8_BAR; PG8_WAIT_L(0); PG8_MMA(0, 1, At, B1); PG8_BAR;
            PG8_LDA(At, 1, 1); PG8_STAGE(PG8_SA(1, 0), a3, voffA);
            PG8_BAR; PG8_WAIT_L(0); PG8_MMA(1, 0, At, B0); PG8_BAR; PG8_SCHED;
            PG8_STAGE(PG8_SB(1, 1), b3 + hstep, voffB);
            PG8_WAIT_V(6); PG8_BAR; PG8_MMA(1, 1, At, B1); PG8_BAR;
        }
        E(acc, cur, wr, wc, fr, fq);
        if (!has_next) break;
#pragma unroll
        for (int a = 0; a < 2; ++a)
#pragma unroll
            for (int b = 0; b < 2; ++b)
#pragma unroll
                for (int m = 0; m < 4; ++m)
#pragma unroll
                    for (int n = 0; n < 2; ++n) acc[a][b][m][n] = (f32x4){0.f, 0.f, 0.f, 0.f};
        cur = nxt; cA = nA; cB = nB; ++ui;
    }
    PG8_WAIT_V(0);
    if (wr == 0) PG8_BAR;
    PG8_BAR;
#undef PG8_SA
#undef PG8_SB
#undef PG8_STAGE
#undef PG8_LDA
#undef PG8_LDB
#undef PG8_MMA
#undef PG8_WAIT_V
#undef PG8_WAIT_L
#undef PG8_BAR
#undef PG8_SCHED
}
}

struct EpiIn {
    static constexpr bool PERM = true;
    f16* QKV; f16* IQ; float* IKRAW; float* IW;
    __device__ __forceinline__ void operator()(const f32x4 (&acc)[2][2][4][2], const pg8::Unit& u, int wr, int wc, int fr, int fq) const {
#pragma unroll
        for (int bj = 0; bj < 2; ++bj) {
            const int cb = u.pn * 256 + bj * 128 + wc * 32;
            if (cb >= NPROJ) continue;
            const int c0 = cb + 8 * fq;
#pragma unroll
            for (int ai = 0; ai < 2; ++ai)
#pragma unroll
                for (int m = 0; m < 4; ++m) {
                    const int r = u.pm * 256 + ai * 128 + wr * 64 + m * 16 + fr;
                    const f32x4 v0 = acc[ai][bj][m][0], v1 = acc[ai][bj][m][1];
                    if (cb < 3072) {
                        const int g = cb >> 9, hh = (cb & 511) >> 6, d = (c0 & 63);
                        if (g >= 4) {
                            unsigned char* dst = (unsigned char*)(QKV + (size_t)4 * 8 * S * 64) + ((size_t)hh * S + r) * 128 + (g - 4) * 64 + d;
                            u32x2 o; o[0] = pack_fp8x4(v0[0] * DSA_KV_SCALE, v0[1] * DSA_KV_SCALE, v0[2] * DSA_KV_SCALE, v0[3] * DSA_KV_SCALE);
                            o[1] = pack_fp8x4(v1[0] * DSA_KV_SCALE, v1[1] * DSA_KV_SCALE, v1[2] * DSA_KV_SCALE, v1[3] * DSA_KV_SCALE);
                            *(u32x2*)dst = o;
                        } else if (g != 2) {
                            h8 o; o[0] = (f16)v0[0]; o[1] = (f16)v0[1]; o[2] = (f16)v0[2]; o[3] = (f16)v0[3]; o[4] = (f16)v1[0]; o[5] = (f16)v1[1]; o[6] = (f16)v1[2]; o[7] = (f16)v1[3];
                            *(h8*)(QKV + ((size_t)(g * 8 + hh) * S + r) * 64 + d) = o;
                        } else {
                            f16* base = QKV + ((size_t)(2 * 8 + hh) * 64 + d) * S + r;
#pragma unroll
                            for (int i = 0; i < 4; ++i) { base[(size_t)i * S] = (f16)v0[i]; base[(size_t)(i + 4) * S] = (f16)v1[i]; }
                        }
                    } else if (cb < 3328) {
                        h8 o; o[0] = (f16)v0[0]; o[1] = (f16)v0[1]; o[2] = (f16)v0[2]; o[3] = (f16)v0[3]; o[4] = (f16)v1[0]; o[5] = (f16)v1[1]; o[6] = (f16)v1[2]; o[7] = (f16)v1[3];
                        *(h8*)(IQ + (size_t)r * 256 + (c0 - 3072)) = o;
                    } else if (cb < 3392) {
                        float* dst = IKRAW + (size_t)r * 64 + (c0 - 3328);
                        *(f32x4*)dst = v0; *(f32x4*)(dst + 4) = v1;
                    } else {
                        if (fq == 0) *(f32x4*)(IW + (size_t)r * 4) = v0 * 0.5f;
                    }
                }
        }
    }
};
struct EpiOut {
    static constexpr bool PERM = false;
    const float* Xin; float* X1; const float* g1;
    __device__ __forceinline__ void operator()(const f32x4 (&acc)[2][2][4][2], const pg8::Unit& u, int wr, int wc, int fr, int fq) const {
#pragma unroll
        for (int bj = 0; bj < 2; ++bj)
#pragma unroll
            for (int n = 0; n < 2; ++n) {
                const int c = u.pn * 256 + bj * 128 + wc * 32 + 16 * n + 4 * fq;
                const f32x4 gv = *(const f32x4*)(g1 + c);
#pragma unroll
                for (int ai = 0; ai < 2; ++ai)
#pragma unroll
                    for (int m = 0; m < 4; ++m) {
                        const int r = u.pm * 256 + ai * 128 + wr * 64 + m * 16 + fr;
                        const f32x4 xv = *(const f32x4*)(Xin + (size_t)r * D + c);
                        *(f32x4*)(X1 + (size_t)r * D + c) = (DIAG == 1) ? xv : (xv + gv * acc[ai][bj][m][n]);
                    }
            }
    }
};
struct EpiPQ {
    static constexpr bool PERM = true;
    f16* PQ;
    __device__ __forceinline__ void operator()(const f32x4 (&acc)[2][2][4][2], const pg8::Unit& u, int wr, int wc, int fr, int fq) const {
#pragma unroll
        for (int bj = 0; bj < 2; ++bj) {
            const int c0 = u.pn * 256 + bj * 128 + wc * 32 + 8 * fq;
#pragma unroll
            for (int ai = 0; ai < 2; ++ai)
#pragma unroll
                for (int m = 0; m < 4; ++m) {
                    const int r = u.pm * 256 + ai * 128 + wr * 64 + m * 16 + fr;
                    const f32x4 v0 = acc[ai][bj][m][0], v1 = acc[ai][bj][m][1];
                    h8 o; o[0] = (f16)v0[0]; o[1] = (f16)v0[1]; o[2] = (f16)v0[2]; o[3] = (f16)v0[3]; o[4] = (f16)v1[0]; o[5] = (f16)v1[1]; o[6] = (f16)v1[2]; o[7] = (f16)v1[3];
                    *(h8*)(PQ + (size_t)r * NQ + c0) = o;
                }
        }
    }
};

__device__ __forceinline__ void transpose_tile(const float* __restrict__ src, int K, int N, f16* __restrict__ dst, int k0, int n0, LAS f16* tile) {
    const int tid = phase_tid();
    { const int kk = tid >> 4, n4 = (tid & 15) * 4;
#pragma unroll
      for (int p = 0; p < 2; ++p) { const int k = k0 + kk + 32 * p, n = n0 + n4;
          f32x4 v = (f32x4){0.f, 0.f, 0.f, 0.f}; if (n < N) v = *(const f32x4*)(src + (size_t)k * N + n);
#pragma unroll
          for (int i = 0; i < 4; ++i) tile[(n4 + i) * 72 + kk + 32 * p] = (f16)v[i]; } }
    __syncthreads();
    { const int nn = tid >> 3, k8 = (tid & 7) * 8;
      const h8 v = *(const LAS h8*)(tile + nn * 72 + k8);
      *(h8*)(dst + (size_t)(n0 + nn) * K + k0 + k8) = v; }
    __syncthreads();
}
__device__ __forceinline__ void convert_chunk(const float* __restrict__ src, f16* __restrict__ dst, size_t base, int ptid) {
    const size_t o = base + (size_t)ptid * 8;
    const f32x4 a = *(const f32x4*)(src + o), b = *(const f32x4*)(src + o + 4);
    h8 v; v[0] = (f16)a[0]; v[1] = (f16)a[1]; v[2] = (f16)a[2]; v[3] = (f16)a[3]; v[4] = (f16)b[0]; v[5] = (f16)b[1]; v[6] = (f16)b[2]; v[7] = (f16)b[3];
    *(h8*)(dst + o) = v;
}
__device__ __forceinline__ void convert_chunk_fp8(const float* __restrict__ src, unsigned char* __restrict__ dst, size_t base, int ptid, float scale) {
    f32x4 a[4], b[4];
#pragma unroll
    for (int c = 0; c < 4; ++c) { const size_t o = base + (size_t)c * 4096 + (size_t)ptid * 8; a[c] = __builtin_nontemporal_load((const f32x4*)(src + o)); b[c] = __builtin_nontemporal_load((const f32x4*)(src + o + 4)); }
#pragma unroll
    for (int c = 0; c < 4; ++c) { const size_t o = base + (size_t)c * 4096 + (size_t)ptid * 8; const f32x4 x = a[c] * scale, y = b[c] * scale;
        u32x2 v; v[0] = pack_fp8x4(x[0], x[1], x[2], x[3]); v[1] = pack_fp8x4(y[0], y[1], y[2], y[3]);
        *(u32x2*)(dst + o) = v; }
}
__device__ __forceinline__ void phase_prologue(const Params& p_, LAS unsigned char* lds) {
    const Params p = load_params(); (void)p_;
    unsigned char* ws = phase_ws(p.ws); const int ptid = phase_tid();
    const int G = gridDim.x;
    constexpr int N_TR = 2 * 1664, N_SUBK = 128, N_UV = 2048, N_MOD = 192;
    constexpr int TOTAL = N_TR + N_SUBK + 2 * N_UV + N_MOD;
    for (int it = blockIdx.x; it < TOTAL; it += G) {
        if (it < N_MOD) {
            const int kc = it / 24, cg = it % 24, e = cg * 512 + ptid, l = e / 6144, ee = e % 6144;
            float acc = 0.f;
#pragma unroll 16
            for (int d = kc * 128; d < kc * 128 + 128; ++d) { const float cv = p.c[d]; const float sv = cv / (1.0f + __expf(-cv)); acc += sv * p.w_ada[((size_t)l * D + d) * 6144 + ee]; }
            ((float*)(ws + WS_MODP))[kc * 12288 + e] = acc;
        } else if (it < N_MOD + N_TR) {
            int j = it - N_MOD; const int l = j / 1664; j %= 1664;
            if (j < 896) { const int kt = j / 56, ntile = j % 56; transpose_tile(p.w_in + (size_t)l * D * NPROJ, D, NPROJ, (f16*)(ws + WS_WIN) + (size_t)l * NPAD * D, kt * 64, ntile * 64, (LAS f16*)lds); }
            else if (j < 896 + 256) { j -= 896; const int kt = j / 16, ntile = j % 16; transpose_tile(p.w_out + (size_t)l * D * D, D, D, (f16*)(ws + WS_WOUT) + (size_t)l * D * D, kt * 64, ntile * 64, (LAS f16*)lds); }
            else { j -= 1152; const int kt = j / 32, ntile = j % 32; transpose_tile(p.peer_wq + (size_t)l * D * NQ, D, NQ, (f16*)(ws + WS_WQ) + (size_t)l * NQ * D, kt * 64, ntile * 64, (LAS f16*)lds); }
        } else if (it < N_MOD + N_TR + N_SUBK) {
            convert_chunk(p.peer_subkeys, (f16*)(ws + WS_SUBK), (size_t)(it - N_MOD - N_TR) * 4096, ptid);
        } else if (it < N_MOD + N_TR + N_SUBK + N_UV) {
            convert_chunk_fp8(p.peer_u, ws + WS_U16, (size_t)(it - N_MOD - N_TR - N_SUBK) * 16384, ptid, PEER_U_SCALE);
        } else {
            convert_chunk_fp8(p.peer_v, ws + WS_V16, (size_t)(it - N_MOD - N_TR - N_SUBK - N_UV) * 16384, ptid, PEER_V_SCALE);
        }
    }
}
__device__ __forceinline__ float modv_partial(const Params& p, int e) {
    const float* mp = (const float*)(p.ws + WS_MODP);
    float v = p.b_ada[e];
#pragma unroll
    for (int kc = 0; kc < 8; ++kc) v += mp[kc * 12288 + e];
    return v;
}

template <bool FROM_PARTIAL>
__device__ __forceinline__ void phase_norm(const Params& p_, LAS unsigned char* lds, int l, int which) {
    const Params p = load_params(); (void)p_;
    const int shc = which ? 3 : 0, scc = which ? 4 : 1;
    LAS float* sh = (LAS float*)lds; LAS float* sc = sh + 1024; LAS float* nwl = sc + 1024;
    unsigned char* ws = phase_ws(p.ws); const int ptid = phase_tid();
    const float* X = which ? (const float*)(ws + WS_X1) : p.x; const float* nw = (which ? p.norm_ffn : p.norm_attn) + l * 1024;
    float* MOD = (float*)(ws + WS_MOD);
    if (FROM_PARTIAL) {
        for (int e = blockIdx.x * NTHREADS + ptid; e < 12288; e += gridDim.x * NTHREADS) MOD[e] = modv_partial(p, e);
        for (int i = ptid; i < 1024; i += NTHREADS) { sh[i] = modv_partial(p, l * 6144 + shc * 1024 + i); sc[i] = modv_partial(p, l * 6144 + scc * 1024 + i); nwl[i] = nw[i]; }
    } else {
        for (int i = ptid; i < 1024; i += NTHREADS) { sh[i] = MOD[l * 6144 + shc * 1024 + i]; sc[i] = MOD[l * 6144 + scc * 1024 + i]; nwl[i] = nw[i]; }
    }
    __syncthreads();
    f16* H = (f16*)(ws + WS_H);
    const int lane = ptid & 63, gw = blockIdx.x * NWAVES + (ptid >> 6);
    for (int t = gw; t < S; t += gridDim.x * NWAVES) {
        f32x4 v[4]; float ss = 0.f;
#pragma unroll
        for (int i = 0; i < 4; ++i) { v[i] = *(const f32x4*)(X + (size_t)t * D + 256 * i + 4 * lane); ss += v[i][0] * v[i][0] + v[i][1] * v[i][1] + v[i][2] * v[i][2] + v[i][3] * v[i][3]; }
        ss = wave_sum(ss);
        const float r = rsqrtf(ss * (1.0f / D) + EPS);
#pragma unroll
        for (int i = 0; i < 4; ++i) { const int c = 256 * i + 4 * lane; h4 o;
#pragma unroll
            for (int j = 0; j < 4; ++j) o[j] = (f16)((v[i][j] * r * nwl[c + j]) * (1.0f + sc[c + j]) + sh[c + j]);
            *(h4*)(H + (size_t)t * D + c) = o; }
    }
    __syncthreads();
}

__device__ __forceinline__ void phase_prep(const Params& p_, LAS unsigned char* lds) {
    const Params p = load_params(); (void)p_;
    unsigned char* ws = phase_ws(p.ws); const int ptid = phase_tid();
    const int lane = ptid & 63, wave = ptid >> 6, gw = blockIdx.x * NWAVES + wave;
    const float* IKRAW = (const float*)(ws + WS_IKRAW); f16* KN = (f16*)(ws + WS_KN);
    for (int t = gw; t < S; t += gridDim.x * NWAVES) {
        const float v = IKRAW[(size_t)t * 64 + lane];
        const float ss = wave_sum(v * v);
        KN[(size_t)t * 64 + lane] = (f16)(v * rsqrtf(ss * (1.0f / 64) + EPS));
    }
    const f16* MK = (const f16*)(ws + WS_QKV) + (size_t)1 * 8 * S * 64;
    float* KMEAN = (float*)(ws + WS_KMEAN);
    LAS float* red = (LAS float*)lds;
    for (int it = blockIdx.x; it < 512; it += gridDim.x) {
        const int h = it >> 6, j = it & 63;
        const f16* base = MK + ((size_t)h * S + (size_t)j * 256 + wave * 32) * 64 + lane;
        float a = 0.f;
        for (int r = 0; r < 32; ++r) a += (float)base[(size_t)r * 64];
        red[wave * 64 + lane] = a;
        __syncthreads();
        if (wave == 0) { float s = 0.f;
#pragma unroll
            for (int w = 0; w < 8; ++w) s += red[w * 64 + lane];
            KMEAN[(size_t)it * 64 + lane] = s * (1.0f / 256.0f); }
        __syncthreads();
    }
}

__device__ __forceinline__ void phase_gate(const Params& p_, LAS unsigned char* lds, int layer, bool dry = false) {
    const Params p = load_params(); (void)p_;
    unsigned char* ws = phase_ws(p.ws); const int ptid = phase_tid();
    const f16* MQ = (const f16*)(ws + WS_QKV);
    const float* KMEAN = (const float*)(ws + WS_KMEAN);
    int* SEL = (int*)(ws + WS_SEL);
    unsigned* LCNT = (unsigned*)(ws + WS_LCNT) + layer * 512;
    u16* LIST = (u16*)(ws + WS_LIST);
    LAS float* km = (LAS float*)lds;
    for (int it = blockIdx.x; it < 256; it += gridDim.x) {
        const int h = it >> 5, t = (it & 31) * 512 + ptid, b0 = t >> 8;
        __syncthreads();
        for (int i = ptid; i < 4096; i += NTHREADS) km[i] = KMEAN[(size_t)h * 4096 + i];
        __syncthreads();
        float q[64];
        { const f16* qp = MQ + ((size_t)h * S + t) * 64;
#pragma unroll
          for (int i = 0; i < 8; ++i) { const h8 v = *(const h8*)(qp + 8 * i);
#pragma unroll
              for (int j = 0; j < 8; ++j) q[8 * i + j] = (float)v[j]; } }
        float v0 = -INFINITY, v1 = -INFINITY, v2 = -INFINITY; int s0 = -1, s1 = -1, s2 = -1;
        const int b0u = __builtin_amdgcn_readfirstlane(b0);
        for (int n = 0; n < b0u; ++n) {
            float g = 0.f;
#pragma unroll
            for (int d4 = 0; d4 < 16; ++d4) { const f32x4 kv = *(const LAS f32x4*)(km + n * 64 + 4 * d4);
                g += q[4 * d4] * kv[0]; g += q[4 * d4 + 1] * kv[1]; g += q[4 * d4 + 2] * kv[2]; g += q[4 * d4 + 3] * kv[3]; }
            if (g > v0) { v2 = v1; s2 = s1; v1 = v0; s1 = s0; v0 = g; s0 = n; }
            else if (g > v1) { v2 = v1; s2 = s1; v1 = g; s1 = n; }
            else if (g > v2) { v2 = g; s2 = n; }
        }
        if (dry) { if (s0 == 12345) SEL[0] = 0; continue; }
        SEL[(size_t)h * S + t] = (s0 & 0xFF) | ((s1 & 0xFF) << 8) | ((s2 & 0xFF) << 16);
        if (s0 >= 0) { const unsigned pos = atomicAdd(&LCNT[h * 64 + s0], 1u); LIST[((size_t)(h * 64 + s0)) * S + pos] = (u16)(t | (0 << 14)); }
        if (s1 >= 0) { const unsigned pos = atomicAdd(&LCNT[h * 64 + s1], 1u); LIST[((size_t)(h * 64 + s1)) * S + pos] = (u16)(t | (1 << 14)); }
        if (s2 >= 0) { const unsigned pos = atomicAdd(&LCNT[h * 64 + s2], 1u); LIST[((size_t)(h * 64 + s2)) * S + pos] = (u16)(t | (2 << 14)); }
    }
    __syncthreads();
}

constexpr int TK_CAP = 1280, TK_TRIG = 1024, TK_K = 256, TK_E = TK_CAP / 64;
template <int E>
__device__ __forceinline__ void topk_compact(LAS float* val, LAS u16* idx, LAS unsigned* cnt, LAS float* tau, int lane, const int K = TK_K) {
    const int n = (int)*cnt;
    unsigned key[E]; unsigned id[E];
    unsigned kmin = 0xFFFFFFFFu, kmax = 0u;
    float vraw[E]; unsigned iraw[E];
#pragma unroll
    for (int i = 0; i < E; ++i) { vraw[i] = val[lane + 64 * i]; iraw[i] = (unsigned)idx[lane + 64 * i]; }
#pragma unroll
    for (int i = 0; i < E; ++i) { const int e = lane + 64 * i; const bool ok = e < n; key[i] = ok ? f2ord(vraw[i]) : 0u; id[i] = ok ? iraw[i] : 0xFFFFu;
        kmax = key[i] > kmax ? key[i] : kmax; const unsigned km = ok ? key[i] : 0xFFFFFFFFu; kmin = km < kmin ? km : kmin; }
#pragma unroll
    for (int o = 32; o >= 1; o >>= 1) { const unsigned a = (unsigned)__shfl_xor((int)kmax, o), b = (unsigned)__shfl_xor((int)kmin, o); kmax = a > kmax ? a : kmax; kmin = b < kmin ? b : kmin; }
    unsigned lo = kmin, hi = kmax + 1u;
    while (hi - lo > 1u) {
        const unsigned mid = lo + ((hi - lo) >> 1);
        int c = 0;
#pragma unroll
        for (int i = 0; i < E; ++i) c += __popcll(__ballot(key[i] >= mid));
        if (c >= K) lo = mid; else hi = mid;
    }
    const unsigned vstar = lo;
    int cgt = 0, ceq = 0;
#pragma unroll
    for (int i = 0; i < E; ++i) { cgt += __popcll(__ballot(key[i] > vstar)); ceq += __popcll(__ballot(key[i] == vstar)); }
    const int r = K - cgt;
    unsigned istar = 0xFFFFu;
    if (ceq > r) {
        unsigned ilo = 0u, ihi = 0xFFFFu;
        while (ilo < ihi) {
            const unsigned mid = (ilo + ihi) >> 1;
            int c = 0;
#pragma unroll
            for (int i = 0; i < E; ++i) c += __popcll(__ballot(key[i] == vstar && id[i] <= mid));
            if (c >= r) ihi = mid; else ilo = mid + 1u;
        }
        istar = ilo;
    }
    int base = 0;
    const unsigned long long lt = (1ull << lane) - 1ull;
#pragma unroll
    for (int i = 0; i < E; ++i) {
        const bool keep = key[i] > vstar || (key[i] == vstar && id[i] <= istar);
        const unsigned long long bal = __ballot(keep);
        if (keep) { const int pos = base + __popcll(bal & lt); val[pos] = ord2f(key[i]); idx[pos] = (u16)id[i]; }
        base += __popcll(bal);
    }
    if (lane == 0) { *cnt = (unsigned)base; *tau = ord2f(vstar); }
}
__device__ __forceinline__ int topk_compact_approx(LAS float* val, LAS u16* idx, LAS unsigned* cnt, LAS float* tau, LAS unsigned* hist, int lane, const int K = TK_K) {
    const int n = (int)*cnt;
    unsigned key[TK_E]; unsigned id[TK_E];
    unsigned kmin = 0xFFFFFFFFu, kmax = 0u;
    float vraw[TK_E]; unsigned iraw[TK_E];
#pragma unroll
    for (int i = 0; i < TK_E; ++i) { vraw[i] = val[lane + 64 * i]; iraw[i] = (unsigned)idx[lane + 64 * i]; }
#pragma unroll
    for (int i = 0; i < TK_E; ++i) { const int e = lane + 64 * i; const bool ok = e < n; key[i] = ok ? f2ord(vraw[i]) : 0u; id[i] = ok ? iraw[i] : 0xFFFFu;
        kmax = key[i] > kmax ? key[i] : kmax; const unsigned km = ok ? key[i] : 0xFFFFFFFFu; kmin = km < kmin ? km : kmin; }
#pragma unroll
    for (int o = 32; o >= 1; o >>= 1) { const unsigned a = (unsigned)__shfl_xor((int)kmax, o), b = (unsigned)__shfl_xor((int)kmin, o); kmax = a > kmax ? a : kmax; kmin = b < kmin ? b : kmin; }
    const unsigned R = kmax - kmin;
    const int sh = (R >> 8) ? (32 - __clz((int)(R >> 8))) : 0;
#pragma unroll
    for (int j = 0; j < 4; ++j) hist[4 * lane + j] = 0u;
    __builtin_amdgcn_wave_barrier();
#pragma unroll
    for (int i = 0; i < TK_E; ++i) if (lane + 64 * i < n) __hip_atomic_fetch_add(&hist[(key[i] - kmin) >> sh], 1u, __ATOMIC_RELAXED, __HIP_MEMORY_SCOPE_WORKGROUP);
    __builtin_amdgcn_wave_barrier();
    unsigned hb[4];
#pragma unroll
    for (int j = 0; j < 4; ++j) hb[j] = hist[4 * lane + j];
    unsigned lsum = hb[0] + hb[1] + hb[2] + hb[3];
    unsigned above = lsum;
#pragma unroll
    for (int o = 1; o < 64; o <<= 1) { const unsigned v = (unsigned)__shfl_down((int)above, o); if (lane + o < 64) above += v; }
    const unsigned excl = above - lsum;
    unsigned sfx[4];
    sfx[3] = excl + hb[3]; sfx[2] = sfx[3] + hb[2]; sfx[1] = sfx[2] + hb[1]; sfx[0] = sfx[1] + hb[0];
    int mybin = -1;
#pragma unroll
    for (int j = 0; j < 4; ++j) if (sfx[j] >= (unsigned)K) mybin = 4 * lane + j;
    int b = mybin;
#pragma unroll
    for (int o = 32; o >= 1; o >>= 1) { const int v = __shfl_xor(b, o); b = v > b ? v : b; }
    const unsigned edge = kmin + ((unsigned)b << sh);
    int base = 0;
    const unsigned long long lt = (1ull << lane) - 1ull;
#pragma unroll
    for (int i = 0; i < TK_E; ++i) {
        const bool keep = key[i] >= edge && (lane + 64 * i < n);
        const unsigned long long bal = __ballot(keep);
        if (keep) { const int pos = base + __popcll(bal & lt); val[pos] = ord2f(key[i]); idx[pos] = (u16)id[i]; }
        base += __popcll(bal);
    }
    if (lane == 0) { *cnt = (unsigned)base; *tau = ord2f(edge - 1u); }
    return base;
}
__device__ __forceinline__ void phase_topk(const Params& p_, LAS unsigned char* lds, int layer) {
    const Params p = load_params(); (void)p_;
    unsigned char* ws = phase_ws(p.ws); const int ptid = phase_tid();
    const f16* IQ = (const f16*)(ws + WS_IQ); const f16* KN = (const f16*)(ws + WS_KN); const float* IW = (const float*)(ws + WS_IW);
    u16* IDX = (u16*)(ws + WS_IDX); int* NIDX = (int*)(ws + WS_NIDX);
    LAS float* val = (LAS float*)lds;
    LAS u16* idx = (LAS u16*)(lds + 16 * TK_CAP * 4);
    LAS unsigned* cnt = (LAS unsigned*)(lds + 16 * TK_CAP * 6);
    LAS float* tau = (LAS float*)(lds + 16 * TK_CAP * 6 + 64);
    LAS unsigned* flg = (LAS unsigned*)(lds + 16 * TK_CAP * 6 + 128);
    LAS unsigned* hist = (LAS unsigned*)(lds + 16 * TK_CAP * 6 + 1024) + 256 * (ptid >> 6);
    static_assert(16 * TK_CAP * 6 + 1024 + 8 * 1024 <= LDS_BYTES - 16, "topk LDS");
    LAS unsigned* specd = (LAS unsigned*)(lds + 16 * TK_CAP * 6 + 256);
    LAS unsigned* failq = (LAS unsigned*)(lds + 16 * TK_CAP * 6 + 320);
    const int tid = ptid, lane = tid & 63, wave = __builtin_amdgcn_readfirstlane(tid >> 6), half = lane >> 5, l31 = lane & 31;
    unsigned* tctr = (unsigned*)(ws + WS_CTL + 41472) + layer;
    LAS int* tsl = (LAS int*)(lds + 16 * TK_CAP * 6 + 512);
    for (;;) {
        __syncthreads();
        if (tid == 0) tsl[0] = (int)__hip_atomic_fetch_add(tctr, 1u, __ATOMIC_RELAXED, __HIP_MEMORY_SCOPE_AGENT);
        __syncthreads();
        const int ti = tsl[0];
        if (ti >= 1024) break;
        const int tile = 1023 - ti;
        const int t0 = tile * 16;
        __syncthreads();
        if (tid < 16) { cnt[tid] = 0u; tau[tid] = -INFINITY; specd[tid] = 0u; failq[tid] = 0u; }
        if (tid == 16) failq[16] = 0u;
        if (tid < 3) flg[tid] = 0u;
        h8 a[2][4];
#pragma unroll
        for (int mt = 0; mt < 2; ++mt)
#pragma unroll
            for (int kk = 0; kk < 4; ++kk) a[mt][kk] = *(const h8*)(IQ + (size_t)(t0 + mt * 8 + (l31 >> 2)) * 256 + (l31 & 3) * 64 + 16 * kk + 8 * half);
        float wq[2][4][4];
#pragma unroll
        for (int mt = 0; mt < 2; ++mt)
#pragma unroll
            for (int j = 0; j < 4; ++j) { const f32x4 w = *(const f32x4*)(IW + (size_t)(t0 + mt * 8 + 2 * j + half) * 4);
                wq[mt][j][0] = w[0]; wq[mt][j][1] = w[1]; wq[mt][j][2] = w[2]; wq[mt][j][3] = w[3]; }
        const int nkt = (t0 + 15) / 256 + 1;
        for (int pass = 0; pass < 2; ++pass) {
        if (pass == 1) {
            __syncthreads();
            if (failq[16] == 0u) break;
            __syncthreads();
            if (tid < 16) { const bool f = failq[tid] != 0u; cnt[tid] = 0u; tau[tid] = f ? -INFINITY : INFINITY; }
            if (tid < 3) flg[tid] = 0u;
        }
        h8 bnx[4];
#pragma unroll
        for (int kk = 0; kk < 4; ++kk) bnx[kk] = *(const h8*)(KN + (size_t)(32 * wave + l31) * 64 + 16 * kk + 8 * half);
        __syncthreads();
        int par = 0;
        for (int kt = 0; kt < nkt; ++kt) {
            const int kb = kt * 256 + 32 * wave;
            const int s = kb + l31;
            h8 bfr[4];
#pragma unroll
            for (int kk = 0; kk < 4; ++kk) bfr[kk] = bnx[kk];
            if (kt + 1 < nkt) {
#pragma unroll
                for (int kk = 0; kk < 4; ++kk) bnx[kk] = *(const h8*)(KN + (size_t)(s + 256) * 64 + 16 * kk + 8 * half);
            }
            float tq[2][4];
#pragma unroll
            for (int mt = 0; mt < 2; ++mt)
#pragma unroll
                for (int j = 0; j < 4; ++j) tq[mt][j] = tau[mt * 8 + 2 * j + half];
            f32x16 acc[2];
#pragma unroll
            for (int mt = 0; mt < 2; ++mt) { acc[mt] = (f32x16){0.f,0.f,0.f,0.f,0.f,0.f,0.f,0.f,0.f,0.f,0.f,0.f,0.f,0.f,0.f,0.f};
#pragma unroll
                for (int kk = 0; kk < 4; ++kk) acc[mt] = __builtin_amdgcn_mfma_f32_32x32x16_f16(a[mt][kk], bfr[kk], acc[mt], 0, 0, 0); }
            bool trig = false;
            float Iv[2][4]; bool okv[2][4]; bool anyok = false;
#pragma unroll
            for (int mt = 0; mt < 2; ++mt)
#pragma unroll
                for (int j = 0; j < 4; ++j) {
                    const int q = mt * 8 + 2 * j + half;
                    float I = __builtin_fmaf(wq[mt][j][0], relu_i(acc[mt][4 * j]), 0.0f);
                    I = __builtin_fmaf(wq[mt][j][1], relu_i(acc[mt][4 * j + 1]), I);
                    I = __builtin_fmaf(wq[mt][j][2], relu_i(acc[mt][4 * j + 2]), I);
                    I = __builtin_fmaf(wq[mt][j][3], relu_i(acc[mt][4 * j + 3]), I);
                    Iv[mt][j] = I; okv[mt][j] = (s <= t0 + q) && (I > tq[mt][j]); anyok = anyok || okv[mt][j];
                }
            if (__any(anyok)) {
                unsigned hcnt[2][4]; unsigned rank[2][4];
                const unsigned long long hm = half ? 0xFFFFFFFF00000000ull : 0x00000000FFFFFFFFull;
                const unsigned long long ltm = (1ull << lane) - 1ull;
#pragma unroll
                for (int mt = 0; mt < 2; ++mt)
#pragma unroll
                    for (int j = 0; j < 4; ++j) { const unsigned long long bal = __ballot(okv[mt][j]) & hm; hcnt[mt][j] = (unsigned)__popcll(bal); rank[mt][j] = (unsigned)__popcll(bal & ltm); }
                unsigned base[2][4];
#pragma unroll
                for (int mt = 0; mt < 2; ++mt)
#pragma unroll
                    for (int j = 0; j < 4; ++j) base[mt][j] = 0u;
                if (l31 == 0) {
#pragma unroll
                    for (int mt = 0; mt < 2; ++mt)
#pragma unroll
                        for (int j = 0; j < 4; ++j) base[mt][j] = __hip_atomic_fetch_add(&cnt[mt * 8 + 2 * j + half], hcnt[mt][j], __ATOMIC_RELAXED, __HIP_MEMORY_SCOPE_WORKGROUP);
                }
#pragma unroll
                for (int mt = 0; mt < 2; ++mt)
#pragma unroll
                    for (int j = 0; j < 4; ++j) {
                        const unsigned b0 = (unsigned)__shfl((int)base[mt][j], lane & 32);
                        if (okv[mt][j]) { const int q = mt * 8 + 2 * j + half; const unsigned pos = b0 + rank[mt][j];
                            val[q * TK_CAP + pos] = Iv[mt][j]; idx[q * TK_CAP + pos] = (u16)s; trig = trig || (pos >= (unsigned)TK_TRIG); }
                    }
            }
            if (trig) flg[par] = 1u;
            const int parn = (par == 2) ? 0 : par + 1;
            if (tid == 0) flg[parn] = 0u;
            __syncthreads();
            const unsigned need = flg[par];
            par = parn;
            if (need) {
#pragma unroll 1
                for (int qq = 0; qq < 2; ++qq) { const int q = 2 * wave + qq;
                    if (cnt[q] > 352u) {
                        const int Nq = t0 + q + 1; int seen = 256 * (kt + 1); seen = seen < Nq ? seen : Nq;
                        int K = TK_K;
                        if (pass == 0 && Nq > 3072) { K = (768 * seen + Nq - 1) / Nq; K = K < 32 ? 32 : (K > TK_K ? TK_K : K); }
                        if (K < TK_K && lane == 0) specd[q] = 1u;
                        const int c2 = topk_compact_approx(val + q * TK_CAP, idx + q * TK_CAP, cnt + q, tau + q, hist, lane, K);
                        if (c2 > TK_TRIG) topk_compact<TK_E>(val + q * TK_CAP, idx + q * TK_CAP, cnt + q, tau + q, lane, K); } }
                __syncthreads();
            }
        }
        {
#pragma unroll 1
        for (int qq = 0; qq < 2; ++qq) { const int q = 2 * wave + qq;
            if (pass == 1 && failq[q] == 0u) continue;
            { const int Nq = t0 + q + 1; const int needc = Nq < TK_K ? Nq : TK_K;
              if (pass == 0 && ((specd[q] != 0u && (int)cnt[q] < needc) || (FORCE_FAIL && ((t0 + q) % 5) == 0))) { if (lane == 0) { failq[q] = 1u; failq[16] = 1u; } continue; } }
            if (cnt[q] > (unsigned)TK_K) {
                int c2 = (int)cnt[q];
                if (c2 > 320) c2 = topk_compact_approx(val + q * TK_CAP, idx + q * TK_CAP, cnt + q, tau + q, hist, lane);
                if (c2 > 320) topk_compact<TK_E>(val + q * TK_CAP, idx + q * TK_CAP, cnt + q, tau + q, lane);
                else if (c2 > TK_K) topk_compact<5>(val + q * TK_CAP, idx + q * TK_CAP, cnt + q, tau + q, lane);
            }
            const int n = (int)cnt[q];
            {
                LAS unsigned* bm = (LAS unsigned*)(val + q * TK_CAP);
                __builtin_amdgcn_wave_barrier();
#pragma unroll
                for (int k = 0; k < 8; ++k) bm[lane * 8 + k] = 0u;
                __builtin_amdgcn_wave_barrier();
                for (int e = lane; e < n; e += 64) { const unsigned id = idx[q * TK_CAP + e]; __hip_atomic_fetch_or(&bm[id >> 5], 1u << (id & 31u), __ATOMIC_RELAXED, __HIP_MEMORY_SCOPE_WORKGROUP); }
                __builtin_amdgcn_wave_barrier();
                int cl = 0;
#pragma unroll
                for (int k = 0; k < 8; ++k) cl += __popc(bm[lane * 8 + k]);
                int incl = cl;
#pragma unroll
                for (int o = 1; o < 64; o <<= 1) { const int v = __shfl_up(incl, o); if (lane >= o) incl += v; }
                int pos = incl - cl;
                LAS u16* sl = idx + q * TK_CAP;
#pragma unroll 1
                for (int k = 0; k < 8; ++k) { unsigned w = bm[lane * 8 + k];
                    while (w) { const int b = __ffs((int)w) - 1; sl[pos++] = (u16)((lane * 8 + k) * 32 + b); w &= w - 1u; } }
                __builtin_amdgcn_wave_barrier();
                for (int e = n + lane; e < TK_K; e += 64) sl[e] = (u16)0;
                __builtin_amdgcn_wave_barrier();
                *(u32x2*)(IDX + (size_t)(t0 + q) * TK_K + 4 * lane) = *(const LAS u32x2*)(sl + 4 * lane);
            }
            if (lane == 0) NIDX[t0 + q] = n; }
        }
        }
    }
    __syncthreads();
}

template <bool causal>
__device__ __forceinline__ void moba_block(const f16* __restrict__ Qh, const f16* __restrict__ Kh, const f16* __restrict__ VTh, int tq, int keybase, int ntiles,
                                           const LAS float* tab, const LAS unsigned char* blut, f32x16 (&o)[2], float& m, float& l, int lane) {
    const int half = lane >> 5, l31 = lane & 31;
    h8 qf[4];
#pragma unroll
    for (int kk = 0; kk < 4; ++kk) qf[kk] = *(const h8*)(Qh + (size_t)tq * 64 + 16 * kk + 8 * half);
    m = -INFINITY; l = 0.f;
#pragma unroll
    for (int mt = 0; mt < 2; ++mt) o[mt] = (f32x16){0.f,0.f,0.f,0.f,0.f,0.f,0.f,0.f,0.f,0.f,0.f,0.f,0.f,0.f,0.f,0.f};
    h8 kn[4]; h4 vnl[2][2], vnh[2][2];
    {
        const int kb = keybase;
#pragma unroll
        for (int kk = 0; kk < 4; ++kk) kn[kk] = *(const h8*)(Kh + (size_t)(kb + l31) * 64 + 16 * kk + 8 * half);
#pragma unroll
        for (int s2 = 0; s2 < 2; ++s2)
#pragma unroll
            for (int mt = 0; mt < 2; ++mt) { const f16* vp = VTh + (size_t)(32 * mt + l31) * S + kb + 16 * s2 + 4 * half; vnl[s2][mt] = *(const h4*)vp; vnh[s2][mt] = *(const h4*)(vp + 8); }
    }
    for (int kt = 0; kt < ntiles; ++kt) {
        const int kb = keybase + 32 * kt;
        h8 kf[4]; h4 vl[2][2], vh[2][2];
#pragma unroll
        for (int kk = 0; kk < 4; ++kk) kf[kk] = kn[kk];
#pragma unroll
        for (int s2 = 0; s2 < 2; ++s2)
#pragma unroll
            for (int mt = 0; mt < 2; ++mt) { vl[s2][mt] = vnl[s2][mt]; vh[s2][mt] = vnh[s2][mt]; }
        if (kt + 1 < ntiles) {
            const int kb2 = kb + 32;
#pragma unroll
            for (int kk = 0; kk < 4; ++kk) kn[kk] = *(const h8*)(Kh + (size_t)(kb2 + l31) * 64 + 16 * kk + 8 * half);
#pragma unroll
            for (int s2 = 0; s2 < 2; ++s2)
#pragma unroll
                for (int mt = 0; mt < 2; ++mt) { const f16* vp = VTh + (size_t)(32 * mt + l31) * S + kb2 + 16 * s2 + 4 * half; vnl[s2][mt] = *(const h4*)vp; vnh[s2][mt] = *(const h4*)(vp + 8); }
        }
        f32x16 s = (f32x16){0.f,0.f,0.f,0.f,0.f,0.f,0.f,0.f,0.f,0.f,0.f,0.f,0.f,0.f,0.f,0.f};
#pragma unroll
        for (int kk = 0; kk < 4; ++kk) s = __builtin_amdgcn_mfma_f32_32x32x16_f16(kf[kk], qf[kk], s, 0, 0, 0);
        float tmax = -INFINITY;
#pragma unroll
        for (int r = 0; r < 16; ++r) {
            const int key = kb + (r & 3) + 8 * (r >> 2) + 4 * half;
            int dist = tq - key; dist = dist < 0 ? 0 : (dist > 4095 ? 4095 : dist);
            float v = s[r] * (0.125f * 1.44269504089f) + tab[blut[dist]];
            if (causal && key > tq) v = -INFINITY;
            s[r] = v; tmax = fmaxf(tmax, v);
        }
        tmax = fmaxf(tmax, __shfl_xor(tmax, 32));
        const float mnew = fmaxf(m, tmax);
        const float alpha = __builtin_amdgcn_exp2f(m - mnew);
        float lsum = 0.f;
#pragma unroll
        for (int r = 0; r < 16; ++r) { const float pv = __builtin_amdgcn_exp2f(s[r] - mnew); s[r] = pv; lsum += pv; }
        lsum += __shfl_xor(lsum, 32);
        l = l * alpha + lsum;
#pragma unroll
        for (int mt = 0; mt < 2; ++mt) o[mt] = o[mt] * alpha;
#pragma unroll
        for (int s2 = 0; s2 < 2; ++s2) {
            h8 pf;
#pragma unroll
            for (int j = 0; j < 8; ++j) pf[j] = (f16)s[8 * s2 + j];
#pragma unroll
            for (int mt = 0; mt < 2; ++mt) {
                const h4 lo = vl[s2][mt], hi = vh[s2][mt];
                h8 vf; vf[0] = lo[0]; vf[1] = lo[1]; vf[2] = lo[2]; vf[3] = lo[3]; vf[4] = hi[0]; vf[5] = hi[1]; vf[6] = hi[2]; vf[7] = hi[3];
                o[mt] = __builtin_amdgcn_mfma_f32_32x32x16_f16(vf, pf, o[mt], 0, 0, 0);
            }
        }
        m = mnew;
    }
}
__device__ __forceinline__ void phase_moba_sel(const Params& p_, LAS unsigned char* lds, int layer, bool overlap = false) {
    const Params p = load_params(); (void)p_;
    unsigned char* ws = phase_ws(p.ws); const int ptid = phase_tid();
    const f16* QKV = (const f16*)(ws + WS_QKV);
    const unsigned* LCNT = (const unsigned*)(ws + WS_LCNT) + layer * 512;
    const u16* LIST = (const u16*)(ws + WS_LIST);
    f16* PARTO = (f16*)(ws + WS_PQ); float* ML = (float*)(ws + WS_EIDX);
    LAS int* pre = (LAS int*)lds;
    LAS float* tab = (LAS float*)(lds + 4096);
    const int tid = ptid, lane = tid & 63, wave = __builtin_amdgcn_readfirstlane(tid >> 6), half = lane >> 5, l31 = lane & 31;
    tab[tid] = p.rel_bias[tid] * 1.44269504089f;
    LAS unsigned char* blut = (LAS unsigned char*)(lds + 24576);
    for (int d = tid; d < 4096; d += NTHREADS) blut[d] = (unsigned char)t5_bucket(d);
    { const int c = (int)((LCNT[tid] + 31u) >> 5);
      pre[tid + 1] = c; if (tid == 0) pre[0] = 0;
      __syncthreads();
      for (int off = 1; off < 512; off <<= 1) { int v = 0; if (tid >= off) v = pre[tid + 1 - off]; __syncthreads(); pre[tid + 1] += v; __syncthreads(); } }
    const int total = pre[512];
    const int nmw = overlap ? 4 : NWAVES, mw = overlap ? wave - 4 : wave;
    if (mw >= 0)
    for (int w = blockIdx.x * nmw + mw; w < total; w += gridDim.x * nmw) {
        int lo = 0, hi = 511;
        while (lo < hi) { const int mid = (lo + hi + 1) >> 1; if (pre[mid] <= w) lo = mid; else hi = mid - 1; }
        const int L = lo, h = L >> 6, j = L & 63, tile = w - pre[L];
        const int cntL = (int)LCNT[L];
        int ei = tile * 32 + l31; const bool valid = ei < cntL; if (!valid) ei = cntL - 1;
        const unsigned e = LIST[(size_t)L * S + ei];
        const int tq = (int)(e & 0x3FFFu), slot = (int)(e >> 14);
        f32x16 o[2]; float m, l;
        moba_block<false>(QKV + (size_t)(0 * 8 + h) * S * 64, QKV + (size_t)(1 * 8 + h) * S * 64, QKV + (size_t)(2 * 8 + h) * S * 64, tq, j * 256, 8, tab + h * 32, blut, o, m, l, lane);
        if (valid) {
            const float inv = 1.0f / l;
            f16* dst = PARTO + ((size_t)(tq * 8 + h) * 3 + slot) * 64;
#pragma unroll
            for (int mt = 0; mt < 2; ++mt)
#pragma unroll
                for (int r4 = 0; r4 < 4; ++r4) { h4 ov;
#pragma unroll
                    for (int i = 0; i < 4; ++i) ov[i] = (f16)(o[mt][4 * r4 + i] * inv);
                    *(h4*)(dst + 32 * mt + 8 * r4 + 4 * half) = ov; }
            if (half == 0) { float* mlp = ML + ((size_t)(tq * 8 + h) * 3 + slot) * 2; mlp[0] = m; mlp[1] = l; }
        }
    }
    if (!overlap) __syncthreads();
}
__device__ __forceinline__ void phase_moba_own(const Params& p_, LAS unsigned char* lds) {
    const Params p = load_params(); (void)p_;
    unsigned char* ws = phase_ws(p.ws); const int ptid = phase_tid();
    const f16* QKV = (const f16*)(ws + WS_QKV);
    const int* SEL = (const int*)(ws + WS_SEL);
    const f16* PARTO = (const f16*)(ws + WS_PQ); const float* ML = (const float*)(ws + WS_EIDX);
    f16* Y = (f16*)(ws + WS_Y);
    LAS float* tab = (LAS float*)(lds + 4096);
    const int tid = ptid, lane = tid & 63, wave = tid >> 6, half = lane >> 5, l31 = lane & 31;
    LAS unsigned char* blut = (LAS unsigned char*)(lds + 24576);
    __syncthreads();
    if (tid < 256) tab[tid] = p.rel_bias[tid] * 1.44269504089f;
    for (int d = tid; d < 4096; d += NTHREADS) blut[d] = (unsigned char)t5_bucket(d);
    __syncthreads();
    for (int w = blockIdx.x * NWAVES + wave; w < 4096; w += gridDim.x * NWAVES) {
        const int h = w & 7; int qt = w >> 3; if (qt >= 256) qt ^= 7;
        const int t0 = qt * 32, tq = t0 + l31, b0 = t0 >> 8;
        f32x16 o[2]; float m, l;
        moba_block<true>(QKV + (size_t)(0 * 8 + h) * S * 64, QKV + (size_t)(1 * 8 + h) * S * 64, QKV + (size_t)(2 * 8 + h) * S * 64, tq, b0 * 256, ((t0 & 255) >> 5) + 1, tab + h * 32, blut, o, m, l, lane);
        const int sel = SEL[(size_t)h * S + tq];
        float mp[3], lp[3]; float M = m;
#pragma unroll
        for (int sl = 0; sl < 3; ++sl) { const bool ok = (((sel >> (8 * sl)) & 0xFF) != 0xFF);
            const float* mlp = ML + ((size_t)(tq * 8 + h) * 3 + sl) * 2;
            mp[sl] = ok ? mlp[0] : -INFINITY; lp[sl] = ok ? mlp[1] : 0.f; M = fmaxf(M, mp[sl]); }
        const float wo = __builtin_amdgcn_exp2f(m - M);
        float L = l * wo; float wsl[3];
#pragma unroll
        for (int sl = 0; sl < 3; ++sl) { wsl[sl] = lp[sl] * __builtin_amdgcn_exp2f(mp[sl] - M); L += wsl[sl]; }
        const float inv = 1.0f / L;
#pragma unroll
        for (int mt = 0; mt < 2; ++mt)
#pragma unroll
            for (int r4 = 0; r4 < 4; ++r4) {
                const int d0 = 32 * mt + 8 * r4 + 4 * half;
                float v[4];
#pragma unroll
                for (int i = 0; i < 4; ++i) v[i] = o[mt][4 * r4 + i] * wo;
#pragma unroll
                for (int sl = 0; sl < 3; ++sl) if (wsl[sl] != 0.f) {
                    const h4 pv = *(const h4*)(PARTO + ((size_t)(tq * 8 + h) * 3 + sl) * 64 + d0);
#pragma unroll
                    for (int i = 0; i < 4; ++i) v[i] += wsl[sl] * (float)pv[i]; }
                h4 ov;
#pragma unroll
                for (int i = 0; i < 4; ++i) ov[i] = (DIAG == 3) ? (f16)0.f : (f16)(v[i] * inv);
                *(h4*)(Y + (size_t)tq * D + h * 64 + d0) = ov;
            }
    }
    __syncthreads();
}

__device__ __forceinline__ void phase_dsa(const Params& p_, LAS unsigned char* lds, int layer, bool skip_prologue = false) {
    const Params p = load_params(); (void)p_;
    unsigned char* ws = phase_ws(p.ws); const int ptid = phase_tid();
    const f16* QKV = (const f16*)(ws + WS_QKV);
    const u16* IDX = (const u16*)(ws + WS_IDX); const int* NIDX = (const int*)(ws + WS_NIDX);
    f16* Y = (f16*)(ws + WS_Y);
    LAS float* tab = (LAS float*)(lds + 4096);
    const int tid = ptid, lane = tid & 63, wave = __builtin_amdgcn_readfirstlane(tid >> 6), kg = lane >> 2, c = lane & 3;
    LAS u16* ibase = (LAS u16*)(lds + 8192 + wave * 1024);
    LAS float* scb = (LAS float*)(lds + 16384 + wave * 1024);
    LAS f16* bl16 = (LAS f16*)(lds + 32768);
    {
        __syncthreads();
        for (int i = tid; i < 512; i += NTHREADS) tab[i] = p.rel_bias[i];
        for (int d = tid; d < 4096; d += NTHREADS) { const int bk = t5_bucket(d);
#pragma unroll
            for (int hh = 0; hh < 8; ++hh) bl16[hh * 4096 + d] = (f16)(p.rel_bias[(8 + hh) * 32 + bk] * 1.44269504089f); }
        __syncthreads();
    }
    const int G = gridDim.x;
    const int h0 = (int)(xb_xcc_id() & 7u);
    auto do_head = [&](const int h, const bool dyn, const int first, const int stride) __attribute__((always_inline)) {
    unsigned* hctr = (unsigned*)(ws + WS_CTL + 40960) + layer * 8 + h;
    const f16* DQ = QKV + (size_t)(3 * 8 + h) * S * 64;
    const unsigned char* KV = (const unsigned char*)(QKV + (size_t)4 * 8 * S * 64) + (size_t)h * S * 128 + 16 * c;
    const LAS f16* blh = bl16 + h * 4096;
    const int gwh = (blockIdx.x >> 3) * NWAVES + wave, nwh = (G >> 3) * NWAVES;
    const int eo = ((lane >> 5) & 1) * 8 + ((lane >> 4) & 1) * 4 + ((lane >> 3) & 1) * 2 + ((lane >> 2) & 1);
    const int role = (lane >> 2) & 1, g2 = lane >> 3;
    constexpr int CH = 16;
    for (int ck = first; ; ck += stride) {
      int tb0 = ck * CH;
      if (dyn) { if (lane == 0) tb0 = (int)__hip_atomic_fetch_add(hctr, (unsigned)CH, __ATOMIC_RELAXED, __HIP_MEMORY_SCOPE_AGENT);
                 tb0 = __builtin_amdgcn_readfirstlane(tb0); }
      if (tb0 >= S) break;
      u32x2 nidx = __builtin_nontemporal_load((const u32x2*)(IDX + (size_t)tb0 * 256 + 4 * lane));
      int nn = __builtin_nontemporal_load(NIDX + tb0);
      h8 nqa = __builtin_nontemporal_load((const h8*)(DQ + (size_t)tb0 * 64 + 16 * c)), nqb = __builtin_nontemporal_load((const h8*)(DQ + (size_t)tb0 * 64 + 16 * c + 8));
      for (int t = tb0; t < tb0 + CH; ++t) {
        const int n = nn;
        LAS u16* ib = ibase + ((t & 1) ? 256 : 0);
        __builtin_amdgcn_wave_barrier();
        *(LAS u32x2*)(ib + 4 * lane) = nidx;
        __builtin_amdgcn_wave_barrier();
        h2 qh[8];
#pragma unroll
        for (int j = 0; j < 4; ++j) { qh[j] = (h2){nqa[2 * j], nqa[2 * j + 1]}; qh[4 + j] = (h2){nqb[2 * j], nqb[2 * j + 1]}; }
        if (t + 1 < tb0 + CH) {
            nidx = __builtin_nontemporal_load((const u32x2*)(IDX + (size_t)(t + 1) * 256 + 4 * lane));
            nn = __builtin_nontemporal_load(NIDX + t + 1);
            nqa = __builtin_nontemporal_load((const h8*)(DQ + (size_t)(t + 1) * 64 + 16 * c)); nqb = __builtin_nontemporal_load((const h8*)(DQ + (size_t)(t + 1) * 64 + 16 * c + 8));
        }
        h2 acc2[8]; float ls = 0.f, mref = -INFINITY;
#pragma unroll
        for (int j = 0; j < 8; ++j) acc2[j] = (h2){(f16)0.f, (f16)0.f};
        auto half_body = [&](auto FULLT, const int hh) __attribute__((always_inline)) {
            constexpr bool FULL = decltype(FULLT)::value;
            u32x4 krr[8], vrr[8]; float so[8]; bool vv[8]; bool vk[8]; int rk[8];
#pragma unroll
            for (int i = 0; i < 8; ++i) {
                const int kkK = 16 * (8 * hh + i) + 2 * g2 + role, kkV = kkK ^ 1;
                vk[i] = FULL || (kkK < n); vv[i] = FULL || (kkV < n);
                rk[i] = vk[i] ? (int)ib[kkK] : 0; const int rowV = vv[i] ? (int)ib[kkV] : 0;
                krr[i] = *(const u32x4*)(KV + (size_t)rk[i] * 128);
                vrr[i] = *(const u32x4*)(KV + (size_t)rowV * 128 + 64);
            }
            __builtin_amdgcn_sched_barrier(0);
#pragma unroll
            for (int i = 0; i < 8; ++i) {
                const u32x4 kr = krr[i];
                float dp[4];
#pragma unroll
                for (int w = 0; w < 4; ++w) { const h2 lo = __builtin_amdgcn_cvt_scalef32_pk_f16_fp8((int)kr[w], 1.0f, false), hi = __builtin_amdgcn_cvt_scalef32_pk_f16_fp8((int)kr[w], 1.0f, true);
                    dp[w] = __builtin_amdgcn_fdot2(hi, qh[2 * w + 1], __builtin_amdgcn_fdot2(lo, qh[2 * w], 0.f, false), false); }
                float d = (dp[0] + dp[1]) + (dp[2] + dp[3]);
                d += dpp_f<0xB1>(d); d += dpp_f<0x4E>(d);
                int dd = t - rk[i]; dd = FULL ? (dd > 4095 ? 4095 : dd) : (dd < 0 ? 0 : (dd > 4095 ? 4095 : dd));
                float sv = d * (0.125f * 1.44269504089f / DSA_KV_SCALE) + (float)blh[dd];
                sv = vk[i] ? sv : -INFINITY;
                so[i] = dpp_f<0x141>(sv);
            }
            float mh = mref;
#pragma unroll
            for (int i = 0; i < 8; ++i) mh = fmaxf(mh, so[i]);
            if (hh != 0) { const float scl = (mref == -INFINITY) ? 0.f : __builtin_amdgcn_exp2f(mref - mh); ls *= scl;
              const h2 s2 = pkrtz2(scl, scl);
#pragma unroll
              for (int j = 0; j < 8; ++j) acc2[j] = acc2[j] * s2; }
            mref = mh;
#pragma unroll
            for (int i = 0; i < 8; ++i) {
                const float pv = vv[i] ? __builtin_amdgcn_exp2f(so[i] - mref) : 0.f; ls += pv;
                const h2 p2 = pkrtz2(pv, pv);
#pragma unroll
                for (int w = 0; w < 4; ++w) { const h2 lo = __builtin_amdgcn_cvt_scalef32_pk_f16_fp8((int)vrr[i][w], 1.0f, false), hi = __builtin_amdgcn_cvt_scalef32_pk_f16_fp8((int)vrr[i][w], 1.0f, true);
                    acc2[2 * w] = __builtin_elementwise_fma(p2, lo, acc2[2 * w]); acc2[2 * w + 1] = __builtin_elementwise_fma(p2, hi, acc2[2 * w + 1]); }
            }
        };
        if (n == TK_K) {
#pragma unroll 1
            for (int hh = 0; hh < 2; ++hh) half_body(std::true_type{}, hh);
        } else {
#pragma unroll 1
            for (int hh = 0; hh < 2; ++hh) half_body(std::false_type{}, hh);
        }
        float acc[16];
#pragma unroll
        for (int j = 0; j < 8; ++j) { acc[2 * j] = (float)acc2[j][0]; acc[2 * j + 1] = (float)acc2[j][1]; }
        float M = mref;
        M = fmaxf(M, __shfl_xor(M, 4)); M = fmaxf(M, __shfl_xor(M, 8)); M = fmaxf(M, __shfl_xor(M, 16)); M = fmaxf(M, __shfl_xor(M, 32));
        const float fs = (mref == -INFINITY) ? 0.f : __builtin_amdgcn_exp2f(mref - M);
        ls *= fs;
#pragma unroll
        for (int j = 0; j < 16; ++j) acc[j] *= fs;
        ls += __shfl_xor(ls, 4); ls += __shfl_xor(ls, 8); ls += __shfl_xor(ls, 16); ls += __shfl_xor(ls, 32);
        float r8[8], r4[4], r2[2], r1;
        { const bool hi = (lane >> 5) & 1;
#pragma unroll
          for (int j = 0; j < 8; ++j) { const float send = hi ? acc[j] : acc[j + 8]; const float keep = hi ? acc[j + 8] : acc[j]; r8[j] = keep + __shfl_xor(send, 32); } }
        { const bool hi = (lane >> 4) & 1;
#pragma unroll
          for (int j = 0; j < 4; ++j) { const float send = hi ? r8[j] : r8[j + 4]; const float keep = hi ? r8[j + 4] : r8[j]; r4[j] = keep + __shfl_xor(send, 16); } }
        { const bool hi = (lane >> 3) & 1;
#pragma unroll
          for (int j = 0; j < 2; ++j) { const float send = hi ? r4[j] : r4[j + 2]; const float keep = hi ? r4[j + 2] : r4[j]; r2[j] = keep + __shfl_xor(send, 8); } }
        { const bool hi = (lane >> 2) & 1; const float send = hi ? r2[0] : r2[1]; const float keep = hi ? r2[1] : r2[0]; r1 = keep + __shfl_xor(send, 4); }
        __builtin_nontemporal_store((DIAG == 2) ? (f16)0.f : (f16)(r1 / (ls * DSA_KV_SCALE)), Y + (size_t)t * D + 512 + h * 64 + 16 * c + eo);
      }
    }
    };
    unsigned* xr = (unsigned*)(ws + WS_CTL + 41216) + layer * 16 + xb_xcc_id();
    LAS int* rk = (LAS int*)(lds + 28672);
    if (tid == 0) { rk[0] = (int)__hip_atomic_fetch_add(xr, 1u, __ATOMIC_RELAXED, __HIP_MEMORY_SCOPE_AGENT);
                    rk[1] = (int)__hip_atomic_load((unsigned*)(ws + WS_CTL) + XB_XCNT(xb_xcc_id()), __ATOMIC_RELAXED, __HIP_MEMORY_SCOPE_AGENT); }
    __syncthreads();
    const int rank = rk[0], nloc = rk[1] > 0 ? rk[1] : 1;
    do_head(h0, false, rank * NWAVES + wave, nloc * NWAVES);
#pragma unroll 1
    for (int h2 = 0; h2 < 8; ++h2) {
        unsigned present = 0u;
        for (int x = h2; x < 16; x += 8) present += __hip_atomic_load((unsigned*)(ws + WS_CTL) + XB_XCNT(x), __ATOMIC_RELAXED, __HIP_MEMORY_SCOPE_AGENT);
        if (__builtin_amdgcn_readfirstlane((int)present) == 0) do_head(h2, true, 0, 0);
    }
    __syncthreads();
}

#define INS16(a, ai, x, xi) do { float _x = (x); int _xi = (xi); _Pragma("unroll") for (int _k = 0; _k < 16; ++_k) { const bool _g = _x > a[_k]; \
        const float _t = _g ? a[_k] : _x; const int _ti = _g ? ai[_k] : _xi; a[_k] = _g ? _x : a[_k]; ai[_k] = _g ? _xi : ai[_k]; _x = _t; _xi = _ti; } } while (0)
__device__ __forceinline__ void ce_desc(float& a, int& ai, float& b, int& bi) {
    const bool sw = a < b; const float t = sw ? b : a, u = sw ? a : b; const int ti = sw ? bi : ai, ui = sw ? ai : bi; a = t; b = u; ai = ti; bi = ui;
}
__device__ __forceinline__ void sort16_desc(float (&c)[16], int (&ci)[16]) {
#pragma unroll
    for (int k = 2; k <= 16; k <<= 1)
#pragma unroll
        for (int j = k >> 1; j >= 1; j >>= 1)
#pragma unroll
            for (int i = 0; i < 16; ++i) { const int l = i ^ j; if (l > i) { if ((i & k) == 0) ce_desc(c[i], ci[i], c[l], ci[l]); else ce_desc(c[l], ci[l], c[i], ci[i]); } }
}
__device__ __forceinline__ void merge16(float (&a)[16], int (&ai)[16], const float (&b)[16], const int (&bi)[16]) {
    float c[16]; int ci[16];
#pragma unroll
    for (int k = 0; k < 16; ++k) { const bool g = a[k] >= b[15 - k]; c[k] = g ? a[k] : b[15 - k]; ci[k] = g ? ai[k] : bi[15 - k]; }
#pragma unroll
    for (int st = 8; st >= 1; st >>= 1)
#pragma unroll
        for (int k = 0; k < 16; ++k) if ((k & st) == 0) ce_desc(c[k], ci[k], c[k + st], ci[k + st]);
#pragma unroll
    for (int k = 0; k < 16; ++k) { a[k] = c[k]; ai[k] = ci[k]; }
}
__device__ __forceinline__ void merge_halves(float (&a)[16], int (&ai)[16]) {
    float b[16]; int bi[16];
#pragma unroll
    for (int k = 0; k < 16; ++k) { b[k] = __shfl_xor(a[k], 32); bi[k] = __shfl_xor(ai[k], 32); }
    merge16(a, ai, b, bi);
}
__device__ __forceinline__ void phase_psel(const Params& p_, LAS unsigned char* lds, int layer) {
    const Params p = load_params(); (void)p_;
    unsigned char* ws = phase_ws(p.ws); const int ptid = phase_tid();
    const f16* PQ = (const f16*)(ws + WS_PQ);
    const f16* SUBK = (const f16*)(ws + WS_SUBK) + (size_t)layer * 8 * 2 * 128 * 128;
    int* EIDX = (int*)(ws + WS_EIDX); float* EG = (float*)(ws + WS_EG);
    const int tid = ptid, lane = tid & 63, wave = tid >> 6, half = lane >> 5, l31 = lane & 31;
    for (int w = blockIdx.x * NWAVES + wave; w < 4096; w += gridDim.x * NWAVES) {
        const int h = w & 7, tt = w >> 3, t = tt * 32 + l31;
        float v0[16], v1[16]; int i0[16], i1[16];
#pragma unroll
        for (int pp = 0; pp < 2; ++pp) {
            float a[16]; int ai[16];
#pragma unroll
            for (int k = 0; k < 16; ++k) { a[k] = -INFINITY; ai[k] = 0; }
            h8 qf[8];
#pragma unroll
            for (int kk = 0; kk < 8; ++kk) qf[kk] = *(const h8*)(PQ + (size_t)t * NQ + (2 * h + pp) * 128 + 16 * kk + 8 * half);
            const f16* sk = SUBK + (size_t)(h * 2 + pp) * 128 * 128;
#pragma unroll 1
            for (int mt = 0; mt < 4; ++mt) {
                f32x16 acc = (f32x16){0.f,0.f,0.f,0.f,0.f,0.f,0.f,0.f,0.f,0.f,0.f,0.f,0.f,0.f,0.f,0.f};
#pragma unroll
                for (int kk = 0; kk < 8; ++kk) { const h8 af = *(const h8*)(sk + (size_t)(32 * mt + l31) * 128 + 16 * kk + 8 * half);
                    acc = __builtin_amdgcn_mfma_f32_32x32x16_f16(af, qf[kk], acc, 0, 0, 0); }
                float cv[16]; int cn[16];
#pragma unroll
                for (int r = 0; r < 16; ++r) { cv[r] = acc[r]; cn[r] = 32 * mt + (r & 3) + 8 * (r >> 2) + 4 * half; }
                sort16_desc(cv, cn);
                merge16(a, ai, cv, cn);
            }
            merge_halves(a, ai);
            if (pp == 0) {
#pragma unroll
                for (int k = 0; k < 16; ++k) { v0[k] = a[k]; i0[k] = ai[k]; }
            } else {
#pragma unroll
                for (int k = 0; k < 16; ++k) { v1[k] = a[k]; i1[k] = ai[k]; }
            }
        }
        float ca[16]; int ci[16];
#pragma unroll
        for (int k = 0; k < 16; ++k) {
            const float sA = v0[0] + v1[k]; const int eA = i0[0] * 128 + i1[k];
            const float sB = (k < 8) ? (v0[1] + v1[k]) : -INFINITY; const int eB = (k < 8) ? (i0[1] * 128 + i1[k]) : 0;
            ca[k] = half ? sB : sA; ci[k] = half ? eB : eA;
        }
        {
            constexpr int PI[26] = {2,2,2,2,2, 3,3,3,3, 4,4,4, 5,5, 6,6, 7,7, 8,9,10,11,12,13,14,15};
            constexpr int PJ[26] = {0,1,2,3,4, 0,1,2,3, 0,1,2, 0,1, 0,1, 0,1, 0,0,0,0,0,0,0,0};
#pragma unroll
            for (int k = 0; k < 13; ++k) {
                const float sA = v0[PI[2 * k]] + v1[PJ[2 * k]]; const int eA = i0[PI[2 * k]] * 128 + i1[PJ[2 * k]];
                const float sB = v0[PI[2 * k + 1]] + v1[PJ[2 * k + 1]]; const int eB = i0[PI[2 * k + 1]] * 128 + i1[PJ[2 * k + 1]];
                INS16(ca, ci, half ? sB : sA, half ? eB : eA);
            }
        }
        merge_halves(ca, ci);
        float e[16]; float sum = 0.f;
#pragma unroll
        for (int k = 0; k < 16; ++k) { e[k] = __expf(ca[k] - ca[0]); sum += e[k]; }
        const float inv = 1.0f / sum;
        int* ep = EIDX + (size_t)t * 128 + h * 16; float* gp = EG + (size_t)t * 128 + h * 16;
#pragma unroll
        for (int k = 0; k < 16; ++k) if ((k >> 3) == half) { ep[k] = ci[k]; gp[k] = e[k] * inv; }
    }
    __syncthreads();
}

template <bool LAST>
__device__ __forceinline__ void phase_peer(const Params& p_, LAS unsigned char* lds, int layer) {
    const Params p = load_params(); (void)p_;
    unsigned char* ws = phase_ws(p.ws); const int ptid = phase_tid();
    const unsigned char* U = ws + WS_U16 + (size_t)layer * 16384 * D; const unsigned char* V = ws + WS_V16 + (size_t)layer * 16384 * D;
    const int* EIDX = (const int*)(ws + WS_EIDX); const float* EG = (const float*)(ws + WS_EG);
    const float* X1 = (const float*)(ws + WS_X1); f16* H = (f16*)(ws + WS_H);
    const float* MOD = (const float*)(ws + WS_MOD);
    LAS float* g2 = (LAS float*)lds; LAS float* nw = g2 + 1024; LAS float* sh = nw + 1024; LAS float* sc = sh + 1024;
    const int tid = ptid, lane = tid & 63, wave = __builtin_amdgcn_readfirstlane(tid >> 6);
    __syncthreads();
    for (int i = tid; i < 1024; i += NTHREADS) {
        g2[i] = MOD[layer * 6144 + 5 * 1024 + i];
        if (LAST) { nw[i] = p.norm_final[i]; sh[i] = 0.f; sc[i] = 0.f; }
        else { nw[i] = p.norm_attn[(layer + 1) * 1024 + i]; sh[i] = MOD[(layer + 1) * 6144 + i]; sc[i] = MOD[(layer + 1) * 6144 + 1024 + i]; }
    }
    __syncthreads();
    const int el = ((lane >> 5) & 1) * 4 + ((lane >> 4) & 1) * 2 + ((lane >> 3) & 1);
    for (int ti = 0; ; ++ti) {
        const int tt = blockIdx.x + gridDim.x * (ti >> 2); if (tt >= S / 32) break;
        const int t = tt * 32 + (ti & 3) * 8 + wave;
        h2 hh2[8];
        { const h8 hA = *(const h8*)(H + (size_t)t * D + 16 * lane), hB = *(const h8*)(H + (size_t)t * D + 16 * lane + 8);
#pragma unroll
          for (int i = 0; i < 4; ++i) { hh2[i] = (h2){hA[2 * i], hA[2 * i + 1]}; hh2[4 + i] = (h2){hB[2 * i], hB[2 * i + 1]}; } }
        const int ev0 = EIDX[(size_t)t * 128 + lane], ev1 = EIDX[(size_t)t * 128 + 64 + lane];
        const float gv0 = EG[(size_t)t * 128 + lane], gv1 = EG[(size_t)t * 128 + 64 + lane];
        float acc[16];
#pragma unroll
        for (int j = 0; j < 16; ++j) acc[j] = 0.f;
#pragma unroll 1
        for (int bt = 0; bt < 16; ++bt) {
            const int kb = bt * 8;
            u32x4 ur[8], vr[8];
#pragma unroll
            for (int j = 0; j < 8; ++j) { const int k = kb + j; const int e = __builtin_amdgcn_readlane(k < 64 ? ev0 : ev1, k & 63);
                ur[j] = *(const u32x4*)(U + (size_t)e * D + 16 * lane); vr[j] = *(const u32x4*)(V + (size_t)e * D + 16 * lane); }
            __builtin_amdgcn_sched_barrier(0);
            float pd[8];
#pragma unroll
            for (int j = 0; j < 8; ++j) { float dp[4];
#pragma unroll
                for (int w = 0; w < 4; ++w) { const h2 lo = __builtin_amdgcn_cvt_scalef32_pk_f16_fp8((int)ur[j][w], 1.0f, false), hi = __builtin_amdgcn_cvt_scalef32_pk_f16_fp8((int)ur[j][w], 1.0f, true);
                    dp[w] = __builtin_amdgcn_fdot2(hi, hh2[2 * w + 1], __builtin_amdgcn_fdot2(lo, hh2[2 * w], 0.f, false), false); }
                pd[j] = (dp[0] + dp[1]) + (dp[2] + dp[3]); }
            float r4[4], r2[2], r1;
            { const bool hi = (lane >> 5) & 1;
#pragma unroll
              for (int j = 0; j < 4; ++j) { const float send = hi ? pd[j] : pd[j + 4]; const float keep = hi ? pd[j + 4] : pd[j]; r4[j] = keep + __shfl_xor(send, 32); } }
            { const bool hi = (lane >> 4) & 1;
#pragma unroll
              for (int j = 0; j < 2; ++j) { const float send = hi ? r4[j] : r4[j + 2]; const float keep = hi ? r4[j + 2] : r4[j]; r2[j] = keep + __shfl_xor(send, 16); } }
            { const bool hi = (lane >> 3) & 1; const float send = hi ? r2[0] : r2[1]; const float keep = hi ? r2[1] : r2[0]; r1 = keep + __shfl_xor(send, 8); }
            r1 += __shfl_xor(r1, 4); r1 += __shfl_xor(r1, 2); r1 += __shfl_xor(r1, 1);
            const int kmine = kb + el;
            const float gmine = __shfl(kmine < 64 ? gv0 : gv1, kmine & 63);
            const float wmine = gmine * gelu_exact(r1 * (1.0f / PEER_U_SCALE));
#pragma unroll
            for (int j = 0; j < 8; ++j) {
                const int src = ((j >> 2) & 1) * 32 + ((j >> 1) & 1) * 16 + (j & 1) * 8;
                const float wj = __uint_as_float(__builtin_amdgcn_readlane(__float_as_uint(wmine), src));
#pragma unroll
                for (int w = 0; w < 4; ++w) { const f32x2 lo = __builtin_amdgcn_cvt_pk_f32_fp8((int)vr[j][w], false), hi = __builtin_amdgcn_cvt_pk_f32_fp8((int)vr[j][w], true);
                    acc[4 * w] += wj * lo[0]; acc[4 * w + 1] += wj * lo[1]; acc[4 * w + 2] += wj * hi[0]; acc[4 * w + 3] += wj * hi[1]; }
            }
        }
#pragma unroll
        for (int j = 0; j < 16; ++j) acc[j] *= (1.0f / PEER_V_SCALE);
        const float* xr = X1 + (size_t)t * D + 16 * lane;
        float x2[16]; float ss = 0.f;
#pragma unroll
        for (int i = 0; i < 4; ++i) { const f32x4 xv = *(const f32x4*)(xr + 4 * i);
#pragma unroll
            for (int j = 0; j < 4; ++j) { const float v = xv[j] + g2[16 * lane + 4 * i + j] * acc[4 * i + j]; x2[4 * i + j] = v; ss += v * v; } }
        ss = wave_sum(ss);
        const float r = rsqrtf(ss * (1.0f / D) + EPS);
        if (LAST) {
            float* op = p.out + (size_t)t * D + 16 * lane;
#pragma unroll
            for (int i = 0; i < 4; ++i) { f32x4 ov;
#pragma unroll
                for (int j = 0; j < 4; ++j) ov[j] = x2[4 * i + j] * r * nw[16 * lane + 4 * i + j];
                *(f32x4*)(op + 4 * i) = ov; }
        } else {
            float* op = p.out + (size_t)t * D + 16 * lane;
#pragma unroll
            for (int i = 0; i < 4; ++i) { f32x4 ov;
#pragma unroll
                for (int j = 0; j < 4; ++j) ov[j] = x2[4 * i + j];
                *(f32x4*)(op + 4 * i) = ov; }
            h8 oA, oB;
#pragma unroll
            for (int j = 0; j < 8; ++j) { const int cA = 16 * lane + j, cB = cA + 8;
                oA[j] = (f16)((x2[j] * r * nw[cA]) * (1.0f + sc[cA]) + sh[cA]); oB[j] = (f16)((x2[8 + j] * r * nw[cB]) * (1.0f + sc[cB]) + sh[cB]); }
            *(h8*)(H + (size_t)t * D + 16 * lane) = oA; *(h8*)(H + (size_t)t * D + 16 * lane + 8) = oB;
        }
    }
    __syncthreads();
}


#ifndef CHECKS
#define CHECKS 0
#endif
__device__ __forceinline__ float naive_iscore(const f16* IQ, const f16* KN, const float* IW, int t, int s) {
    float x[4] = {0.f, 0.f, 0.f, 0.f};
    for (int d8 = 0; d8 < 8; ++d8) {
        const h8 kv = *(const h8*)(KN + (size_t)s * 64 + 8 * d8);
#pragma unroll
        for (int hh = 0; hh < 4; ++hh) { const h8 qv = *(const h8*)(IQ + (size_t)t * 256 + hh * 64 + 8 * d8);
#pragma unroll
            for (int j = 0; j < 8; ++j) x[hh] += (float)qv[j] * (float)kv[j]; }
    }
    float I = 0.f;
#pragma unroll
    for (int hh = 0; hh < 4; ++hh) I += IW[(size_t)t * 4 + hh] * fmaxf(x[hh], 0.f);
    return I + 0.0f;
}
__device__ __forceinline__ void phase_check_attn(const Params& p_, LAS unsigned char* lds) {
    const Params p = load_params(); (void)p_;
    unsigned char* ws = phase_ws(p.ws); const int ptid = phase_tid();
    const f16* QKV = (const f16*)(ws + WS_QKV); const f16* IQ = (const f16*)(ws + WS_IQ); const f16* KN = (const f16*)(ws + WS_KN); const float* IW = (const float*)(ws + WS_IW);
    const u16* IDX = (const u16*)(ws + WS_IDX); const int* NIDX = (const int*)(ws + WS_NIDX); const f16* Y = (const f16*)(ws + WS_Y);
    const int* SEL = (const int*)(ws + WS_SEL); const float* KMEAN = (const float*)(ws + WS_KMEAN); const f16* H = (const f16*)(ws + WS_H);
    const int lane = ptid & 63, wave = __builtin_amdgcn_readfirstlane(ptid >> 6), gw = blockIdx.x * NWAVES + wave, nw = gridDim.x * NWAVES;
    constexpr int NS = 40;
    for (int si = gw; si < NS; si += nw) {
        const int t = (si < 4) ? (si * 85 + 3) : (si * 419 + 7) % S;
        const int n = NIDX[t];
        if (n != (t + 1 < 256 ? t + 1 : 256)) set_flag(ws, 4u);
        int sidx[4]; float sI[4]; float mn = INFINITY;
#pragma unroll
        for (int i = 0; i < 4; ++i) { const int k = lane + 64 * i; const bool ok = k < n; sidx[i] = ok ? (int)IDX[(size_t)t * 256 + k] : 0;
            sI[i] = ok ? naive_iscore(IQ, KN, IW, t, sidx[i]) : INFINITY; mn = fminf(mn, sI[i]);
            if (ok && sidx[i] > t) set_flag(ws, 4u); }
        mn = wave_min(mn);
        const float tol = 1e-4f * fabsf(mn) + 1e-5f;
        int call = 0, csel = 0;
        for (int s2 = lane; s2 <= t; s2 += 64) call += (naive_iscore(IQ, KN, IW, t, s2) > mn + tol) ? 1 : 0;
#pragma unroll
        for (int i = 0; i < 4; ++i) csel += (lane + 64 * i < n && sI[i] > mn + tol) ? 1 : 0;
        call = wave_sumi(call); csel = wave_sumi(csel);
        if (call != csel) set_flag(ws, 4u);
        for (int h = 0; h < 8; ++h) {
            const f16* DQ = QKV + (size_t)(3 * 8 + h) * S * 64; const f16* DK = QKV + (size_t)(4 * 8 + h) * S * 64; const f16* DV = QKV + (size_t)(5 * 8 + h) * S * 64;
            float lg[4]; float mx = -INFINITY;
#pragma unroll
            for (int i = 0; i < 4; ++i) { const bool ok = lane + 64 * i < n; float d = 0.f;
                for (int dd = 0; dd < 64; ++dd) d += (float)DQ[(size_t)t * 64 + dd] * (float)DK[(size_t)sidx[i] * 64 + dd];
                const int dist = t - sidx[i];
                lg[i] = ok ? d * 0.125f + p.rel_bias[(8 + h) * 32 + t5_bucket(dist < 0 ? 0 : dist)] : -INFINITY; mx = fmaxf(mx, lg[i]); }
            mx = wave_max(mx);
            float pr[4]; float ls = 0.f;
#pragma unroll
            for (int i = 0; i < 4; ++i) { pr[i] = __expf(lg[i] - mx); ls += pr[i]; }
            ls = wave_sum(ls);
            float o = 0.f;
#pragma unroll
            for (int i = 0; i < 4; ++i)
                for (int src = 0; src < 64; ++src) { const float pk = __shfl(pr[i], src); const int row = __shfl(sidx[i], src); o += pk * (float)DV[(size_t)row * 64 + lane]; }
            o /= ls;
            const float got = (float)Y[(size_t)t * D + 512 + h * 64 + lane];
            const float err = wave_max(fabsf(got - o)), sc = wave_max(fabsf(o));
            if (err > 4e-3f * sc + 1e-3f) set_flag(ws, 8u);
        }
    }
    LAS float* pbuf = (LAS float*)(lds + 32768) + wave * 1024;
    LAS int* sbuf = (LAS int*)(lds + 32768 + 8 * 4096) + wave * 4;
    for (int si = gw; si < NS * 8; si += nw) {
        const int h = si & 7, s8 = si >> 3;
        const int t = (s8 < 4) ? (s8 * 170 + 11) : (s8 * 419 + 7) % S;
        const int b0 = t >> 8;
        const f16* MQ = QKV + (size_t)(0 * 8 + h) * S * 64; const f16* MK = QKV + (size_t)(1 * 8 + h) * S * 64; const f16* MVT = QKV + (size_t)(2 * 8 + h) * S * 64;
        float g = -INFINITY;
        if (lane < b0) { g = 0.f; for (int dd = 0; dd < 64; ++dd) g += (float)MQ[(size_t)t * 64 + dd] * KMEAN[(size_t)(h * 64 + lane) * 64 + dd]; }
        const int sel = SEL[(size_t)h * S + t];
        __builtin_amdgcn_wave_barrier();
        for (int r = 0; r < 3; ++r) { const float mxg = wave_max(g); int cand = (g == mxg && mxg > -INFINITY) ? lane : 999; cand = -(int)wave_max((float)(-cand));
            const int sb_ref = cand < 999 ? cand : -1; if (lane == 0) sbuf[r] = sb_ref; if (lane == cand) g = -INFINITY;
            int sb = (sel >> (8 * r)) & 0xFF; if (sb == 0xFF) sb = -1; if (sb != sb_ref) set_flag(ws, 16u); }
        if (lane == 0) sbuf[3] = b0;
        __builtin_amdgcn_wave_barrier();
        float mx = -INFINITY;
        for (int r = 0; r < 4; ++r) { const int sb = sbuf[r];
            for (int i = 0; i < 4; ++i) { const int key = sb * 256 + lane + 64 * i; const bool ok = sb >= 0 && key <= t;
                float d = 0.f; if (ok) for (int dd = 0; dd < 64; ++dd) d += (float)MQ[(size_t)t * 64 + dd] * (float)MK[(size_t)key * 64 + dd];
                const float lgv = ok ? d * 0.125f + p.rel_bias[h * 32 + t5_bucket(t - key)] : -INFINITY; mx = fmaxf(mx, lgv); pbuf[r * 256 + lane + 64 * i] = lgv; } }
        mx = wave_max(mx);
        float ls = 0.f;
        __builtin_amdgcn_wave_barrier();
        for (int e2 = lane; e2 < 1024; e2 += 64) { const float pv = __expf(pbuf[e2] - mx); ls += pv; pbuf[e2] = pv; }
        ls = wave_sum(ls);
        __builtin_amdgcn_wave_barrier();
        float o = 0.f;
        for (int r = 0; r < 4; ++r) { const int sb = sbuf[r]; if (sb < 0) continue;
            for (int kk = 0; kk < 256; ++kk) { const float pv = pbuf[r * 256 + kk]; if (pv != 0.f) o += pv * (float)MVT[(size_t)lane * S + sb * 256 + kk]; } }
        o /= ls;
        const float got = (float)Y[(size_t)t * D + h * 64 + lane];
        const float err = wave_max(fabsf(got - o)), sc = wave_max(fabsf(o));
        if (err > 4e-3f * sc + 1e-3f) set_flag(ws, 16u);
        __builtin_amdgcn_wave_barrier();
    }
    for (int si = gw; si < NS; si += nw) {
        const int t = (si * 419 + 7) % S;
        const int layer_unknown = 0; (void)layer_unknown;
        (void)H;
    }
    __syncthreads();
}


__device__ __forceinline__ void phase_check_psel(const Params& p_, LAS unsigned char* lds, int layer) {
    const Params p = load_params(); (void)p_;
    int zoff = 0; LAUNDER_S(zoff); unsigned char* ws = p.ws + zoff; const int ptid = phase_tid();
    const f16* PQ = (const f16*)(ws + WS_PQ);
    const f16* SUBK = (const f16*)(ws + WS_SUBK) + (size_t)layer * 8 * 2 * 128 * 128;
    const int* EIDX = (const int*)(ws + WS_EIDX); const float* EG = (const float*)(ws + WS_EG);
    const int lane = ptid & 63, wave = __builtin_amdgcn_readfirstlane(ptid >> 6), gw = blockIdx.x * NWAVES + wave, nw = gridDim.x * NWAVES;
    LAS float* tvL = (LAS float*)(lds + 32768) + wave * 64;
    LAS int* tiL = (LAS int*)(lds + 32768 + 8 * 256) + wave * 64;
    constexpr int NS = 40;
    for (int si = gw; si < NS * 8; si += nw) {
        const int h = si & 7, s8 = si >> 3, t = (s8 * 419 + 7) % S;
        __builtin_amdgcn_wave_barrier();
        for (int pp = 0; pp < 2; ++pp) {
            float s0 = 0.f, s1 = 0.f;
            const f16* qp = PQ + (size_t)t * NQ + (2 * h + pp) * 128; const f16* kp = SUBK + (size_t)(h * 2 + pp) * 128 * 128;
            for (int d = 0; d < 128; ++d) { const float qv = (float)qp[d]; s0 += qv * (float)kp[(size_t)lane * 128 + d]; s1 += qv * (float)kp[(size_t)(lane + 64) * 128 + d]; }
            for (int r = 0; r < 16; ++r) {
                const float mx = wave_max(fmaxf(s0, s1));
                int c = (s0 == mx) ? lane : ((s1 == mx) ? lane + 64 : 999);
                c = -(int)wave_max((float)(-c));
                if (lane == 0) { tvL[pp * 16 + r] = mx; tiL[pp * 16 + r] = c; }
                if (c == lane) s0 = -INFINITY; if (c == lane + 64) s1 = -INFINITY;
            }
        }
        __builtin_amdgcn_wave_barrier();
        float cs[4]; const int ci_ = lane >> 2;
#pragma unroll
        for (int jj = 0; jj < 4; ++jj) cs[jj] = tvL[ci_] + tvL[16 + 4 * (lane & 3) + jj];
        float gs[16]; int ge[16];
#pragma unroll
        for (int r = 0; r < 16; ++r) {
            float m4 = fmaxf(fmaxf(cs[0], cs[1]), fmaxf(cs[2], cs[3]));
            const float mx = wave_max(m4);
            int c = 999;
#pragma unroll
            for (int jj = 3; jj >= 0; --jj) if (cs[jj] == mx) c = ci_ * 16 + 4 * (lane & 3) + jj;
            c = -(int)wave_max((float)(-c));
            gs[r] = mx; ge[r] = tiL[c >> 4] * 128 + tiL[16 + (c & 15)];
#pragma unroll
            for (int jj = 0; jj < 4; ++jj) if (c == ci_ * 16 + 4 * (lane & 3) + jj) cs[jj] = -INFINITY;
        }
        float sum = 0.f;
        { const float g0 = gs[0];
#pragma unroll
          for (int r = 0; r < 16; ++r) gs[r] = __expf(gs[r] - g0); }
#pragma unroll
        for (int r = 0; r < 16; ++r) sum += gs[r];
        bool bad = false;
#pragma unroll
        for (int r = 0; r < 16; ++r) { const int e = EIDX[(size_t)t * 128 + h * 16 + r]; const float g = EG[(size_t)t * 128 + h * 16 + r];
            if (e != ge[r]) bad = true; if (fabsf(g - gs[r] / sum) > 1e-3f) bad = true; }
        if (bad) set_flag(ws, 1u);
    }
    __syncthreads();
}

constexpr int NPHASE = 2 + 2 * 9 + (CHECKS ? 1 : 0);
__global__ void __launch_bounds__(NTHREADS) fwd_kernel(Params p) {
    extern __shared__ __attribute__((aligned(16))) unsigned char lds_raw[];
    LAS unsigned char* lds = (LAS unsigned char*)lds_raw;
    volatile LAS unsigned* xbw = (volatile LAS unsigned*)(lds + LDS_BYTES - 16);
    if (threadIdx.x < 4) xbw[threadIdx.x] = 0u;
    __syncthreads();
    const Params p0 = load_params();
    XcdBarrier bar; bar.bar = (unsigned*)(p0.ws + WS_CTL); bar.x = 0; bar.st = xbw;
#if ONE_LAUNCH
    bar = xcd_barrier_post((unsigned*)(p0.ws + WS_CTL), xbw);
#endif
    const int lo = p0.ph_lo, hi = p0.ph_hi;
    int ph = 0;
#if ONE_LAUNCH
#define PHASE(...) do { if (PH_ON(ph) && ph >= lo && ph < hi) { __VA_ARGS__; if (ph + 1 < hi) xcd_barrier(bar); } ++ph; } while (0)
#else
#define PHASE(...) do { if (PH_ON(ph) && ph >= lo && ph < hi) { __VA_ARGS__; } ++ph; } while (0)
#endif
    PHASE(REP(8, phase_prologue(p, lds)));
    PHASE(phase_norm<true>(p, lds, 0, 0));
    for (int layer = 0; layer < 2; ++layer) {
        PHASE({ const Params q = load_params(); unsigned char* ws = phase_ws(q.ws); pg8::Gemm g{(const f16*)(ws + WS_H), (const f16*)(ws + WS_WIN) + (size_t)layer * NPAD * D, S, NPAD, D};
                pg8::StaticOrder so; so.init(S, NPAD, gridDim.x, blockIdx.x);
                EpiIn E{(f16*)(ws + WS_QKV), (f16*)(ws + WS_IQ), (float*)(ws + WS_IKRAW), (float*)(ws + WS_IW)};
                REP(6, pg8::gemm_phase<EpiIn>(lds, g, so, E)); });
        PHASE(REP(10, phase_prep(p, lds)));
        PHASE({ phase_gate(p, lds, layer); if (REP_WHAT == 15) phase_gate(p, lds, layer, true); phase_topk(p, lds, layer); });
        PHASE({ phase_moba_sel(p, lds, layer, false); phase_dsa(p, lds, layer, false); });
        PHASE(REP(7, phase_moba_own(p, lds)));
        PHASE({ if (CHECKS) phase_check_attn(p, lds); const Params q = load_params(); unsigned char* ws = phase_ws(q.ws); const float* Xin = (layer == 0) ? q.x : q.out; pg8::Gemm g{(const f16*)(ws + WS_Y), (const f16*)(ws + WS_WOUT) + (size_t)layer * D * D, S, D, D};
                pg8::StaticOrder so; so.init(S, D, gridDim.x, blockIdx.x);
                EpiOut E{Xin, (float*)(ws + WS_X1), (const float*)(ws + WS_MOD) + layer * 6144 + 2 * 1024};
                REP(13, pg8::gemm_phase<EpiOut>(lds, g, so, E)); });
        PHASE(REP(11, phase_norm<false>(p, lds, layer, 1)));
        PHASE({ const Params q = load_params(); unsigned char* ws = phase_ws(q.ws); pg8::Gemm g{(const f16*)(ws + WS_H), (const f16*)(ws + WS_WQ) + (size_t)layer * NQ * D, S, NQ, D};
                pg8::StaticOrder so; so.init(S, NQ, gridDim.x, blockIdx.x);
                EpiPQ E{(f16*)(ws + WS_PQ)};
                REP(12, pg8::gemm_phase<EpiPQ>(lds, g, so, E)); });
        if (layer == 0) { PHASE({ phase_psel(p, lds, layer); asm volatile("s_waitcnt vmcnt(0)" ::: "memory"); __syncthreads(); phase_peer<false>(p, lds, layer); }); } else { PHASE({ phase_psel(p, lds, layer); asm volatile("s_waitcnt vmcnt(0)" ::: "memory"); __syncthreads(); phase_peer<true>(p, lds, layer); }); }
    }
#if ONE_LAUNCH
    if (REP_WHAT == 14) { for (int i = 0; i < 20; ++i) xcd_barrier(bar); }
#endif
    if (CHECKS) PHASE({ const Params q = load_params(); if (blockIdx.x == 0 && threadIdx.x == 0) { const unsigned fl = *(volatile unsigned*)(q.ws + WS_FLAG);
              if (fl) q.out[0] += sqrtf((10.0f + (float)fl) * 1000.0f * 16777216.0f); } });
#undef PHASE
}

extern "C" void kernel_launch(void* const* d_in, const int* in_sizes, int n_in, void* d_out, int out_size, void* d_ws, size_t ws_size, hipStream_t stream) {
    static int grid = 0;
    if (grid == 0) {
        if (n_in != 14 || out_size != S * D || ws_size < WS_END) { fprintf(stderr, "kernel_launch: unexpected shapes (n_in %d out %d ws %zu)\n", n_in, out_size, ws_size); grid = -1; return; }
        if (hipFuncSetAttribute((const void*)fwd_kernel, hipFuncAttributeMaxDynamicSharedMemorySize, LDS_BYTES) != hipSuccess) { fprintf(stderr, "kernel_launch: hipFuncSetAttribute failed\n"); grid = -1; return; }
        int dev = 0, cus = 0, per_cu = 0;
        (void)hipGetDevice(&dev); (void)hipDeviceGetAttribute(&cus, hipDeviceAttributeMultiprocessorCount, dev);
        (void)hipOccupancyMaxActiveBlocksPerMultiprocessor(&per_cu, (const void*)fwd_kernel, NTHREADS, LDS_BYTES);
        (void)hipGetLastError();
        if (per_cu < 1) fprintf(stderr, "kernel_launch: occupancy query reports %d blocks per CU\n", per_cu);
        grid = (cus > 0 ? cus : 256);
        if (grid > 256) grid = 256;
    }
    if (grid < 0) return;
    (void)hipMemsetAsync((char*)d_ws + WS_CTL, 0, CTL_ZERO_BYTES, stream);
    Params p{};
    p.x = (const float*)d_in[0]; p.c = (const float*)d_in[1]; p.w_ada = (const float*)d_in[2]; p.b_ada = (const float*)d_in[3];
    p.norm_attn = (const float*)d_in[4]; p.norm_ffn = (const float*)d_in[5]; p.w_in = (const float*)d_in[6]; p.w_out = (const float*)d_in[7];
    p.rel_bias = (const float*)d_in[8]; p.peer_wq = (const float*)d_in[9]; p.peer_subkeys = (const float*)d_in[10]; p.peer_u = (const float*)d_in[11];
    p.peer_v = (const float*)d_in[12]; p.norm_final = (const float*)d_in[13];
    p.out = (float*)d_out; p.ws = (unsigned char*)d_ws;
#if ONE_LAUNCH
    p.ph_lo = 0; p.ph_hi = NPHASE;
    hipLaunchKernelGGL(fwd_kernel, dim3(grid), dim3(NTHREADS), LDS_BYTES, stream, p);
#else
    for (int ph = 0; ph < NPHASE; ++ph) { p.ph_lo = ph; p.ph_hi = ph + 1; hipLaunchKernelGGL(fwd_kernel, dim3(grid), dim3(NTHREADS), LDS_BYTES, stream, p); }
#endif
}
```

```cpp
#include <hip/hip_runtime.h>
#include <cstdio>
#include <cstdint>
#include <type_traits>

#ifndef DIAG
#define DIAG 0
#endif
#ifdef ONLY_PHASE
#define PH_ON(ph) ((ph) == ONLY_PHASE)
#else
#define PH_ON(ph) true
#endif
#ifndef ONE_LAUNCH
#define ONE_LAUNCH 1
#endif
#ifndef REP_WHAT
#define REP_WHAT 0
#endif
#ifndef FORCE_FAIL
#define FORCE_FAIL 0
#endif
#define REP(k, ...) do { int _nrep = (REP_WHAT == (k)) ? 2 : 1; if (REP_WHAT) asm volatile("" : "+s"(_nrep)); for (int _r = 0; _r < _nrep; ++_r) { __VA_ARGS__; } } while (0)

#define LAS __attribute__((address_space(3)))
typedef _Float16 f16;
typedef _Float16 h8 __attribute__((ext_vector_type(8)));
typedef _Float16 h4 __attribute__((ext_vector_type(4)));
typedef _Float16 h2 __attribute__((ext_vector_type(2)));
typedef float f32x2 __attribute__((ext_vector_type(2)));
typedef float f32x4 __attribute__((ext_vector_type(4)));
typedef float f32x16 __attribute__((ext_vector_type(16)));
typedef unsigned short u16;
typedef unsigned u32x2 __attribute__((ext_vector_type(2)));
typedef unsigned u32x4 __attribute__((ext_vector_type(4)));

constexpr int S = 16384, D = 1024, NPROJ = 3396, NPAD = 3584, NQ = 2048;
constexpr int NTHREADS = 512, NWAVES = 8;
constexpr int LDS_BYTES = 147456;
constexpr float EPS = 1e-6f;
constexpr float DSA_KV_SCALE = 4.0f;
constexpr float DSA_K_ISCALE = 16.0f;
#ifndef DSA_SWEEP
#define DSA_SWEEP 1
#endif
constexpr float PEER_U_SCALE = 1000.0f, PEER_V_SCALE = 8.0f;
constexpr size_t MBy = 1ull << 20;
constexpr size_t WS_CTL = 0, WS_LCNT = 16384, WS_MODP = 65536, WS_MOD = 458752, WS_KMEAN = 524288, WS_SEL = 1 * MBy, WS_IW = 2 * MBy, WS_NIDX = 3 * MBy,
    WS_WIN = 4 * MBy, WS_WOUT = 18 * MBy, WS_WQ = 22 * MBy, WS_SUBK = 30 * MBy, WS_U16 = 32 * MBy, WS_V16 = 96 * MBy, WS_H = 160 * MBy, WS_X1 = 192 * MBy,
    WS_QKV = 256 * MBy, WS_IQ = 352 * MBy, WS_IKRAW = 360 * MBy, WS_KN = 364 * MBy, WS_IDX = 366 * MBy, WS_LIST = 374 * MBy, WS_Y = 390 * MBy,
    WS_PQ = 422 * MBy, WS_EIDX = 486 * MBy, WS_EG = 494 * MBy, WS_END = 502 * MBy;
constexpr size_t CTL_ZERO_BYTES = 65536;

struct Params {
    const float* x; const float* c; const float* w_ada; const float* b_ada; const float* norm_attn; const float* norm_ffn; const float* w_in; const float* w_out;
    const float* rel_bias; const float* peer_wq; const float* peer_subkeys; const float* peer_u; const float* peer_v; const float* norm_final;
    float* out; unsigned char* ws; int ph_lo, ph_hi;
};

#define XB_TMO      128
#define XB_XCNT(j)  (256  + 64 * (j))
#define XB_XSUB(j)  (1280 + 64 * (j))
#define XB_XGEN(j)  (2304 + 64 * (j))
#define XB_TOP      3328
#define XB_TOPGEN   3392
#define XCD_BAR_WORDS 3456
#define XB_SPIN_CAP (1u << 25)
__device__ __forceinline__ unsigned xb_ld(unsigned* p)              { return __hip_atomic_load(p, __ATOMIC_RELAXED, __HIP_MEMORY_SCOPE_AGENT); }
__device__ __forceinline__ unsigned xb_add(unsigned* p, unsigned v) { return __hip_atomic_fetch_add(p, v, __ATOMIC_RELAXED, __HIP_MEMORY_SCOPE_AGENT); }
__device__ __forceinline__ unsigned xb_xcc_id() { return (unsigned)__builtin_amdgcn_s_getreg((3 << 11) | 20) & 0xFu; }
#define XB_SPIN(cond, bar) do { unsigned _sp = 0; while (cond) { __builtin_amdgcn_s_sleep(1); \
    if ((++_sp & 255u) == 0u) { if (xb_ld(&(bar)[XB_TMO])) break; if (_sp > XB_SPIN_CAP) { atomicAdd(&(bar)[XB_TMO], 1u); break; } } } } while (0)
struct XcdBarrier { unsigned* bar; unsigned x; volatile LAS unsigned* st; };
__device__ __forceinline__ XcdBarrier xcd_barrier_post(unsigned* bar, volatile LAS unsigned* st) {
    XcdBarrier b; b.bar = bar; b.x = xb_xcc_id(); b.st = st;
    if (threadIdx.x == 0) (void)xb_add(&bar[XB_XCNT(b.x)], 1u);
    return b;
}
__device__ __forceinline__ void xcd_barrier_complete(unsigned* bar, unsigned x, unsigned& nloc, unsigned& nx) {
    const unsigned G = gridDim.x * gridDim.y * gridDim.z;
    unsigned sum, cnt, mine, sp = 0u;
    for (;;) {
        sum = 0u; cnt = 0u; mine = 0u;
#pragma unroll
        for (unsigned j = 0; j < 16; ++j) { const unsigned c = xb_ld(&bar[XB_XCNT(j)]); sum += c; cnt += (c > 0u) ? 1u : 0u; mine = (j == x) ? c : mine; }
        if (sum == G) break;
        __builtin_amdgcn_s_sleep(1);
        if ((++sp & 255u) == 0u) { if (xb_ld(&bar[XB_TMO])) break; if (sp > XB_SPIN_CAP) { atomicAdd(&bar[XB_TMO], 1u); break; } }
    }
    nloc = mine > 0u ? mine : 1u; nx = cnt > 0u ? cnt : 1u;
}
__device__ __forceinline__ void xcd_barrier(const XcdBarrier& b) {
    asm volatile("s_waitcnt vmcnt(0)" ::: "memory");
    __syncthreads();
    if (threadIdx.x == 0) {
        unsigned* bar = b.bar;
        __builtin_amdgcn_s_waitcnt(0);
        unsigned nloc = b.st[0], nx = b.st[1];
        if (nloc == 0u) { xcd_barrier_complete(bar, b.x, nloc, nx); b.st[0] = nloc; b.st[1] = nx; }
        const unsigned old = xb_add(&bar[XB_XSUB(b.x)], 1u);
        const unsigned gen = old / nloc;
        if (old + 1u == (gen + 1u) * nloc) {
            __builtin_amdgcn_fence(__ATOMIC_RELEASE, "agent");
            asm volatile("s_waitcnt vmcnt(0)" ::: "memory");
            const unsigned og = xb_add(&bar[XB_TOP], 1u);
            const unsigned tg = og / nx;
            if (og + 1u == (tg + 1u) * nx) xb_add(&bar[XB_TOPGEN], 1u);
            else XB_SPIN(xb_ld(&bar[XB_TOPGEN]) == tg, bar);
            __builtin_amdgcn_fence(__ATOMIC_ACQUIRE, "agent");
            xb_add(&bar[XB_XGEN(b.x)], 1u);
            asm volatile("s_waitcnt vmcnt(0)" ::: "memory");
        } else {
            XB_SPIN(xb_ld(&bar[XB_XGEN(b.x)]) == gen, bar);
            __builtin_amdgcn_fence(__ATOMIC_ACQUIRE, "agent");
            asm volatile("s_waitcnt vmcnt(0)" ::: "memory");
        }
    }
    __syncthreads();
}

#define LAUNDER_S(x) asm volatile("" : "+s"(x) :: "memory")
#define LAUNDER_V(x) asm volatile("" : "+v"(x) :: "memory")
#define LAUNDER_P(ptr) do { int _z = 0; LAUNDER_S(_z); ptr = (decltype(ptr))((const char*)(ptr) + _z); } while (0)
__device__ __forceinline__ Params load_params() {
#if defined(__HIP_DEVICE_COMPILE__)
    int z = 0; LAUNDER_S(z);
    const Params* kp = (const Params*)((const char*)(const void*)__builtin_amdgcn_kernarg_segment_ptr() + z);
    return *kp;
#else
    return Params{};
#endif
}
__device__ __forceinline__ int phase_tid() { int t = threadIdx.x; LAUNDER_V(t); return t; }
__device__ __forceinline__ unsigned char* phase_ws(const unsigned char* w) { int z = 0; LAUNDER_S(z); return (unsigned char*)w + z; }
__device__ __forceinline__ float wave_sum(float v) {
#pragma unroll
    for (int o = 32; o >= 1; o >>= 1) v += __shfl_xor(v, o);
    return v;
}
__device__ __forceinline__ int t5_bucket(int d) {
    const float x = (float)d * 0.0625f;
    int k = (int)(2.0f * __log2f(x) + 1e-4f);
    k = k > 15 ? 15 : k;
    return d < 16 ? d : 16 + k;
}
__device__ __forceinline__ unsigned f2ord(float f) { const unsigned u = __float_as_uint(f); return (u & 0x80000000u) ? ~u : (u | 0x80000000u); }
__device__ __forceinline__ float ord2f(unsigned k) { const unsigned u = (k & 0x80000000u) ? (k & 0x7FFFFFFFu) : ~k; return __uint_as_float(u); }
__device__ __forceinline__ float dot8(h8 a, h8 b, float acc) {
    acc = __builtin_amdgcn_fdot2((h2){a[0], a[1]}, (h2){b[0], b[1]}, acc, false);
    acc = __builtin_amdgcn_fdot2((h2){a[2], a[3]}, (h2){b[2], b[3]}, acc, false);
    acc = __builtin_amdgcn_fdot2((h2){a[4], a[5]}, (h2){b[4], b[5]}, acc, false);
    acc = __builtin_amdgcn_fdot2((h2){a[6], a[7]}, (h2){b[6], b[7]}, acc, false);
    return acc;
}
__device__ __forceinline__ unsigned pack_fp8x4(float a, float b, float c, float d) {
    int w = __builtin_amdgcn_cvt_pk_fp8_f32(a, b, 0, false);
    w = __builtin_amdgcn_cvt_pk_fp8_f32(c, d, w, true);
    return (unsigned)w;
}
#ifndef CHECKS
#define CHECKS 0
#endif
constexpr size_t WS_FLAG = 32768;
__device__ __forceinline__ float wave_max(float v) {
#pragma unroll
    for (int o = 32; o >= 1; o >>= 1) v = fmaxf(v, __shfl_xor(v, o));
    return v;
}
__device__ __forceinline__ float wave_min(float v) {
#pragma unroll
    for (int o = 32; o >= 1; o >>= 1) v = fminf(v, __shfl_xor(v, o));
    return v;
}
__device__ __forceinline__ int wave_sumi(int v) {
#pragma unroll
    for (int o = 32; o >= 1; o >>= 1) v += __shfl_xor(v, o);
    return v;
}
__device__ __forceinline__ void set_flag(unsigned char* ws, unsigned bit) { atomicOr((unsigned*)(ws + WS_FLAG), bit); }
template <int CTRL> __device__ __forceinline__ float dpp_f(float v) { return __int_as_float(__builtin_amdgcn_update_dpp(0, __float_as_int(v), CTRL, 0xF, 0xF, false)); }
typedef __fp16 fp16x2_t __attribute__((ext_vector_type(2)));
__device__ __forceinline__ h2 pkrtz2(float a, float b) { const fp16x2_t r = __builtin_amdgcn_cvt_pkrtz(a, b); h2 o; __builtin_memcpy(&o, &r, 4); return o; }
__device__ __forceinline__ unsigned pack_i8x4(float a, float b, float c, float d, float scale) {
    int ia = __float2int_rn(a * scale), ib = __float2int_rn(b * scale), ic = __float2int_rn(c * scale), id = __float2int_rn(d * scale);
    ia = ia < -127 ? -127 : (ia > 127 ? 127 : ia); ib = ib < -127 ? -127 : (ib > 127 ? 127 : ib); ic = ic < -127 ? -127 : (ic > 127 ? 127 : ic); id = id < -127 ? -127 : (id > 127 ? 127 : id);
    return (unsigned)(ia & 0xFF) | ((unsigned)(ib & 0xFF) << 8) | ((unsigned)(ic & 0xFF) << 16) | ((unsigned)(id & 0xFF) << 24);
}
__device__ __forceinline__ float relu_i(float x) { const int b = __float_as_int(x); return __int_as_float(b > 0 ? b : 0); }
__device__ __forceinline__ float gelu_exact(float v) { return 0.5f * v * (1.0f + erff(v * 0.70710678118654752f)); }

namespace pg8 {
constexpr int BM = 256, BK = 64, HALF = 128, HTB = HALF * BK * 2, STAGE_BYTES = 8 * HTB, NXCD = 8, WGM = 8;
__host__ __device__ __forceinline__ int lds_byte(int r, int c) { const int st = (r >> 4) * 2 + (c >> 5), rr = r & 15, cc = c & 31, ob = rr * 64 + cc * 2; return st * 1024 + (ob ^ (((ob >> 9) & 1) << 5)); }
__host__ __device__ __forceinline__ void stage_rc(int b, int& R, int& C) { const int st = b / 1024, sb = b % 1024, swz = sb ^ (((sb >> 9) & 1) << 5); R = (st >> 1) * 16 + swz / 64; C = (st & 1) * 32 + (swz % 64) / 2; }
__host__ __device__ __forceinline__ int perm32(int rho) { const int n = rho >> 4, i = rho & 15; return 8 * (i >> 2) + 4 * n + (i & 3); }
struct Unit { int pm, pn; };
struct Gemm { const f16* A; const f16* Bt; int M, N, K; };
struct StaticOrder {
    int nM, nN, nwg, G, c;
    __device__ void init(int M, int N, int G_, int c_) { nM = M / BM; nN = N / BM; nwg = nM * nN; G = G_; c = c_; }
    __device__ bool next(int i, Unit& u) const {
        const long L = (long)i * G + c; if (L >= nwg) return false;
        int wgid = (int)L; { const int q = nwg / NXCD, r = nwg % NXCD, xcd = wgid % NXCD, off = wgid / NXCD; wgid = (xcd < r ? xcd * (q + 1) : r * (q + 1) + (xcd - r) * q) + off; }
        const int nig = WGM * nN, gid = wgid / nig, fm = gid * WGM, gsz = (nM - fm) < WGM ? (nM - fm) : WGM;
        u.pm = fm + ((wgid % nig) % gsz); u.pn = (wgid % nig) / gsz; return true;
    }
};

template <class Epi>
__device__ __forceinline__ void gemm_phase(LAS unsigned char* lds, const Gemm g, const StaticOrder& S_, const Epi& E) {
    const int tid = phase_tid(), wid = __builtin_amdgcn_readfirstlane(tid >> 6), lane = tid & 63, wr = wid >> 2, wc = wid & 3, fr = lane & 15, fq = lane >> 4;
    const int K = g.K, nt = K / BK;
    unsigned voffA[2], voffB[2];
#pragma unroll
    for (int i = 0; i < 2; ++i) { int R, C; stage_rc(tid * 16 + i * 8192, R, C); const int Rb = Epi::PERM ? ((R & ~31) + perm32(R & 31)) : R;
        voffA[i] = (unsigned)(R * K + C) * 2u; voffB[i] = (unsigned)(Rb * K + C) * 2u; }
    const size_t kstep = (size_t)(BK * 2);
    const size_t hstep = (size_t)HALF * K * 2;
    const size_t tstep = 2 * hstep;
    const unsigned ldsw = (unsigned)wid * 1024u;
    const int aoff = lds_byte(wr * 64 + fr, fq * 8), boff = lds_byte(wc * 32 + fr, fq * 8);
#define PG8_SA(b, h) (((b) * 2 + (h)) * HTB)
#define PG8_SB(b, h) ((4 + (b) * 2 + (h)) * HTB)
#define PG8_STAGE(bufoff, gbase, voff) do { _Pragma("unroll") for (int _i = 0; _i < 2; ++_i) \
        __builtin_amdgcn_global_load_lds((const unsigned*)((const char*)(gbase) + (voff)[_i]), (LAS unsigned*)(lds + (bufoff) + ldsw + _i * 8192), 16, 0, 0); } while (0)
#define PG8_LDA(dst, b, h) do { _Pragma("unroll") for (int m = 0; m < 4; ++m) _Pragma("unroll") for (int k = 0; k < 2; ++k) dst[m][k] = *(const LAS h8*)(lds + PG8_SA(b, h) + aoff + m * 2048 + k * 1024); } while (0)
#define PG8_LDB(dst, b, h) do { _Pragma("unroll") for (int n = 0; n < 2; ++n) _Pragma("unroll") for (int k = 0; k < 2; ++k) dst[n][k] = *(const LAS h8*)(lds + PG8_SB(b, h) + boff + n * 2048 + k * 1024); } while (0)
#define PG8_MMA(ai, bj, At, Bt) do { __builtin_amdgcn_s_setprio(1); _Pragma("unroll") for (int m = 0; m < 4; ++m) _Pragma("unroll") for (int n = 0; n < 2; ++n) _Pragma("unroll") for (int k = 0; k < 2; ++k) \
        acc[ai][bj][m][n] = __builtin_amdgcn_mfma_f32_16x16x32_f16(Bt[n][k], At[m][k], acc[ai][bj][m][n], 0, 0, 0); __builtin_amdgcn_s_setprio(0); } while (0)
#define PG8_WAIT_V(n) asm volatile("s_waitcnt vmcnt(" #n ")" ::: "memory")
#define PG8_WAIT_L(n) asm volatile("s_waitcnt lgkmcnt(" #n ")" ::: "memory")
#define PG8_BAR __builtin_amdgcn_s_barrier()
#define PG8_SCHED __builtin_amdgcn_sched_barrier(0)
    Unit cur, nxt; int ui = 0;
    if (!S_.next(0, cur)) return;
    f32x4 acc[2][2][4][2];
#pragma unroll
    for (int a = 0; a < 2; ++a)
#pragma unroll
        for (int b = 0; b < 2; ++b)
#pragma unroll
            for (int m = 0; m < 4; ++m)
#pragma unroll
                for (int n = 0; n < 2; ++n) acc[a][b][m][n] = (f32x4){0.f, 0.f, 0.f, 0.f};
    h8 At[4][2], B0[2][2], B1[2][2];
    const char* cA = (const char*)g.A + (size_t)cur.pm * tstep; const char* cB = (const char*)g.Bt + (size_t)cur.pn * tstep;
    PG8_STAGE(PG8_SB(0, 0), cB, voffB); PG8_STAGE(PG8_SA(0, 0), cA, voffA); PG8_STAGE(PG8_SB(0, 1), cB + hstep, voffB); PG8_STAGE(PG8_SA(0, 1), cA + hstep, voffA);
    if (wr == 1) PG8_BAR;
    PG8_WAIT_V(4); PG8_BAR;
    PG8_STAGE(PG8_SB(1, 0), cB + kstep, voffB); PG8_STAGE(PG8_SA(1, 0), cA + kstep, voffA); PG8_STAGE(PG8_SB(1, 1), cB + hstep + kstep, voffB);
    PG8_WAIT_V(6); PG8_BAR;
    for (;;) {
        const bool has_next = S_.next(ui + 1, nxt);
        const char* nA = has_next ? (const char*)g.A + (size_t)nxt.pm * tstep : cA; const char* nB = has_next ? (const char*)g.Bt + (size_t)nxt.pn * tstep : cB;
        for (int t = 0; t < nt; t += 2) {
            const bool last = (t == nt - 2);
            const char* a1 = cA + (size_t)(t + 1) * kstep;
            const char* a2 = last ? nA : cA + (size_t)(t + 2) * kstep; const char* b2 = last ? nB : cB + (size_t)(t + 2) * kstep;
            const char* a3 = a2 + kstep; const char* b3 = b2 + kstep;
            PG8_LDB(B0, 0, 0); PG8_SCHED; PG8_LDA(At, 0, 0); PG8_STAGE(PG8_SA(1, 1), a1 + hstep, voffA);
            PG8_WAIT_L(8); PG8_BAR; PG8_WAIT_L(0); PG8_MMA(0, 0, At, B0); PG8_BAR; PG8_SCHED;
            PG8_LDB(B1, 0, 1); PG8_STAGE(PG8_SB(0, 0), b2, voffB);
            PG8_BAR; PG8_WAIT_L(0); PG8_MMA(0, 1, At, B1); PG8_BAR;
            PG8_LDA(At, 0, 1); PG8_STAGE(PG8_SA(0, 0), a2, voffA);
            PG8_BAR; PG8_WAIT_L(0); PG8_MMA(1, 0, At, B0); PG8_BAR; PG8_SCHED;
            PG8_STAGE(PG8_SB(0, 1), b2 + hstep, voffB);
            PG8_WAIT_V(6); PG8_BAR; PG8_MMA(1, 1, At, B1); PG8_BAR;
            PG8_LDB(B0, 1, 0); PG8_SCHED; PG8_LDA(At, 1, 0); PG8_STAGE(PG8_SA(0, 1), a2 + hstep, voffA);
            PG8_WAIT_L(8); PG8_BAR; PG8_WAIT_L(0); PG8_MMA(0, 0, At, B0); PG8_BAR; PG8_SCHED;
            PG8_LDB(B1, 1, 1); PG8_STAGE(PG8_SB(1, 0), b3, voffB);
            PG8_BAR; PG8_WAIT_L(0); PG8_MMA(0, 1, At, B1); PG8_BAR;
            PG8_LDA(At, 1, 1); PG8_STAGE(PG8_SA(1, 0), a3, voffA);
            PG8_BAR; PG8_WAIT_L(0); PG8_MMA(1, 0, At, B0); PG8_BAR; PG8_SCHED;
            PG8_STAGE(PG8_SB(1, 1), b3 + hstep, voffB);
            PG8_WAIT_V(6); PG8_BAR; PG8_MMA(1, 1, At, B1); PG8_BAR;
        }
        E(acc, cur, wr, wc, fr, fq);
        if (!has_next) break;
#pragma unroll
        for (int a = 0; a < 2; ++a)
#pragma unroll
            for (int b = 0; b < 2; ++b)
#pragma unroll
                for (int m = 0; m < 4; ++m)
#pragma unroll
                    for (int n = 0; n < 2; ++n) acc[a][b][m][n] = (f32x4){0.f, 0.f, 0.f, 0.f};
        cur = nxt; cA = nA; cB = nB; ++ui;
    }
    PG8_WAIT_V(0);
    if (wr == 0) PG8_BAR;
    PG8_BAR;
#undef PG8_SA
#undef PG8_SB
#undef PG8_STAGE
#undef PG8_LDA
#undef PG8_LDB
#undef PG8_MMA
#undef PG8_WAIT_V
#undef PG8_WAIT_L
#undef PG8_BAR
#undef PG8_SCHED
}
}

struct EpiIn {
    static constexpr bool PERM = true;
    f16* QKV; f16* IQ; float* IKRAW; float* IW;
    __device__ __forceinline__ void operator()(const f32x4 (&acc)[2][2][4][2], const pg8::Unit& u, int wr, int wc, int fr, int fq) const {
#pragma unroll
        for (int bj = 0; bj < 2; ++bj) {
            const int cb = u.pn * 256 + bj * 128 + wc * 32;
            if (cb >= NPROJ) continue;
            const int c0 = cb + 8 * fq;
#pragma unroll
            for (int ai = 0; ai < 2; ++ai)
#pragma unroll
                for (int m = 0; m < 4; ++m) {
                    const int r = u.pm * 256 + ai * 128 + wr * 64 + m * 16 + fr;
                    const f32x4 v0 = acc[ai][bj][m][0], v1 = acc[ai][bj][m][1];
                    if (cb < 3072) {
                        const int g = cb >> 9, hh = (cb & 511) >> 6, d = (c0 & 63);
                        if (g >= 4) {
                            unsigned char* dst = (unsigned char*)(QKV + (size_t)4 * 8 * S * 64) + ((size_t)hh * S + r) * 128 + (g - 4) * 64 + d;
                            u32x2 o;
                            if (g == 4) { o[0] = pack_i8x4(v0[0], v0[1], v0[2], v0[3], DSA_K_ISCALE); o[1] = pack_i8x4(v1[0], v1[1], v1[2], v1[3], DSA_K_ISCALE); }
                            else { o[0] = pack_fp8x4(v0[0] * DSA_KV_SCALE, v0[1] * DSA_KV_SCALE, v0[2] * DSA_KV_SCALE, v0[3] * DSA_KV_SCALE);
                                   o[1] = pack_fp8x4(v1[0] * DSA_KV_SCALE, v1[1] * DSA_KV_SCALE, v1[2] * DSA_KV_SCALE, v1[3] * DSA_KV_SCALE); }
                            *(u32x2*)dst = o;
                        } else if (g != 2) {
                            h8 o; o[0] = (f16)v0[0]; o[1] = (f16)v0[1]; o[2] = (f16)v0[2]; o[3] = (f16)v0[3]; o[4] = (f16)v1[0]; o[5] = (f16)v1[1]; o[6] = (f16)v1[2]; o[7] = (f16)v1[3];
                            *(h8*)(QKV + ((size_t)(g * 8 + hh) * S + r) * 64 + d) = o;
                        } else {
                            f16* base = QKV + ((size_t)(2 * 8 + hh) * 64 + d) * S + r;
#pragma unroll
                            for (int i = 0; i < 4; ++i) { base[(size_t)i * S] = (f16)v0[i]; base[(size_t)(i + 4) * S] = (f16)v1[i]; }
                        }
                    } else if (cb < 3328) {
                        h8 o; o[0] = (f16)v0[0]; o[1] = (f16)v0[1]; o[2] = (f16)v0[2]; o[3] = (f16)v0[3]; o[4] = (f16)v1[0]; o[5] = (f16)v1[1]; o[6] = (f16)v1[2]; o[7] = (f16)v1[3];
                        *(h8*)(IQ + (size_t)r * 256 + (c0 - 3072)) = o;
                    } else if (cb < 3392) {
                        float* dst = IKRAW + (size_t)r * 64 + (c0 - 3328);
                        *(f32x4*)dst = v0; *(f32x4*)(dst + 4) = v1;
                    } else {
                        if (fq == 0) *(f32x4*)(IW + (size_t)r * 4) = v0 * 0.5f;
                    }
                }
        }
    }
};
struct EpiOut {
    static constexpr bool PERM = false;
    const float* Xin; float* X1; const float* g1;
    __device__ __forceinline__ void operator()(const f32x4 (&acc)[2][2][4][2], const pg8::Unit& u, int wr, int wc, int fr, int fq) const {
#pragma unroll
        for (int bj = 0; bj < 2; ++bj)
#pragma unroll
            for (int n = 0; n < 2; ++n) {
                const int c = u.pn * 256 + bj * 128 + wc * 32 + 16 * n + 4 * fq;
                const f32x4 gv = *(const f32x4*)(g1 + c);
#pragma unroll
                for (int ai = 0; ai < 2; ++ai)
#pragma unroll
                    for (int m = 0; m < 4; ++m) {
                        const int r = u.pm * 256 + ai * 128 + wr * 64 + m * 16 + fr;
                        const f32x4 xv = *(const f32x4*)(Xin + (size_t)r * D + c);
                        *(f32x4*)(X1 + (size_t)r * D + c) = (DIAG == 1) ? xv : (xv + gv * acc[ai][bj][m][n]);
                    }
            }
    }
};
struct EpiPQ {
    static constexpr bool PERM = true;
    f16* PQ;
    __device__ __forceinline__ void operator()(const f32x4 (&acc)[2][2][4][2], const pg8::Unit& u, int wr, int wc, int fr, int fq) const {
#pragma unroll
        for (int bj = 0; bj < 2; ++bj) {
            const int c0 = u.pn * 256 + bj * 128 + wc * 32 + 8 * fq;
#pragma unroll
            for (int ai = 0; ai < 2; ++ai)
#pragma unroll
                for (int m = 0; m < 4; ++m) {
                    const int r = u.pm * 256 + ai * 128 + wr * 64 + m * 16 + fr;
                    const f32x4 v0 = acc[ai][bj][m][0], v1 = acc[ai][bj][m][1];
                    h8 o; o[0] = (f16)v0[0]; o[1] = (f16)v0[1]; o[2] = (f16)v0[2]; o[3] = (f16)v0[3]; o[4] = (f16)v1[0]; o[5] = (f16)v1[1]; o[6] = (f16)v1[2]; o[7] = (f16)v1[3];
                    *(h8*)(PQ + (size_t)r * NQ + c0) = o;
                }
        }
    }
};

__device__ __forceinline__ void transpose_tile(const float* __restrict__ src, int K, int N, f16* __restrict__ dst, int k0, int n0, LAS f16* tile) {
    const int tid = phase_tid();
    { const int kk = tid >> 4, n4 = (tid & 15) * 4;
#pragma unroll
      for (int p = 0; p < 2; ++p) { const int k = k0 + kk + 32 * p, n = n0 + n4;
          f32x4 v = (f32x4){0.f, 0.f, 0.f, 0.f}; if (n < N) v = *(const f32x4*)(src + (size_t)k * N + n);
#pragma unroll
          for (int i = 0; i < 4; ++i) tile[(n4 + i) * 72 + kk + 32 * p] = (f16)v[i]; } }
    __syncthreads();
    { const int nn = tid >> 3, k8 = (tid & 7) * 8;
      const h8 v = *(const LAS h8*)(tile + nn * 72 + k8);
      *(h8*)(dst + (size_t)(n0 + nn) * K + k0 + k8) = v; }
    __syncthreads();
}
__device__ __forceinline__ void convert_chunk(const float* __restrict__ src, f16* __restrict__ dst, size_t base, int ptid) {
    const size_t o = base + (size_t)ptid * 8;
    const f32x4 a = *(const f32x4*)(src + o), b = *(const f32x4*)(src + o + 4);
    h8 v; v[0] = (f16)a[0]; v[1] = (f16)a[1]; v[2] = (f16)a[2]; v[3] = (f16)a[3]; v[4] = (f16)b[0]; v[5] = (f16)b[1]; v[6] = (f16)b[2]; v[7] = (f16)b[3];
    *(h8*)(dst + o) = v;
}
template <bool I8>
__device__ __forceinline__ void convert_chunk_fp8(const float* __restrict__ src, unsigned char* __restrict__ dst, size_t base, int ptid, float scale) {
    f32x4 a[4], b[4];
#pragma unroll
    for (int c = 0; c < 4; ++c) { const size_t o = base + (size_t)c * 4096 + (size_t)ptid * 8; a[c] = __builtin_nontemporal_load((const f32x4*)(src + o)); b[c] = __builtin_nontemporal_load((const f32x4*)(src + o + 4)); }
#pragma unroll
    for (int c = 0; c < 4; ++c) { const size_t o = base + (size_t)c * 4096 + (size_t)ptid * 8; const f32x4 x = a[c] * scale, y = b[c] * scale;
        u32x2 v;
        if (I8) { v[0] = pack_i8x4(a[c][0], a[c][1], a[c][2], a[c][3], scale); v[1] = pack_i8x4(b[c][0], b[c][1], b[c][2], b[c][3], scale); }
        else { v[0] = pack_fp8x4(x[0], x[1], x[2], x[3]); v[1] = pack_fp8x4(y[0], y[1], y[2], y[3]); }
        *(u32x2*)(dst + o) = v; }
}
__device__ __forceinline__ void phase_prologue(const Params& p_, LAS unsigned char* lds) {
    const Params p = load_params(); (void)p_;
    unsigned char* ws = phase_ws(p.ws); const int ptid = phase_tid();
    const int G = gridDim.x;
    constexpr int N_TR = 2 * 1664, N_SUBK = 128, N_UV = 2048, N_MOD = 192;
    constexpr int TOTAL = N_TR + N_SUBK + 2 * N_UV + N_MOD;
    for (int it = blockIdx.x; it < TOTAL; it += G) {
        if (it < N_MOD) {
            const int kc = it / 24, cg = it % 24, e = cg * 512 + ptid, l = e / 6144, ee = e % 6144;
            float acc = 0.f;
#pragma unroll 16
            for (int d = kc * 128; d < kc * 128 + 128; ++d) { const float cv = p.c[d]; const float sv = cv / (1.0f + __expf(-cv)); acc += sv * p.w_ada[((size_t)l * D + d) * 6144 + ee]; }
            ((float*)(ws + WS_MODP))[kc * 12288 + e] = acc;
        } else if (it < N_MOD + N_TR) {
            int j = it - N_MOD; const int l = j / 1664; j %= 1664;
            if (j < 896) { const int kt = j / 56, ntile = j % 56; transpose_tile(p.w_in + (size_t)l * D * NPROJ, D, NPROJ, (f16*)(ws + WS_WIN) + (size_t)l * NPAD * D, kt * 64, ntile * 64, (LAS f16*)lds); }
            else if (j < 896 + 256) { j -= 896; const int kt = j / 16, ntile = j % 16; transpose_tile(p.w_out + (size_t)l * D * D, D, D, (f16*)(ws + WS_WOUT) + (size_t)l * D * D, kt * 64, ntile * 64, (LAS f16*)lds); }
            else { j -= 1152; const int kt = j / 32, ntile = j % 32; transpose_tile(p.peer_wq + (size_t)l * D * NQ, D, NQ, (f16*)(ws + WS_WQ) + (size_t)l * NQ * D, kt * 64, ntile * 64, (LAS f16*)lds); }
        } else if (it < N_MOD + N_TR + N_SUBK) {
            convert_chunk(p.peer_subkeys, (f16*)(ws + WS_SUBK), (size_t)(it - N_MOD - N_TR) * 4096, ptid);
        } else if (it < N_MOD + N_TR + N_SUBK + N_UV) {
            convert_chunk_fp8<true>(p.peer_u, ws + WS_U16, (size_t)(it - N_MOD - N_TR - N_SUBK) * 16384, ptid, PEER_U_SCALE);
        } else {
            convert_chunk_fp8<false>(p.peer_v, ws + WS_V16, (size_t)(it - N_MOD - N_TR - N_SUBK - N_UV) * 16384, ptid, PEER_V_SCALE);
        }
    }
}
__device__ __forceinline__ float modv_partial(const Params& p, int e) {
    const float* mp = (const float*)(p.ws + WS_MODP);
    float v = p.b_ada[e];
#pragma unroll
    for (int kc = 0; kc < 8; ++kc) v += mp[kc * 12288 + e];
    return v;
}

template <bool FROM_PARTIAL>
__device__ __forceinline__ void phase_norm(const Params& p_, LAS unsigned char* lds, int l, int which) {
    const Params p = load_params(); (void)p_;
    const int shc = which ? 3 : 0, scc = which ? 4 : 1;
    LAS float* sh = (LAS float*)lds; LAS float* sc = sh + 1024; LAS float* nwl = sc + 1024;
    unsigned char* ws = phase_ws(p.ws); const int ptid = phase_tid();
    const float* X = which ? (const float*)(ws + WS_X1) : p.x; const float* nw = (which ? p.norm_ffn : p.norm_attn) + l * 1024;
    float* MOD = (float*)(ws + WS_MOD);
    if (FROM_PARTIAL) {
        for (int e = blockIdx.x * NTHREADS + ptid; e < 12288; e += gridDim.x * NTHREADS) MOD[e] = modv_partial(p, e);
        for (int i = ptid; i < 1024; i += NTHREADS) { sh[i] = modv_partial(p, l * 6144 + shc * 1024 + i); sc[i] = modv_partial(p, l * 6144 + scc * 1024 + i); nwl[i] = nw[i]; }
    } else {
        for (int i = ptid; i < 1024; i += NTHREADS) { sh[i] = MOD[l * 6144 + shc * 1024 + i]; sc[i] = MOD[l * 6144 + scc * 1024 + i]; nwl[i] = nw[i]; }
    }
    __syncthreads();
    f16* H = (f16*)(ws + WS_H);
    const int lane = ptid & 63, gw = blockIdx.x * NWAVES + (ptid >> 6);
    for (int t = gw; t < S; t += gridDim.x * NWAVES) {
        f32x4 v[4]; float ss = 0.f;
#pragma unroll
        for (int i = 0; i < 4; ++i) { v[i] = *(const f32x4*)(X + (size_t)t * D + 256 * i + 4 * lane); ss += v[i][0] * v[i][0] + v[i][1] * v[i][1] + v[i][2] * v[i][2] + v[i][3] * v[i][3]; }
        ss = wave_sum(ss);
        const float r = rsqrtf(ss * (1.0f / D) + EPS);
#pragma unroll
        for (int i = 0; i < 4; ++i) { const int c = 256 * i + 4 * lane; h4 o;
#pragma unroll
            for (int j = 0; j < 4; ++j) o[j] = (f16)((v[i][j] * r * nwl[c + j]) * (1.0f + sc[c + j]) + sh[c + j]);
            *(h4*)(H + (size_t)t * D + c) = o; }
    }
    __syncthreads();
}

__device__ __forceinline__ void phase_prep(const Params& p_, LAS unsigned char* lds) {
    const Params p = load_params(); (void)p_;
    unsigned char* ws = phase_ws(p.ws); const int ptid = phase_tid();
    const int lane = ptid & 63, wave = ptid >> 6, gw = blockIdx.x * NWAVES + wave;
    const float* IKRAW = (const float*)(ws + WS_IKRAW); f16* KN = (f16*)(ws + WS_KN);
    for (int t = gw; t < S; t += gridDim.x * NWAVES) {
        const float v = IKRAW[(size_t)t * 64 + lane];
        const float ss = wave_sum(v * v);
        KN[(size_t)t * 64 + lane] = (f16)(v * rsqrtf(ss * (1.0f / 64) + EPS));
    }
    const f16* MK = (const f16*)(ws + WS_QKV) + (size_t)1 * 8 * S * 64;
    float* KMEAN = (float*)(ws + WS_KMEAN);
    LAS float* red = (LAS float*)lds;
    for (int it = blockIdx.x; it < 512; it += gridDim.x) {
        const int h = it >> 6, j = it & 63;
        const f16* base = MK + ((size_t)h * S + (size_t)j * 256 + wave * 32) * 64 + lane;
        float a = 0.f;
        for (int r = 0; r < 32; ++r) a += (float)base[(size_t)r * 64];
        red[wave * 64 + lane] = a;
        __syncthreads();
        if (wave == 0) { float s = 0.f;
#pragma unroll
            for (int w = 0; w < 8; ++w) s += red[w * 64 + lane];
            KMEAN[(size_t)it * 64 + lane] = s * (1.0f / 256.0f); }
        __syncthreads();
    }
}

__device__ __forceinline__ void phase_gate(const Params& p_, LAS unsigned char* lds, int layer, bool dry = false) {
    const Params p = load_params(); (void)p_;
    unsigned char* ws = phase_ws(p.ws); const int ptid = phase_tid();
    const f16* MQ = (const f16*)(ws + WS_QKV);
    const float* KMEAN = (const float*)(ws + WS_KMEAN);
    int* SEL = (int*)(ws + WS_SEL);
    unsigned* LCNT = (unsigned*)(ws + WS_LCNT) + layer * 512;
    u16* LIST = (u16*)(ws + WS_LIST);
    LAS float* km = (LAS float*)lds;
    for (int it = blockIdx.x; it < 256; it += gridDim.x) {
        const int h = it >> 5, t = (it & 31) * 512 + ptid, b0 = t >> 8;
        __syncthreads();
        for (int i = ptid; i < 4096; i += NTHREADS) km[i] = KMEAN[(size_t)h * 4096 + i];
        __syncthreads();
        float q[64];
        { const f16* qp = MQ + ((size_t)h * S + t) * 64;
#pragma unroll
          for (int i = 0; i < 8; ++i) { const h8 v = *(const h8*)(qp + 8 * i);
#pragma unroll
              for (int j = 0; j < 8; ++j) q[8 * i + j] = (float)v[j]; } }
        float v0 = -INFINITY, v1 = -INFINITY, v2 = -INFINITY; int s0 = -1, s1 = -1, s2 = -1;
        const int b0u = __builtin_amdgcn_readfirstlane(b0);
        for (int n = 0; n < b0u; ++n) {
            float g = 0.f;
#pragma unroll
            for (int d4 = 0; d4 < 16; ++d4) { const f32x4 kv = *(const LAS f32x4*)(km + n * 64 + 4 * d4);
                g += q[4 * d4] * kv[0]; g += q[4 * d4 + 1] * kv[1]; g += q[4 * d4 + 2] * kv[2]; g += q[4 * d4 + 3] * kv[3]; }
            if (g > v0) { v2 = v1; s2 = s1; v1 = v0; s1 = s0; v0 = g; s0 = n; }
            else if (g > v1) { v2 = v1; s2 = s1; v1 = g; s1 = n; }
            else if (g > v2) { v2 = g; s2 = n; }
        }
        if (dry) { if (s0 == 12345) SEL[0] = 0; continue; }
        SEL[(size_t)h * S + t] = (s0 & 0xFF) | ((s1 & 0xFF) << 8) | ((s2 & 0xFF) << 16);
        if (s0 >= 0) { const unsigned pos = atomicAdd(&LCNT[h * 64 + s0], 1u); LIST[((size_t)(h * 64 + s0)) * S + pos] = (u16)(t | (0 << 14)); }
        if (s1 >= 0) { const unsigned pos = atomicAdd(&LCNT[h * 64 + s1], 1u); LIST[((size_t)(h * 64 + s1)) * S + pos] = (u16)(t | (1 << 14)); }
        if (s2 >= 0) { const unsigned pos = atomicAdd(&LCNT[h * 64 + s2], 1u); LIST[((size_t)(h * 64 + s2)) * S + pos] = (u16)(t | (2 << 14)); }
    }
    __syncthreads();
}

constexpr int TK_CAP = 1280, TK_TRIG = 1024, TK_K = 256, TK_E = TK_CAP / 64;
template <int E>
__device__ __forceinline__ void topk_compact(LAS float* val, LAS u16* idx, LAS unsigned* cnt, LAS float* tau, int lane, const int K = TK_K) {
    const int n = (int)*cnt;
    unsigned key[E]; unsigned id[E];
    unsigned kmin = 0xFFFFFFFFu, kmax = 0u;
    float vraw[E]; unsigned iraw[E];
#pragma unroll
    for (int i = 0; i < E; ++i) { vraw[i] = val[lane + 64 * i]; iraw[i] = (unsigned)idx[lane + 64 * i]; }
#pragma unroll
    for (int i = 0; i < E; ++i) { const int e = lane + 64 * i; const bool ok = e < n; key[i] = ok ? f2ord(vraw[i]) : 0u; id[i] = ok ? iraw[i] : 0xFFFFu;
        kmax = key[i] > kmax ? key[i] : kmax; const unsigned km = ok ? key[i] : 0xFFFFFFFFu; kmin = km < kmin ? km : kmin; }
#pragma unroll
    for (int o = 32; o >= 1; o >>= 1) { const unsigned a = (unsigned)__shfl_xor((int)kmax, o), b = (unsigned)__shfl_xor((int)kmin, o); kmax = a > kmax ? a : kmax; kmin = b < kmin ? b : kmin; }
    unsigned lo = kmin, hi = kmax + 1u;
    while (hi - lo > 1u) {
        const unsigned mid = lo + ((hi - lo) >> 1);
        int c = 0;
#pragma unroll
        for (int i = 0; i < E; ++i) c += __popcll(__ballot(key[i] >= mid));
        if (c >= K) lo = mid; else hi = mid;
    }
    const unsigned vstar = lo;
    int cgt = 0, ceq = 0;
#pragma unroll
    for (int i = 0; i < E; ++i) { cgt += __popcll(__ballot(key[i] > vstar)); ceq += __popcll(__ballot(key[i] == vstar)); }
    const int r = K - cgt;
    unsigned istar = 0xFFFFu;
    if (ceq > r) {
        unsigned ilo = 0u, ihi = 0xFFFFu;
        while (ilo < ihi) {
            const unsigned mid = (ilo + ihi) >> 1;
            int c = 0;
#pragma unroll
            for (int i = 0; i < E; ++i) c += __popcll(__ballot(key[i] == vstar && id[i] <= mid));
            if (c >= r) ihi = mid; else ilo = mid + 1u;
        }
        istar = ilo;
    }
    int base = 0;
    const unsigned long long lt = (1ull << lane) - 1ull;
#pragma unroll
    for (int i = 0; i < E; ++i) {
        const bool keep = key[i] > vstar || (key[i] == vstar && id[i] <= istar);
        const unsigned long long bal = __ballot(keep);
        if (keep) { const int pos = base + __popcll(bal & lt); val[pos] = ord2f(key[i]); idx[pos] = (u16)id[i]; }
        base += __popcll(bal);
    }
    if (lane == 0) { *cnt = (unsigned)base; *tau = ord2f(vstar); }
}
__device__ __forceinline__ int topk_compact_approx(LAS float* val, LAS u16* idx, LAS unsigned* cnt, LAS float* tau, LAS unsigned* hist, int lane, const int K = TK_K) {
    const int n = (int)*cnt;
    unsigned key[TK_E]; unsigned id[TK_E];
    unsigned kmin = 0xFFFFFFFFu, kmax = 0u;
    float vraw[TK_E]; unsigned iraw[TK_E];
#pragma unroll
    for (int i = 0; i < TK_E; ++i) { vraw[i] = val[lane + 64 * i]; iraw[i] = (unsigned)idx[lane + 64 * i]; }
#pragma unroll
    for (int i = 0; i < TK_E; ++i) { const int e = lane + 64 * i; const bool ok = e < n; key[i] = ok ? f2ord(vraw[i]) : 0u; id[i] = ok ? iraw[i] : 0xFFFFu;
        kmax = key[i] > kmax ? key[i] : kmax; const unsigned km = ok ? key[i] : 0xFFFFFFFFu; kmin = km < kmin ? km : kmin; }
#pragma unroll
    for (int o = 32; o >= 1; o >>= 1) { const unsigned a = (unsigned)__shfl_xor((int)kmax, o), b = (unsigned)__shfl_xor((int)kmin, o); kmax = a > kmax ? a : kmax; kmin = b < kmin ? b : kmin; }
    const unsigned R = kmax - kmin;
    const int sh = (R >> 8) ? (32 - __clz((int)(R >> 8))) : 0;
#pragma unroll
    for (int j = 0; j < 4; ++j) hist[4 * lane + j] = 0u;
    __builtin_amdgcn_wave_barrier();
#pragma unroll
    for (int i = 0; i < TK_E; ++i) if (lane + 64 * i < n) __hip_atomic_fetch_add(&hist[(key[i] - kmin) >> sh], 1u, __ATOMIC_RELAXED, __HIP_MEMORY_SCOPE_WORKGROUP);
    __builtin_amdgcn_wave_barrier();
    unsigned hb[4];
#pragma unroll
    for (int j = 0; j < 4; ++j) hb[j] = hist[4 * lane + j];
    unsigned lsum = hb[0] + hb[1] + hb[2] + hb[3];
    unsigned above = lsum;
#pragma unroll
    for (int o = 1; o < 64; o <<= 1) { const unsigned v = (unsigned)__shfl_down((int)above, o); if (lane + o < 64) above += v; }
    const unsigned excl = above - lsum;
    unsigned sfx[4];
    sfx[3] = excl + hb[3]; sfx[2] = sfx[3] + hb[2]; sfx[1] = sfx[2] + hb[1]; sfx[0] = sfx[1] + hb[0];
    int mybin = -1;
#pragma unroll
    for (int j = 0; j < 4; ++j) if (sfx[j] >= (unsigned)K) mybin = 4 * lane + j;
    int b = mybin;
#pragma unroll
    for (int o = 32; o >= 1; o >>= 1) { const int v = __shfl_xor(b, o); b = v > b ? v : b; }
    const unsigned edge = kmin + ((unsigned)b << sh);
    int base = 0;
    const unsigned long long lt = (1ull << lane) - 1ull;
#pragma unroll
    for (int i = 0; i < TK_E; ++i) {
        const bool keep = key[i] >= edge && (lane + 64 * i < n);
        const unsigned long long bal = __ballot(keep);
        if (keep) { const int pos = base + __popcll(bal & lt); val[pos] = ord2f(key[i]); idx[pos] = (u16)id[i]; }
        base += __popcll(bal);
    }
    if (lane == 0) { *cnt = (unsigned)base; *tau = ord2f(edge - 1u); }
    return base;
}
__device__ __forceinline__ void phase_topk(const Params& p_, LAS unsigned char* lds, int layer) {
    const Params p = load_params(); (void)p_;
    unsigned char* ws = phase_ws(p.ws); const int ptid = phase_tid();
    const f16* IQ = (const f16*)(ws + WS_IQ); const f16* KN = (const f16*)(ws + WS_KN); const float* IW = (const float*)(ws + WS_IW);
    u16* IDX = (u16*)(ws + WS_IDX); int* NIDX = (int*)(ws + WS_NIDX);
    LAS float* val = (LAS float*)lds;
    LAS u16* idx = (LAS u16*)(lds + 16 * TK_CAP * 4);
    LAS unsigned* cnt = (LAS unsigned*)(lds + 16 * TK_CAP * 6);
    LAS float* tau = (LAS float*)(lds + 16 * TK_CAP * 6 + 64);
    LAS unsigned* flg = (LAS unsigned*)(lds + 16 * TK_CAP * 6 + 128);
    LAS unsigned* hist = (LAS unsigned*)(lds + 16 * TK_CAP * 6 + 1024) + 256 * (ptid >> 6);
    static_assert(16 * TK_CAP * 6 + 1024 + 8 * 1024 <= LDS_BYTES - 16, "topk LDS");
    LAS unsigned* specd = (LAS unsigned*)(lds + 16 * TK_CAP * 6 + 256);
    LAS unsigned* failq = (LAS unsigned*)(lds + 16 * TK_CAP * 6 + 320);
    const int tid = ptid, lane = tid & 63, wave = __builtin_amdgcn_readfirstlane(tid >> 6), half = lane >> 5, l31 = lane & 31;
    unsigned* tctr = (unsigned*)(ws + WS_CTL + 41472) + layer;
    LAS int* tsl = (LAS int*)(lds + 16 * TK_CAP * 6 + 512);
    for (;;) {
        __syncthreads();
        if (tid == 0) tsl[0] = (int)__hip_atomic_fetch_add(tctr, 1u, __ATOMIC_RELAXED, __HIP_MEMORY_SCOPE_AGENT);
        __syncthreads();
        const int ti = tsl[0];
        if (ti >= 1024) break;
        const int tile = 1023 - ti;
        const int t0 = tile * 16;
        __syncthreads();
        if (tid < 16) { cnt[tid] = 0u; tau[tid] = -INFINITY; specd[tid] = 0u; failq[tid] = 0u; }
        if (tid == 16) failq[16] = 0u;
        if (tid < 3) flg[tid] = 0u;
        h8 a[2][4];
#pragma unroll
        for (int mt = 0; mt < 2; ++mt)
#pragma unroll
            for (int kk = 0; kk < 4; ++kk) a[mt][kk] = *(const h8*)(IQ + (size_t)(t0 + mt * 8 + (l31 >> 2)) * 256 + (l31 & 3) * 64 + 16 * kk + 8 * half);
        float wq[2][4][4];
#pragma unroll
        for (int mt = 0; mt < 2; ++mt)
#pragma unroll
            for (int j = 0; j < 4; ++j) { const f32x4 w = *(const f32x4*)(IW + (size_t)(t0 + mt * 8 + 2 * j + half) * 4);
                wq[mt][j][0] = w[0]; wq[mt][j][1] = w[1]; wq[mt][j][2] = w[2]; wq[mt][j][3] = w[3]; }
        const int nkt = (t0 + 15) / 256 + 1;
        for (int pass = 0; pass < 2; ++pass) {
        if (pass == 1) {
            __syncthreads();
            if (failq[16] == 0u) break;
            __syncthreads();
            if (tid < 16) { const bool f = failq[tid] != 0u; cnt[tid] = 0u; tau[tid] = f ? -INFINITY : INFINITY; }
            if (tid < 3) flg[tid] = 0u;
        }
        h8 bnx[4];
#pragma unroll
        for (int kk = 0; kk < 4; ++kk) bnx[kk] = *(const h8*)(KN + (size_t)(32 * wave + l31) * 64 + 16 * kk + 8 * half);
        __syncthreads();
        int par = 0;
        for (int kt = 0; kt < nkt; ++kt) {
            const int kb = kt * 256 + 32 * wave;
            const int s = kb + l31;
            h8 bfr[4];
#pragma unroll
            for (int kk = 0; kk < 4; ++kk) bfr[kk] = bnx[kk];
            if (kt + 1 < nkt) {
#pragma unroll
                for (int kk = 0; kk < 4; ++kk) bnx[kk] = *(const h8*)(KN + (size_t)(s + 256) * 64 + 16 * kk + 8 * half);
            }
            float tq[2][4];
#pragma unroll
            for (int mt = 0; mt < 2; ++mt)
#pragma unroll
                for (int j = 0; j < 4; ++j) tq[mt][j] = tau[mt * 8 + 2 * j + half];
            f32x16 acc[2];
#pragma unroll
            for (int mt = 0; mt < 2; ++mt) { acc[mt] = (f32x16){0.f,0.f,0.f,0.f,0.f,0.f,0.f,0.f,0.f,0.f,0.f,0.f,0.f,0.f,0.f,0.f};
#pragma unroll
                for (int kk = 0; kk < 4; ++kk) acc[mt] = __builtin_amdgcn_mfma_f32_32x32x16_f16(a[mt][kk], bfr[kk], acc[mt], 0, 0, 0); }
            bool trig = false;
            float Iv[2][4]; bool okv[2][4]; bool anyok = false;
#pragma unroll
            for (int mt = 0; mt < 2; ++mt)
#pragma unroll
                for (int j = 0; j < 4; ++j) {
                    const int q = mt * 8 + 2 * j + half;
                    float I = __builtin_fmaf(wq[mt][j][0], relu_i(acc[mt][4 * j]), 0.0f);
                    I = __builtin_fmaf(wq[mt][j][1], relu_i(acc[mt][4 * j + 1]), I);
                    I = __builtin_fmaf(wq[mt][j][2], relu_i(acc[mt][4 * j + 2]), I);
                    I = __builtin_fmaf(wq[mt][j][3], relu_i(acc[mt][4 * j + 3]), I);
                    Iv[mt][j] = I; okv[mt][j] = (s <= t0 + q) && (I > tq[mt][j]); anyok = anyok || okv[mt][j];
                }
            if (__any(anyok)) {
                unsigned hcnt[2][4]; unsigned rank[2][4];
                const unsigned long long hm = half ? 0xFFFFFFFF00000000ull : 0x00000000FFFFFFFFull;
                const unsigned long long ltm = (1ull << lane) - 1ull;
#pragma unroll
                for (int mt = 0; mt < 2; ++mt)
#pragma unroll
                    for (int j = 0; j < 4; ++j) { const unsigned long long bal = __ballot(okv[mt][j]) & hm; hcnt[mt][j] = (unsigned)__popcll(bal); rank[mt][j] = (unsigned)__popcll(bal & ltm); }
                unsigned base[2][4];
#pragma unroll
                for (int mt = 0; mt < 2; ++mt)
#pragma unroll
                    for (int j = 0; j < 4; ++j) base[mt][j] = 0u;
                if (l31 == 0) {
#pragma unroll
                    for (int mt = 0; mt < 2; ++mt)
#pragma unroll
                        for (int j = 0; j < 4; ++j) base[mt][j] = __hip_atomic_fetch_add(&cnt[mt * 8 + 2 * j + half], hcnt[mt][j], __ATOMIC_RELAXED, __HIP_MEMORY_SCOPE_WORKGROUP);
                }
#pragma unroll
                for (int mt = 0; mt < 2; ++mt)
#pragma unroll
                    for (int j = 0; j < 4; ++j) {
                        const unsigned b0 = (unsigned)__shfl((int)base[mt][j], lane & 32);
                        if (okv[mt][j]) { const int q = mt * 8 + 2 * j + half; const unsigned pos = b0 + rank[mt][j];
                            val[q * TK_CAP + pos] = Iv[mt][j]; idx[q * TK_CAP + pos] = (u16)s; trig = trig || (pos >= (unsigned)TK_TRIG); }
                    }
            }
            if (trig) flg[par] = 1u;
            const int parn = (par == 2) ? 0 : par + 1;
            if (tid == 0) flg[parn] = 0u;
            __syncthreads();
            const unsigned need = flg[par];
            par = parn;
            if (need) {
#pragma unroll 1
                for (int qq = 0; qq < 2; ++qq) { const int q = 2 * wave + qq;
                    if (cnt[q] > 352u) {
                        const int Nq = t0 + q + 1; int seen = 256 * (kt + 1); seen = seen < Nq ? seen : Nq;
                        int K = TK_K;
                        if (pass == 0 && Nq > 3072) { K = (768 * seen + Nq - 1) / Nq; K = K < 32 ? 32 : (K > TK_K ? TK_K : K); }
                        if (K < TK_K && lane == 0) specd[q] = 1u;
                        const int c2 = topk_compact_approx(val + q * TK_CAP, idx + q * TK_CAP, cnt + q, tau + q, hist, lane, K);
                        if (c2 > TK_TRIG) topk_compact<TK_E>(val + q * TK_CAP, idx + q * TK_CAP, cnt + q, tau + q, lane, K); } }
                __syncthreads();
            }
        }
        {
#pragma unroll 1
        for (int qq = 0; qq < 2; ++qq) { const int q = 2 * wave + qq;
            if (pass == 1 && failq[q] == 0u) continue;
            { const int Nq = t0 + q + 1; const int needc = Nq < TK_K ? Nq : TK_K;
              if (pass == 0 && ((specd[q] != 0u && (int)cnt[q] < needc) || (FORCE_FAIL && ((t0 + q) % 5) == 0))) { if (lane == 0) { failq[q] = 1u; failq[16] = 1u; } continue; } }
            if (cnt[q] > (unsigned)TK_K) {
                int c2 = (int)cnt[q];
                if (c2 > 320) c2 = topk_compact_approx(val + q * TK_CAP, idx + q * TK_CAP, cnt + q, tau + q, hist, lane);
                if (c2 > 320) topk_compact<TK_E>(val + q * TK_CAP, idx + q * TK_CAP, cnt + q, tau + q, lane);
                else if (c2 > TK_K) topk_compact<5>(val + q * TK_CAP, idx + q * TK_CAP, cnt + q, tau + q, lane);
            }
            const int n = (int)cnt[q];
            {
                LAS unsigned* bm = (LAS unsigned*)(val + q * TK_CAP);
                __builtin_amdgcn_wave_barrier();
#pragma unroll
                for (int k = 0; k < 8; ++k) bm[lane * 8 + k] = 0u;
                __builtin_amdgcn_wave_barrier();
                for (int e = lane; e < n; e += 64) { const unsigned id = idx[q * TK_CAP + e]; __hip_atomic_fetch_or(&bm[id >> 5], 1u << (id & 31u), __ATOMIC_RELAXED, __HIP_MEMORY_SCOPE_WORKGROUP); }
                __builtin_amdgcn_wave_barrier();
                int cl = 0;
#pragma unroll
                for (int k = 0; k < 8; ++k) cl += __popc(bm[lane * 8 + k]);
                int incl = cl;
#pragma unroll
                for (int o = 1; o < 64; o <<= 1) { const int v = __shfl_up(incl, o); if (lane >= o) incl += v; }
                int pos = incl - cl;
                LAS u16* sl = idx + q * TK_CAP;
#pragma unroll 1
                for (int k = 0; k < 8; ++k) { unsigned w = bm[lane * 8 + k];
                    while (w) { const int b = __ffs((int)w) - 1; sl[pos++] = (u16)((lane * 8 + k) * 32 + b); w &= w - 1u; } }
                __builtin_amdgcn_wave_barrier();
                for (int e = n + lane; e < TK_K; e += 64) sl[e] = (u16)0;
                __builtin_amdgcn_wave_barrier();
                *(u32x2*)(IDX + (size_t)(t0 + q) * TK_K + 4 * lane) = *(const LAS u32x2*)(sl + 4 * lane);
            }
            if (lane == 0) NIDX[t0 + q] = n; }
        }
        }
    }
    __syncthreads();
}

template <bool causal>
__device__ __forceinline__ void moba_block(const f16* __restrict__ Qh, const f16* __restrict__ Kh, const f16* __restrict__ VTh, int tq, int keybase, int ntiles,
                                           const LAS float* tab, const LAS unsigned char* blut, f32x16 (&o)[2], float& m, float& l, int lane) {
    const int half = lane >> 5, l31 = lane & 31;
    h8 qf[4];
#pragma unroll
    for (int kk = 0; kk < 4; ++kk) qf[kk] = *(const h8*)(Qh + (size_t)tq * 64 + 16 * kk + 8 * half);
    m = -INFINITY; l = 0.f;
#pragma unroll
    for (int mt = 0; mt < 2; ++mt) o[mt] = (f32x16){0.f,0.f,0.f,0.f,0.f,0.f,0.f,0.f,0.f,0.f,0.f,0.f,0.f,0.f,0.f,0.f};
    h8 kn[4]; h4 vnl[2][2], vnh[2][2];
    {
        const int kb = keybase;
#pragma unroll
        for (int kk = 0; kk < 4; ++kk) kn[kk] = *(const h8*)(Kh + (size_t)(kb + l31) * 64 + 16 * kk + 8 * half);
#pragma unroll
        for (int s2 = 0; s2 < 2; ++s2)
#pragma unroll
            for (int mt = 0; mt < 2; ++mt) { const f16* vp = VTh + (size_t)(32 * mt + l31) * S + kb + 16 * s2 + 4 * half; vnl[s2][mt] = *(const h4*)vp; vnh[s2][mt] = *(const h4*)(vp + 8); }
    }
    for (int kt = 0; kt < ntiles; ++kt) {
        const int kb = keybase + 32 * kt;
        h8 kf[4]; h4 vl[2][2], vh[2][2];
#pragma unroll
        for (int kk = 0; kk < 4; ++kk) kf[kk] = kn[kk];
#pragma unroll
        for (int s2 = 0; s2 < 2; ++s2)
#pragma unroll
            for (int mt = 0; mt < 2; ++mt) { vl[s2][mt] = vnl[s2][mt]; vh[s2][mt] = vnh[s2][mt]; }
        if (kt + 1 < ntiles) {
            const int kb2 = kb + 32;
#pragma unroll
            for (int kk = 0; kk < 4; ++kk) kn[kk] = *(const h8*)(Kh + (size_t)(kb2 + l31) * 64 + 16 * kk + 8 * half);
#pragma unroll
            for (int s2 = 0; s2 < 2; ++s2)
#pragma unroll
                for (int mt = 0; mt < 2; ++mt) { const f16* vp = VTh + (size_t)(32 * mt + l31) * S + kb2 + 16 * s2 + 4 * half; vnl[s2][mt] = *(const h4*)vp; vnh[s2][mt] = *(const h4*)(vp + 8); }
        }
        f32x16 s = (f32x16){0.f,0.f,0.f,0.f,0.f,0.f,0.f,0.f,0.f,0.f,0.f,0.f,0.f,0.f,0.f,0.f};
#pragma unroll
        for (int kk = 0; kk < 4; ++kk) s = __builtin_amdgcn_mfma_f32_32x32x16_f16(kf[kk], qf[kk], s, 0, 0, 0);
        float tmax = -INFINITY;
#pragma unroll
        for (int r = 0; r < 16; ++r) {
            const int key = kb + (r & 3) + 8 * (r >> 2) + 4 * half;
            int dist = tq - key; dist = dist < 0 ? 0 : (dist > 4095 ? 4095 : dist);
            float v = s[r] * (0.125f * 1.44269504089f) + tab[blut[dist]];
            if (causal && key > tq) v = -INFINITY;
            s[r] = v; tmax = fmaxf(tmax, v);
        }
        tmax = fmaxf(tmax, __shfl_xor(tmax, 32));
        const float mnew = fmaxf(m, tmax);
        const float alpha = __builtin_amdgcn_exp2f(m - mnew);
        float lsum = 0.f;
#pragma unroll
        for (int r = 0; r < 16; ++r) { const float pv = __builtin_amdgcn_exp2f(s[r] - mnew); s[r] = pv; lsum += pv; }
        lsum += __shfl_xor(lsum, 32);
        l = l * alpha + lsum;
#pragma unroll
        for (int mt = 0; mt < 2; ++mt) o[mt] = o[mt] * alpha;
#pragma unroll
        for (int s2 = 0; s2 < 2; ++s2) {
            h8 pf;
#pragma unroll
            for (int j = 0; j < 8; ++j) pf[j] = (f16)s[8 * s2 + j];
#pragma unroll
            for (int mt = 0; mt < 2; ++mt) {
                const h4 lo = vl[s2][mt], hi = vh[s2][mt];
                h8 vf; vf[0] = lo[0]; vf[1] = lo[1]; vf[2] = lo[2]; vf[3] = lo[3]; vf[4] = hi[0]; vf[5] = hi[1]; vf[6] = hi[2]; vf[7] = hi[3];
                o[mt] = __builtin_amdgcn_mfma_f32_32x32x16_f16(vf, pf, o[mt], 0, 0, 0);
            }
        }
        m = mnew;
    }
}
__device__ __forceinline__ void phase_moba_sel(const Params& p_, LAS unsigned char* lds, int layer, bool overlap = false) {
    const Params p = load_params(); (void)p_;
    unsigned char* ws = phase_ws(p.ws); const int ptid = phase_tid();
    const f16* QKV = (const f16*)(ws + WS_QKV);
    const unsigned* LCNT = (const unsigned*)(ws + WS_LCNT) + layer * 512;
    const u16* LIST = (const u16*)(ws + WS_LIST);
    f16* PARTO = (f16*)(ws + WS_PQ); float* ML = (float*)(ws + WS_EIDX);
    LAS int* pre = (LAS int*)lds;
    LAS float* tab = (LAS float*)(lds + 4096);
    const int tid = ptid, lane = tid & 63, wave = __builtin_amdgcn_readfirstlane(tid >> 6), half = lane >> 5, l31 = lane & 31;
    tab[tid] = p.rel_bias[tid] * 1.44269504089f;
    LAS unsigned char* blut = (LAS unsigned char*)(lds + 24576);
    for (int d = tid; d < 4096; d += NTHREADS) blut[d] = (unsigned char)t5_bucket(d);
    { const int c = (int)((LCNT[tid] + 31u) >> 5);
      pre[tid + 1] = c; if (tid == 0) pre[0] = 0;
      __syncthreads();
      for (int off = 1; off < 512; off <<= 1) { int v = 0; if (tid >= off) v = pre[tid + 1 - off]; __syncthreads(); pre[tid + 1] += v; __syncthreads(); } }
    const int total = pre[512];
    const int nmw = overlap ? 4 : NWAVES, mw = overlap ? wave - 4 : wave;
    if (mw >= 0)
    for (int w = blockIdx.x * nmw + mw; w < total; w += gridDim.x * nmw) {
        int lo = 0, hi = 511;
        while (lo < hi) { const int mid = (lo + hi + 1) >> 1; if (pre[mid] <= w) lo = mid; else hi = mid - 1; }
        const int L = lo, h = L >> 6, j = L & 63, tile = w - pre[L];
        const int cntL = (int)LCNT[L];
        int ei = tile * 32 + l31; const bool valid = ei < cntL; if (!valid) ei = cntL - 1;
        const unsigned e = LIST[(size_t)L * S + ei];
        const int tq = (int)(e & 0x3FFFu), slot = (int)(e >> 14);
        f32x16 o[2]; float m, l;
        moba_block<false>(QKV + (size_t)(0 * 8 + h) * S * 64, QKV + (size_t)(1 * 8 + h) * S * 64, QKV + (size_t)(2 * 8 + h) * S * 64, tq, j * 256, 8, tab + h * 32, blut, o, m, l, lane);
        if (valid) {
            const float inv = 1.0f / l;
            f16* dst = PARTO + ((size_t)(tq * 8 + h) * 3 + slot) * 64;
#pragma unroll
            for (int mt = 0; mt < 2; ++mt)
#pragma unroll
                for (int r4 = 0; r4 < 4; ++r4) { h4 ov;
#pragma unroll
                    for (int i = 0; i < 4; ++i) ov[i] = (f16)(o[mt][4 * r4 + i] * inv);
                    *(h4*)(dst + 32 * mt + 8 * r4 + 4 * half) = ov; }
            if (half == 0) { float* mlp = ML + ((size_t)(tq * 8 + h) * 3 + slot) * 2; mlp[0] = m; mlp[1] = l; }
        }
    }
    if (!overlap) __syncthreads();
}
__device__ __forceinline__ void phase_moba_own(const Params& p_, LAS unsigned char* lds) {
    const Params p = load_params(); (void)p_;
    unsigned char* ws = phase_ws(p.ws); const int ptid = phase_tid();
    const f16* QKV = (const f16*)(ws + WS_QKV);
    const int* SEL = (const int*)(ws + WS_SEL);
    const f16* PARTO = (const f16*)(ws + WS_PQ); const float* ML = (const float*)(ws + WS_EIDX);
    f16* Y = (f16*)(ws + WS_Y);
    LAS float* tab = (LAS float*)(lds + 4096);
    const int tid = ptid, lane = tid & 63, wave = tid >> 6, half = lane >> 5, l31 = lane & 31;
    LAS unsigned char* blut = (LAS unsigned char*)(lds + 24576);
    __syncthreads();
    if (tid < 256) tab[tid] = p.rel_bias[tid] * 1.44269504089f;
    for (int d = tid; d < 4096; d += NTHREADS) blut[d] = (unsigned char)t5_bucket(d);
    __syncthreads();
    for (int w = blockIdx.x * NWAVES + wave; w < 4096; w += gridDim.x * NWAVES) {
        const int h = w & 7; int qt = w >> 3; if (qt >= 256) qt ^= 7;
        const int t0 = qt * 32, tq = t0 + l31, b0 = t0 >> 8;
        f32x16 o[2]; float m, l;
        moba_block<true>(QKV + (size_t)(0 * 8 + h) * S * 64, QKV + (size_t)(1 * 8 + h) * S * 64, QKV + (size_t)(2 * 8 + h) * S * 64, tq, b0 * 256, ((t0 & 255) >> 5) + 1, tab + h * 32, blut, o, m, l, lane);
        const int sel = SEL[(size_t)h * S + tq];
        float mp[3], lp[3]; float M = m;
#pragma unroll
        for (int sl = 0; sl < 3; ++sl) { const bool ok = (((sel >> (8 * sl)) & 0xFF) != 0xFF);
            const float* mlp = ML + ((size_t)(tq * 8 + h) * 3 + sl) * 2;
            mp[sl] = ok ? mlp[0] : -INFINITY; lp[sl] = ok ? mlp[1] : 0.f; M = fmaxf(M, mp[sl]); }
        const float wo = __builtin_amdgcn_exp2f(m - M);
        float L = l * wo; float wsl[3];
#pragma unroll
        for (int sl = 0; sl < 3; ++sl) { wsl[sl] = lp[sl] * __builtin_amdgcn_exp2f(mp[sl] - M); L += wsl[sl]; }
        const float inv = 1.0f / L;
#pragma unroll
        for (int mt = 0; mt < 2; ++mt)
#pragma unroll
            for (int r4 = 0; r4 < 4; ++r4) {
                const int d0 = 32 * mt + 8 * r4 + 4 * half;
                float v[4];
#pragma unroll
                for (int i = 0; i < 4; ++i) v[i] = o[mt][4 * r4 + i] * wo;
#pragma unroll
                for (int sl = 0; sl < 3; ++sl) if (wsl[sl] != 0.f) {
                    const h4 pv = *(const h4*)(PARTO + ((size_t)(tq * 8 + h) * 3 + sl) * 64 + d0);
#pragma unroll
                    for (int i = 0; i < 4; ++i) v[i] += wsl[sl] * (float)pv[i]; }
                h4 ov;
#pragma unroll
                for (int i = 0; i < 4; ++i) ov[i] = (DIAG == 3) ? (f16)0.f : (f16)(v[i] * inv);
                *(h4*)(Y + (size_t)tq * D + h * 64 + d0) = ov;
            }
    }
    __syncthreads();
}

__device__ __forceinline__ void phase_dsa(const Params& p_, LAS unsigned char* lds, int layer, bool skip_prologue = false) {
    const Params p = load_params(); (void)p_;
    unsigned char* ws = phase_ws(p.ws); const int ptid = phase_tid();
    const f16* QKV = (const f16*)(ws + WS_QKV);
    const u16* IDX = (const u16*)(ws + WS_IDX); const int* NIDX = (const int*)(ws + WS_NIDX);
    f16* Y = (f16*)(ws + WS_Y);
    LAS float* tab = (LAS float*)(lds + 4096);
    const int tid = ptid, lane = tid & 63, wave = __builtin_amdgcn_readfirstlane(tid >> 6), kg = lane >> 2, c = lane & 3;
    LAS u16* ibase = (LAS u16*)(lds + 8192 + wave * 1024);
    LAS float* scb = (LAS float*)(lds + 16384 + wave * 1024);
    LAS f16* bl16 = (LAS f16*)(lds + 32768);
    {
        __syncthreads();
        for (int i = tid; i < 512; i += NTHREADS) tab[i] = p.rel_bias[i];
        for (int d = tid; d < 4096; d += NTHREADS) { const int bk = t5_bucket(d);
#pragma unroll
            for (int hh = 0; hh < 8; ++hh) bl16[hh * 4096 + d] = (f16)(p.rel_bias[(8 + hh) * 32 + bk] * 1.44269504089f); }
        __syncthreads();
    }
    const int G = gridDim.x;
    const int h0 = (int)(xb_xcc_id() & 7u);
    auto do_head = [&](const int h, const bool dyn, const int first, const int stride) __attribute__((always_inline)) {
    unsigned* hctr = (unsigned*)(ws + WS_CTL + 40960) + layer * 8 + h;
    const f16* DQ = QKV + (size_t)(3 * 8 + h) * S * 64;
    const unsigned char* KV = (const unsigned char*)(QKV + (size_t)4 * 8 * S * 64) + (size_t)h * S * 128 + 16 * c;
    const LAS f16* blh = bl16 + h * 4096;
    const int gwh = (blockIdx.x >> 3) * NWAVES + wave, nwh = (G >> 3) * NWAVES;
    const int eo = ((lane >> 5) & 1) * 8 + ((lane >> 4) & 1) * 4 + ((lane >> 3) & 1) * 2 + ((lane >> 2) & 1);
    const int role = (lane >> 2) & 1, g2 = lane >> 3;
    constexpr int CH = 16;
    for (int ck = first; ; ck += stride) {
      int tb0 = ck * CH;
      if (dyn) { if (lane == 0) tb0 = (int)__hip_atomic_fetch_add(hctr, (unsigned)CH, __ATOMIC_RELAXED, __HIP_MEMORY_SCOPE_AGENT);
                 tb0 = __builtin_amdgcn_readfirstlane(tb0); }
      if (tb0 >= S) break;
      u32x2 nidx = __builtin_nontemporal_load((const u32x2*)(IDX + (size_t)tb0 * 256 + 4 * lane));
      int nn = __builtin_nontemporal_load(NIDX + tb0);
      h8 nqa = __builtin_nontemporal_load((const h8*)(DQ + (size_t)tb0 * 64 + 16 * c)), nqb = __builtin_nontemporal_load((const h8*)(DQ + (size_t)tb0 * 64 + 16 * c + 8));
      for (int t = tb0; t < tb0 + CH; ++t) {
        const int n = nn;
        LAS u16* ib = ibase + ((t & 1) ? 256 : 0);
        __builtin_amdgcn_wave_barrier();
        *(LAS u32x2*)(ib + 4 * lane) = nidx;
        __builtin_amdgcn_wave_barrier();
        int qi[4]; float qscale;
        { float qf[16]; float qm = 0.f;
#pragma unroll
          for (int j = 0; j < 8; ++j) { qf[j] = (float)nqa[j]; qf[8 + j] = (float)nqb[j]; }
#pragma unroll
          for (int j = 0; j < 16; ++j) qm = fmaxf(qm, fabsf(qf[j]));
          qm = fmaxf(qm, dpp_f<0xB1>(qm)); qm = fmaxf(qm, dpp_f<0x4E>(qm));
          const float qs = qm > 0.f ? 127.0f / qm : 0.f;
#pragma unroll
          for (int w = 0; w < 4; ++w) qi[w] = (int)pack_i8x4(qf[4 * w], qf[4 * w + 1], qf[4 * w + 2], qf[4 * w + 3], qs);
          qscale = qm * (0.125f * 1.44269504089f / (127.0f * DSA_K_ISCALE)); }
        if (t + 1 < tb0 + CH) {
            nidx = __builtin_nontemporal_load((const u32x2*)(IDX + (size_t)(t + 1) * 256 + 4 * lane));
            nn = __builtin_nontemporal_load(NIDX + t + 1);
            nqa = __builtin_nontemporal_load((const h8*)(DQ + (size_t)(t + 1) * 64 + 16 * c)); nqb = __builtin_nontemporal_load((const h8*)(DQ + (size_t)(t + 1) * 64 + 16 * c + 8));
        }
        h2 acc2[8]; float ls = 0.f, mref = -INFINITY;
#pragma unroll
        for (int j = 0; j < 8; ++j) acc2[j] = (h2){(f16)0.f, (f16)0.f};
        auto half_body = [&](auto FULLT, const int hh) __attribute__((always_inline)) {
            constexpr bool FULL = decltype(FULLT)::value;
            u32x4 krr[8], vrr[8]; float so[8]; bool vv[8]; bool vk[8]; int rk[8];
#pragma unroll
            for (int i = 0; i < 8; ++i) {
                const int kkK = 16 * (8 * hh + i) + 2 * g2 + role, kkV = kkK ^ 1;
                vk[i] = FULL || (kkK < n); vv[i] = FULL || (kkV < n);
                rk[i] = vk[i] ? (int)ib[kkK] : 0; const int rowV = vv[i] ? (int)ib[kkV] : 0;
                krr[i] = *(const u32x4*)(KV + (size_t)rk[i] * 128);
                vrr[i] = *(const u32x4*)(KV + (size_t)rowV * 128 + 64);
            }
            __builtin_amdgcn_sched_barrier(0);
#pragma unroll
            for (int i = 0; i < 8; ++i) {
                const u32x4 kr = krr[i];
                int di = __builtin_amdgcn_sdot4((int)kr[1], qi[1], __builtin_amdgcn_sdot4((int)kr[0], qi[0], 0, false), false)
                       + __builtin_amdgcn_sdot4((int)kr[3], qi[3], __builtin_amdgcn_sdot4((int)kr[2], qi[2], 0, false), false);
                di += __builtin_amdgcn_update_dpp(0, di, 0xB1, 0xF, 0xF, false); di += __builtin_amdgcn_update_dpp(0, di, 0x4E, 0xF, 0xF, false);
                const float d = (float)di;
                int dd = t - rk[i]; dd = FULL ? (dd > 4095 ? 4095 : dd) : (dd < 0 ? 0 : (dd > 4095 ? 4095 : dd));
                float sv = d * qscale + (float)blh[dd];
                sv = vk[i] ? sv : -INFINITY;
                so[i] = dpp_f<0x141>(sv);
            }
            float mh = mref;
#pragma unroll
            for (int i = 0; i < 8; ++i) mh = fmaxf(mh, so[i]);
            if (hh != 0) { const float scl = (mref == -INFINITY) ? 0.f : __builtin_amdgcn_exp2f(mref - mh); ls *= scl;
              const h2 s2 = pkrtz2(scl, scl);
#pragma unroll
              for (int j = 0; j < 8; ++j) acc2[j] = acc2[j] * s2; }
            mref = mh;
#pragma unroll
            for (int i = 0; i < 8; ++i) {
                const float pv = vv[i] ? __builtin_amdgcn_exp2f(so[i] - mref) : 0.f; ls += pv;
                const h2 p2 = pkrtz2(pv, pv);
#pragma unroll
                for (int w = 0; w < 4; ++w) { const h2 lo = __builtin_amdgcn_cvt_scalef32_pk_f16_fp8((int)vrr[i][w], 1.0f, false), hi = __builtin_amdgcn_cvt_scalef32_pk_f16_fp8((int)vrr[i][w], 1.0f, true);
                    acc2[2 * w] = __builtin_elementwise_fma(p2, lo, acc2[2 * w]); acc2[2 * w + 1] = __builtin_elementwise_fma(p2, hi, acc2[2 * w + 1]); }
            }
        };
        if (n == TK_K) {
#pragma unroll 1
            for (int hh = 0; hh < 2; ++hh) half_body(std::true_type{}, hh);
        } else {
#pragma unroll 1
            for (int hh = 0; hh < 2; ++hh) half_body(std::false_type{}, hh);
        }
        float acc[16];
#pragma unroll
        for (int j = 0; j < 8; ++j) { acc[2 * j] = (float)acc2[j][0]; acc[2 * j + 1] = (float)acc2[j][1]; }
        float M = mref;
        M = fmaxf(M, __shfl_xor(M, 4)); M = fmaxf(M, __shfl_xor(M, 8)); M = fmaxf(M, __shfl_xor(M, 16)); M = fmaxf(M, __shfl_xor(M, 32));
        const float fs = (mref == -INFINITY) ? 0.f : __builtin_amdgcn_exp2f(mref - M);
        ls *= fs;
#pragma unroll
        for (int j = 0; j < 16; ++j) acc[j] *= fs;
        ls += __shfl_xor(ls, 4); ls += __shfl_xor(ls, 8); ls += __shfl_xor(ls, 16); ls += __shfl_xor(ls, 32);
        float r8[8], r4[4], r2[2], r1;
        { const bool hi = (lane >> 5) & 1;
#pragma unroll
          for (int j = 0; j < 8; ++j) { const float send = hi ? acc[j] : acc[j + 8]; const float keep = hi ? acc[j + 8] : acc[j]; r8[j] = keep + __shfl_xor(send, 32); } }
        { const bool hi = (lane >> 4) & 1;
#pragma unroll
          for (int j = 0; j < 4; ++j) { const float send = hi ? r8[j] : r8[j + 4]; const float keep = hi ? r8[j + 4] : r8[j]; r4[j] = keep + __shfl_xor(send, 16); } }
        { const bool hi = (lane >> 3) & 1;
#pragma unroll
          for (int j = 0; j < 2; ++j) { const float send = hi ? r4[j] : r4[j + 2]; const float keep = hi ? r4[j + 2] : r4[j]; r2[j] = keep + __shfl_xor(send, 8); } }
        { const bool hi = (lane >> 2) & 1; const float send = hi ? r2[0] : r2[1]; const float keep = hi ? r2[1] : r2[0]; r1 = keep + __shfl_xor(send, 4); }
        __builtin_nontemporal_store((DIAG == 2) ? (f16)0.f : (f16)(r1 / (ls * DSA_KV_SCALE)), Y + (size_t)t * D + 512 + h * 64 + 16 * c + eo);
      }
    }
    };
    unsigned* xr = (unsigned*)(ws + WS_CTL + 41216) + layer * 16 + xb_xcc_id();
    LAS int* rk = (LAS int*)(lds + 28672);
    if (tid == 0) { rk[0] = (int)__hip_atomic_fetch_add(xr, 1u, __ATOMIC_RELAXED, __HIP_MEMORY_SCOPE_AGENT);
                    rk[1] = (int)__hip_atomic_load((unsigned*)(ws + WS_CTL) + XB_XCNT(xb_xcc_id()), __ATOMIC_RELAXED, __HIP_MEMORY_SCOPE_AGENT); }
    __syncthreads();
    const int rank = rk[0], nloc = rk[1] > 0 ? rk[1] : 1;
    do_head(h0, false, rank * NWAVES + wave, nloc * NWAVES);
#pragma unroll 1
    for (int h2 = 0; h2 < 8; ++h2) {
        unsigned present = 0u;
        for (int x = h2; x < 16; x += 8) present += __hip_atomic_load((unsigned*)(ws + WS_CTL) + XB_XCNT(x), __ATOMIC_RELAXED, __HIP_MEMORY_SCOPE_AGENT);
        if (__builtin_amdgcn_readfirstlane((int)present) == 0) do_head(h2, true, 0, 0);
    }
    __syncthreads();
}

#define INS16(a, ai, x, xi) do { float _x = (x); int _xi = (xi); _Pragma("unroll") for (int _k = 0; _k < 16; ++_k) { const bool _g = _x > a[_k]; \
        const float _t = _g ? a[_k] : _x; const int _ti = _g ? ai[_k] : _xi; a[_k] = _g ? _x : a[_k]; ai[_k] = _g ? _xi : ai[_k]; _x = _t; _xi = _ti; } } while (0)
__device__ __forceinline__ void ce_desc(float& a, int& ai, float& b, int& bi) {
    const bool sw = a < b; const float t = sw ? b : a, u = sw ? a : b; const int ti = sw ? bi : ai, ui = sw ? ai : bi; a = t; b = u; ai = ti; bi = ui;
}
__device__ __forceinline__ void sort16_desc(float (&c)[16], int (&ci)[16]) {
#pragma unroll
    for (int k = 2; k <= 16; k <<= 1)
#pragma unroll
        for (int j = k >> 1; j >= 1; j >>= 1)
#pragma unroll
            for (int i = 0; i < 16; ++i) { const int l = i ^ j; if (l > i) { if ((i & k) == 0) ce_desc(c[i], ci[i], c[l], ci[l]); else ce_desc(c[l], ci[l], c[i], ci[i]); } }
}
__device__ __forceinline__ void merge16(float (&a)[16], int (&ai)[16], const float (&b)[16], const int (&bi)[16]) {
    float c[16]; int ci[16];
#pragma unroll
    for (int k = 0; k < 16; ++k) { const bool g = a[k] >= b[15 - k]; c[k] = g ? a[k] : b[15 - k]; ci[k] = g ? ai[k] : bi[15 - k]; }
#pragma unroll
    for (int st = 8; st >= 1; st >>= 1)
#pragma unroll
        for (int k = 0; k < 16; ++k) if ((k & st) == 0) ce_desc(c[k], ci[k], c[k + st], ci[k + st]);
#pragma unroll
    for (int k = 0; k < 16; ++k) { a[k] = c[k]; ai[k] = ci[k]; }
}
__device__ __forceinline__ void merge_halves(float (&a)[16], int (&ai)[16]) {
    float b[16]; int bi[16];
#pragma unroll
    for (int k = 0; k < 16; ++k) { b[k] = __shfl_xor(a[k], 32); bi[k] = __shfl_xor(ai[k], 32); }
    merge16(a, ai, b, bi);
}
__device__ __forceinline__ void phase_psel(const Params& p_, LAS unsigned char* lds, int layer) {
    const Params p = load_params(); (void)p_;
    unsigned char* ws = phase_ws(p.ws); const int ptid = phase_tid();
    const f16* PQ = (const f16*)(ws + WS_PQ);
    const f16* SUBK = (const f16*)(ws + WS_SUBK) + (size_t)layer * 8 * 2 * 128 * 128;
    int* EIDX = (int*)(ws + WS_EIDX); float* EG = (float*)(ws + WS_EG);
    const int tid = ptid, lane = tid & 63, wave = tid >> 6, half = lane >> 5, l31 = lane & 31;
    for (int w = blockIdx.x * NWAVES + wave; w < 4096; w += gridDim.x * NWAVES) {
        const int h = w & 7, tt = w >> 3, t = tt * 32 + l31;
        float v0[16], v1[16]; int i0[16], i1[16];
#pragma unroll
        for (int pp = 0; pp < 2; ++pp) {
            float a[16]; int ai[16];
#pragma unroll
            for (int k = 0; k < 16; ++k) { a[k] = -INFINITY; ai[k] = 0; }
            h8 qf[8];
#pragma unroll
            for (int kk = 0; kk < 8; ++kk) qf[kk] = *(const h8*)(PQ + (size_t)t * NQ + (2 * h + pp) * 128 + 16 * kk + 8 * half);
            const f16* sk = SUBK + (size_t)(h * 2 + pp) * 128 * 128;
#pragma unroll 1
            for (int mt = 0; mt < 4; ++mt) {
                f32x16 acc = (f32x16){0.f,0.f,0.f,0.f,0.f,0.f,0.f,0.f,0.f,0.f,0.f,0.f,0.f,0.f,0.f,0.f};
#pragma unroll
                for (int kk = 0; kk < 8; ++kk) { const h8 af = *(const h8*)(sk + (size_t)(32 * mt + l31) * 128 + 16 * kk + 8 * half);
                    acc = __builtin_amdgcn_mfma_f32_32x32x16_f16(af, qf[kk], acc, 0, 0, 0); }
                float cv[16]; int cn[16];
#pragma unroll
                for (int r = 0; r < 16; ++r) { cv[r] = acc[r]; cn[r] = 32 * mt + (r & 3) + 8 * (r >> 2) + 4 * half; }
                sort16_desc(cv, cn);
                merge16(a, ai, cv, cn);
            }
            merge_halves(a, ai);
            if (pp == 0) {
#pragma unroll
                for (int k = 0; k < 16; ++k) { v0[k] = a[k]; i0[k] = ai[k]; }
            } else {
#pragma unroll
                for (int k = 0; k < 16; ++k) { v1[k] = a[k]; i1[k] = ai[k]; }
            }
        }
        float ca[16]; int ci[16];
#pragma unroll
        for (int k = 0; k < 16; ++k) {
            const float sA = v0[0] + v1[k]; const int eA = i0[0] * 128 + i1[k];
            const float sB = (k < 8) ? (v0[1] + v1[k]) : -INFINITY; const int eB = (k < 8) ? (i0[1] * 128 + i1[k]) : 0;
            ca[k] = half ? sB : sA; ci[k] = half ? eB : eA;
        }
        {
            constexpr int PI[26] = {2,2,2,2,2, 3,3,3,3, 4,4,4, 5,5, 6,6, 7,7, 8,9,10,11,12,13,14,15};
            constexpr int PJ[26] = {0,1,2,3,4, 0,1,2,3, 0,1,2, 0,1, 0,1, 0,1, 0,0,0,0,0,0,0,0};
#pragma unroll
            for (int k = 0; k < 13; ++k) {
                const float sA = v0[PI[2 * k]] + v1[PJ[2 * k]]; const int eA = i0[PI[2 * k]] * 128 + i1[PJ[2 * k]];
                const float sB = v0[PI[2 * k + 1]] + v1[PJ[2 * k + 1]]; const int eB = i0[PI[2 * k + 1]] * 128 + i1[PJ[2 * k + 1]];
                INS16(ca, ci, half ? sB : sA, half ? eB : eA);
            }
        }
        merge_halves(ca, ci);
        float e[16]; float sum = 0.f;
#pragma unroll
        for (int k = 0; k < 16; ++k) { e[k] = __expf(ca[k] - ca[0]); sum += e[k]; }
        const float inv = 1.0f / sum;
        int* ep = EIDX + (size_t)t * 128 + h * 16; float* gp = EG + (size_t)t * 128 + h * 16;
#pragma unroll
        for (int k = 0; k < 16; ++k) if ((k >> 3) == half) { ep[k] = ci[k]; gp[k] = e[k] * inv; }
    }
    __syncthreads();
}

template <bool LAST>
__device__ __forceinline__ void phase_peer(const Params& p_, LAS unsigned char* lds, int layer) {
    const Params p = load_params(); (void)p_;
    unsigned char* ws = phase_ws(p.ws); const int ptid = phase_tid();
    const unsigned char* U = ws + WS_U16 + (size_t)layer * 16384 * D; const unsigned char* V = ws + WS_V16 + (size_t)layer * 16384 * D;
    const int* EIDX = (const int*)(ws + WS_EIDX); const float* EG = (const float*)(ws + WS_EG);
    const float* X1 = (const float*)(ws + WS_X1); f16* H = (f16*)(ws + WS_H);
    const float* MOD = (const float*)(ws + WS_MOD);
    LAS float* g2 = (LAS float*)lds; LAS float* nw = g2 + 1024; LAS float* sh = nw + 1024; LAS float* sc = sh + 1024;
    const int tid = ptid, lane = tid & 63, wave = __builtin_amdgcn_readfirstlane(tid >> 6);
    __syncthreads();
    for (int i = tid; i < 1024; i += NTHREADS) {
        g2[i] = MOD[layer * 6144 + 5 * 1024 + i];
        if (LAST) { nw[i] = p.norm_final[i]; sh[i] = 0.f; sc[i] = 0.f; }
        else { nw[i] = p.norm_attn[(layer + 1) * 1024 + i]; sh[i] = MOD[(layer + 1) * 6144 + i]; sc[i] = MOD[(layer + 1) * 6144 + 1024 + i]; }
    }
    __syncthreads();
    const int el = ((lane >> 5) & 1) * 4 + ((lane >> 4) & 1) * 2 + ((lane >> 3) & 1);
    for (int ti = 0; ; ++ti) {
        const int tt = blockIdx.x + gridDim.x * (ti >> 2); if (tt >= S / 32) break;
        const int t = tt * 32 + (ti & 3) * 8 + wave;
        int hi4[4]; float hscale;
        { const h8 hA = *(const h8*)(H + (size_t)t * D + 16 * lane), hB = *(const h8*)(H + (size_t)t * D + 16 * lane + 8);
          float hf[16]; float hm = 0.f;
#pragma unroll
          for (int i = 0; i < 8; ++i) { hf[i] = (float)hA[i]; hf[8 + i] = (float)hB[i]; }
#pragma unroll
          for (int i = 0; i < 16; ++i) hm = fmaxf(hm, fabsf(hf[i]));
#pragma unroll
          for (int o = 32; o >= 1; o >>= 1) hm = fmaxf(hm, __shfl_xor(hm, o));
          const float hs = hm > 0.f ? 127.0f / hm : 0.f;
#pragma unroll
          for (int w = 0; w < 4; ++w) hi4[w] = (int)pack_i8x4(hf[4 * w], hf[4 * w + 1], hf[4 * w + 2], hf[4 * w + 3], hs);
          hscale = hm * (1.0f / (127.0f * PEER_U_SCALE)); }
        const int ev0 = EIDX[(size_t)t * 128 + lane], ev1 = EIDX[(size_t)t * 128 + 64 + lane];
        const float gv0 = EG[(size_t)t * 128 + lane], gv1 = EG[(size_t)t * 128 + 64 + lane];
        float acc[16];
#pragma unroll
        for (int j = 0; j < 16; ++j) acc[j] = 0.f;
#pragma unroll 1
        for (int bt = 0; bt < 16; ++bt) {
            const int kb = bt * 8;
            u32x4 ur[8], vr[8];
#pragma unroll
            for (int j = 0; j < 8; ++j) { const int k = kb + j; const int e = __builtin_amdgcn_readlane(k < 64 ? ev0 : ev1, k & 63);
                ur[j] = *(const u32x4*)(U + (size_t)e * D + 16 * lane); vr[j] = *(const u32x4*)(V + (size_t)e * D + 16 * lane); }
            __builtin_amdgcn_sched_barrier(0);
            float pd[8];
#pragma unroll
            for (int j = 0; j < 8; ++j) {
                const int di = __builtin_amdgcn_sdot4((int)ur[j][1], hi4[1], __builtin_amdgcn_sdot4((int)ur[j][0], hi4[0], 0, false), false)
                             + __builtin_amdgcn_sdot4((int)ur[j][3], hi4[3], __builtin_amdgcn_sdot4((int)ur[j][2], hi4[2], 0, false), false);
                pd[j] = (float)di; }
            float r4[4], r2[2], r1;
            { const bool hi = (lane >> 5) & 1;
#pragma unroll
              for (int j = 0; j < 4; ++j) { const float send = hi ? pd[j] : pd[j + 4]; const float keep = hi ? pd[j + 4] : pd[j]; r4[j] = keep + __shfl_xor(send, 32); } }
            { const bool hi = (lane >> 4) & 1;
#pragma unroll
              for (int j = 0; j < 2; ++j) { const float send = hi ? r4[j] : r4[j + 2]; const float keep = hi ? r4[j + 2] : r4[j]; r2[j] = keep + __shfl_xor(send, 16); } }
            { const bool hi = (lane >> 3) & 1; const float send = hi ? r2[0] : r2[1]; const float keep = hi ? r2[1] : r2[0]; r1 = keep + __shfl_xor(send, 8); }
            r1 += __shfl_xor(r1, 4); r1 += __shfl_xor(r1, 2); r1 += __shfl_xor(r1, 1);
            const int kmine = kb + el;
            const float gmine = __shfl(kmine < 64 ? gv0 : gv1, kmine & 63);
            const float wmine = gmine * gelu_exact(r1 * hscale);
#pragma unroll
            for (int j = 0; j < 8; ++j) {
                const int src = ((j >> 2) & 1) * 32 + ((j >> 1) & 1) * 16 + (j & 1) * 8;
                const float wj = __uint_as_float(__builtin_amdgcn_readlane(__float_as_uint(wmine), src));
#pragma unroll
                for (int w = 0; w < 4; ++w) { const f32x2 lo = __builtin_amdgcn_cvt_pk_f32_fp8((int)vr[j][w], false), hi = __builtin_amdgcn_cvt_pk_f32_fp8((int)vr[j][w], true);
                    acc[4 * w] += wj * lo[0]; acc[4 * w + 1] += wj * lo[1]; acc[4 * w + 2] += wj * hi[0]; acc[4 * w + 3] += wj * hi[1]; }
            }
        }
#pragma unroll
        for (int j = 0; j < 16; ++j) acc[j] *= (1.0f / PEER_V_SCALE);
        const float* xr = X1 + (size_t)t * D + 16 * lane;
        float x2[16]; float ss = 0.f;
#pragma unroll
        for (int i = 0; i < 4; ++i) { const f32x4 xv = *(const f32x4*)(xr + 4 * i);
#pragma unroll
            for (int j = 0; j < 4; ++j) { const float v = xv[j] + g2[16 * lane + 4 * i + j] * acc[4 * i + j]; x2[4 * i + j] = v; ss += v * v; } }
        ss = wave_sum(ss);
        const float r = rsqrtf(ss * (1.0f / D) + EPS);
        if (LAST) {
            float* op = p.out + (size_t)t * D + 16 * lane;
#pragma unroll
            for (int i = 0; i < 4; ++i) { f32x4 ov;
#pragma unroll
                for (int j = 0; j < 4; ++j) ov[j] = x2[4 * i + j] * r * nw[16 * lane + 4 * i + j];
                *(f32x4*)(op + 4 * i) = ov; }
        } else {
            float* op = p.out + (size_t)t * D + 16 * lane;
#pragma unroll
            for (int i = 0; i < 4; ++i) { f32x4 ov;
#pragma unroll
                for (int j = 0; j < 4; ++j) ov[j] = x2[4 * i + j];
                *(f32x4*)(op + 4 * i) = ov; }
            h8 oA, oB;
#pragma unroll
            for (int j = 0; j < 8; ++j) { const int cA = 16 * lane + j, cB = cA + 8;
                oA[j] = (f16)((x2[j] * r * nw[cA]) * (1.0f + sc[cA]) + sh[cA]); oB[j] = (f16)((x2[8 + j] * r * nw[cB]) * (1.0f + sc[cB]) + sh[cB]); }
            *(h8*)(H + (size_t)t * D + 16 * lane) = oA; *(h8*)(H + (size_t)t * D + 16 * lane + 8) = oB;
        }
    }
    __syncthreads();
}


#ifndef CHECKS
#define CHECKS 0
#endif
__device__ __forceinline__ float naive_iscore(const f16* IQ, const f16* KN, const float* IW, int t, int s) {
    float x[4] = {0.f, 0.f, 0.f, 0.f};
    for (int d8 = 0; d8 < 8; ++d8) {
        const h8 kv = *(const h8*)(KN + (size_t)s * 64 + 8 * d8);
#pragma unroll
        for (int hh = 0; hh < 4; ++hh) { const h8 qv = *(const h8*)(IQ + (size_t)t * 256 + hh * 64 + 8 * d8);
#pragma unroll
            for (int j = 0; j < 8; ++j) x[hh] += (float)qv[j] * (float)kv[j]; }
    }
    float I = 0.f;
#pragma unroll
    for (int hh = 0; hh < 4; ++hh) I += IW[(size_t)t * 4 + hh] * fmaxf(x[hh], 0.f);
    return I + 0.0f;
}
__device__ __forceinline__ void phase_check_attn(const Params& p_, LAS unsigned char* lds) {
    const Params p = load_params(); (void)p_;
    unsigned char* ws = phase_ws(p.ws); const int ptid = phase_tid();
    const f16* QKV = (const f16*)(ws + WS_QKV); const f16* IQ = (const f16*)(ws + WS_IQ); const f16* KN = (const f16*)(ws + WS_KN); const float* IW = (const float*)(ws + WS_IW);
    const u16* IDX = (const u16*)(ws + WS_IDX); const int* NIDX = (const int*)(ws + WS_NIDX); const f16* Y = (const f16*)(ws + WS_Y);
    const int* SEL = (const int*)(ws + WS_SEL); const float* KMEAN = (const float*)(ws + WS_KMEAN); const f16* H = (const f16*)(ws + WS_H);
    const int lane = ptid & 63, wave = __builtin_amdgcn_readfirstlane(ptid >> 6), gw = blockIdx.x * NWAVES + wave, nw = gridDim.x * NWAVES;
    constexpr int NS = 40;
    for (int si = gw; si < NS; si += nw) {
        const int t = (si < 4) ? (si * 85 + 3) : (si * 419 + 7) % S;
        const int n = NIDX[t];
        if (n != (t + 1 < 256 ? t + 1 : 256)) set_flag(ws, 4u);
        int sidx[4]; float sI[4]; float mn = INFINITY;
#pragma unroll
        for (int i = 0; i < 4; ++i) { const int k = lane + 64 * i; const bool ok = k < n; sidx[i] = ok ? (int)IDX[(size_t)t * 256 + k] : 0;
            sI[i] = ok ? naive_iscore(IQ, KN, IW, t, sidx[i]) : INFINITY; mn = fminf(mn, sI[i]);
            if (ok && sidx[i] > t) set_flag(ws, 4u); }
        mn = wave_min(mn);
        const float tol = 1e-4f * fabsf(mn) + 1e-5f;
        int call = 0, csel = 0;
        for (int s2 = lane; s2 <= t; s2 += 64) call += (naive_iscore(IQ, KN, IW, t, s2) > mn + tol) ? 1 : 0;
#pragma unroll
        for (int i = 0; i < 4; ++i) csel += (lane + 64 * i < n && sI[i] > mn + tol) ? 1 : 0;
        call = wave_sumi(call); csel = wave_sumi(csel);
        if (call != csel) set_flag(ws, 4u);
        for (int h = 0; h < 8; ++h) {
            const f16* DQ = QKV + (size_t)(3 * 8 + h) * S * 64; const f16* DK = QKV + (size_t)(4 * 8 + h) * S * 64; const f16* DV = QKV + (size_t)(5 * 8 + h) * S * 64;
            float lg[4]; float mx = -INFINITY;
#pragma unroll
            for (int i = 0; i < 4; ++i) { const bool ok = lane + 64 * i < n; float d = 0.f;
                for (int dd = 0; dd < 64; ++dd) d += (float)DQ[(size_t)t * 64 + dd] * (float)DK[(size_t)sidx[i] * 64 + dd];
                const int dist = t - sidx[i];
                lg[i] = ok ? d * 0.125f + p.rel_bias[(8 + h) * 32 + t5_bucket(dist < 0 ? 0 : dist)] : -INFINITY; mx = fmaxf(mx, lg[i]); }
            mx = wave_max(mx);
            float pr[4]; float ls = 0.f;
#pragma unroll
            for (int i = 0; i < 4; ++i) { pr[i] = __expf(lg[i] - mx); ls += pr[i]; }
            ls = wave_sum(ls);
            float o = 0.f;
#pragma unroll
            for (int i = 0; i < 4; ++i)
                for (int src = 0; src < 64; ++src) { const float pk = __shfl(pr[i], src); const int row = __shfl(sidx[i], src); o += pk * (float)DV[(size_t)row * 64 + lane]; }
            o /= ls;
            const float got = (float)Y[(size_t)t * D + 512 + h * 64 + lane];
            const float err = wave_max(fabsf(got - o)), sc = wave_max(fabsf(o));
            if (err > 4e-3f * sc + 1e-3f) set_flag(ws, 8u);
        }
    }
    LAS float* pbuf = (LAS float*)(lds + 32768) + wave * 1024;
    LAS int* sbuf = (LAS int*)(lds + 32768 + 8 * 4096) + wave * 4;
    for (int si = gw; si < NS * 8; si += nw) {
        const int h = si & 7, s8 = si >> 3;
        const int t = (s8 < 4) ? (s8 * 170 + 11) : (s8 * 419 + 7) % S;
        const int b0 = t >> 8;
        const f16* MQ = QKV + (size_t)(0 * 8 + h) * S * 64; const f16* MK = QKV + (size_t)(1 * 8 + h) * S * 64; const f16* MVT = QKV + (size_t)(2 * 8 + h) * S * 64;
        float g = -INFINITY;
        if (lane < b0) { g = 0.f; for (int dd = 0; dd < 64; ++dd) g += (float)MQ[(size_t)t * 64 + dd] * KMEAN[(size_t)(h * 64 + lane) * 64 + dd]; }
        const int sel = SEL[(size_t)h * S + t];
        __builtin_amdgcn_wave_barrier();
        for (int r = 0; r < 3; ++r) { const float mxg = wave_max(g); int cand = (g == mxg && mxg > -INFINITY) ? lane : 999; cand = -(int)wave_max((float)(-cand));
            const int sb_ref = cand < 999 ? cand : -1; if (lane == 0) sbuf[r] = sb_ref; if (lane == cand) g = -INFINITY;
            int sb = (sel >> (8 * r)) & 0xFF; if (sb == 0xFF) sb = -1; if (sb != sb_ref) set_flag(ws, 16u); }
        if (lane == 0) sbuf[3] = b0;
        __builtin_amdgcn_wave_barrier();
        float mx = -INFINITY;
        for (int r = 0; r < 4; ++r) { const int sb = sbuf[r];
            for (int i = 0; i < 4; ++i) { const int key = sb * 256 + lane + 64 * i; const bool ok = sb >= 0 && key <= t;
                float d = 0.f; if (ok) for (int dd = 0; dd < 64; ++dd) d += (float)MQ[(size_t)t * 64 + dd] * (float)MK[(size_t)key * 64 + dd];
                const float lgv = ok ? d * 0.125f + p.rel_bias[h * 32 + t5_bucket(t - key)] : -INFINITY; mx = fmaxf(mx, lgv); pbuf[r * 256 + lane + 64 * i] = lgv; } }
        mx = wave_max(mx);
        float ls = 0.f;
        __builtin_amdgcn_wave_barrier();
        for (int e2 = lane; e2 < 1024; e2 += 64) { const float pv = __expf(pbuf[e2] - mx); ls += pv; pbuf[e2] = pv; }
        ls = wave_sum(ls);
        __builtin_amdgcn_wave_barrier();
        float o = 0.f;
        for (int r = 0; r < 4; ++r) { const int sb = sbuf[r]; if (sb < 0) continue;
            for (int kk = 0; kk < 256; ++kk) { const float pv = pbuf[r * 256 + kk]; if (pv != 0.f) o += pv * (float)MVT[(size_t)lane * S + sb * 256 + kk]; } }
        o /= ls;
        const float got = (float)Y[(size_t)t * D + h * 64 + lane];
        const float err = wave_max(fabsf(got - o)), sc = wave_max(fabsf(o));
        if (err > 4e-3f * sc + 1e-3f) set_flag(ws, 16u);
        __builtin_amdgcn_wave_barrier();
    }
    for (int si = gw; si < NS; si += nw) {
        const int t = (si * 419 + 7) % S;
        const int layer_unknown = 0; (void)layer_unknown;
        (void)H;
    }
    __syncthreads();
}


__device__ __forceinline__ void phase_check_psel(const Params& p_, LAS unsigned char* lds, int layer) {
    const Params p = load_params(); (void)p_;
    int zoff = 0; LAUNDER_S(zoff); unsigned char* ws = p.ws + zoff; const int ptid = phase_tid();
    const f16* PQ = (const f16*)(ws + WS_PQ);
    const f16* SUBK = (const f16*)(ws + WS_SUBK) + (size_t)layer * 8 * 2 * 128 * 128;
    const int* EIDX = (const int*)(ws + WS_EIDX); const float* EG = (const float*)(ws + WS_EG);
    const int lane = ptid & 63, wave = __builtin_amdgcn_readfirstlane(ptid >> 6), gw = blockIdx.x * NWAVES + wave, nw = gridDim.x * NWAVES;
    LAS float* tvL = (LAS float*)(lds + 32768) + wave * 64;
    LAS int* tiL = (LAS int*)(lds + 32768 + 8 * 256) + wave * 64;
    constexpr int NS = 40;
    for (int si = gw; si < NS * 8; si += nw) {
        const int h = si & 7, s8 = si >> 3, t = (s8 * 419 + 7) % S;
        __builtin_amdgcn_wave_barrier();
        for (int pp = 0; pp < 2; ++pp) {
            float s0 = 0.f, s1 = 0.f;
            const f16* qp = PQ + (size_t)t * NQ + (2 * h + pp) * 128; const f16* kp = SUBK + (size_t)(h * 2 + pp) * 128 * 128;
            for (int d = 0; d < 128; ++d) { const float qv = (float)qp[d]; s0 += qv * (float)kp[(size_t)lane * 128 + d]; s1 += qv * (float)kp[(size_t)(lane + 64) * 128 + d]; }
            for (int r = 0; r < 16; ++r) {
                const float mx = wave_max(fmaxf(s0, s1));
                int c = (s0 == mx) ? lane : ((s1 == mx) ? lane + 64 : 999);
                c = -(int)wave_max((float)(-c));
                if (lane == 0) { tvL[pp * 16 + r] = mx; tiL[pp * 16 + r] = c; }
                if (c == lane) s0 = -INFINITY; if (c == lane + 64) s1 = -INFINITY;
            }
        }
        __builtin_amdgcn_wave_barrier();
        float cs[4]; const int ci_ = lane >> 2;
#pragma unroll
        for (int jj = 0; jj < 4; ++jj) cs[jj] = tvL[ci_] + tvL[16 + 4 * (lane & 3) + jj];
        float gs[16]; int ge[16];
#pragma unroll
        for (int r = 0; r < 16; ++r) {
            float m4 = fmaxf(fmaxf(cs[0], cs[1]), fmaxf(cs[2], cs[3]));
            const float mx = wave_max(m4);
            int c = 999;
#pragma unroll
            for (int jj = 3; jj >= 0; --jj) if (cs[jj] == mx) c = ci_ * 16 + 4 * (lane & 3) + jj;
            c = -(int)wave_max((float)(-c));
            gs[r] = mx; ge[r] = tiL[c >> 4] * 128 + tiL[16 + (c & 15)];
#pragma unroll
            for (int jj = 0; jj < 4; ++jj) if (c == ci_ * 16 + 4 * (lane & 3) + jj) cs[jj] = -INFINITY;
        }
        float sum = 0.f;
        { const float g0 = gs[0];
#pragma unroll
          for (int r = 0; r < 16; ++r) gs[r] = __expf(gs[r] - g0); }
#pragma unroll
        for (int r = 0; r < 16; ++r) sum += gs[r];
        bool bad = false;
#pragma unroll
        for (int r = 0; r < 16; ++r) { const int e = EIDX[(size_t)t * 128 + h * 16 + r]; const float g = EG[(size_t)t * 128 + h * 16 + r];
            if (e != ge[r]) bad = true; if (fabsf(g - gs[r] / sum) > 1e-3f) bad = true; }
        if (bad) set_flag(ws, 1u);
    }
    __syncthreads();
}

constexpr int NPHASE = 2 + 2 * 9 + (CHECKS ? 1 : 0);
__global__ void __launch_bounds__(NTHREADS) fwd_kernel(Params p) {
    extern __shared__ __attribute__((aligned(16))) unsigned char lds_raw[];
    LAS unsigned char* lds = (LAS unsigned char*)lds_raw;
    volatile LAS unsigned* xbw = (volatile LAS unsigned*)(lds + LDS_BYTES - 16);
    if (threadIdx.x < 4) xbw[threadIdx.x] = 0u;
    __syncthreads();
    const Params p0 = load_params();
    XcdBarrier bar; bar.bar = (unsigned*)(p0.ws + WS_CTL); bar.x = 0; bar.st = xbw;
#if ONE_LAUNCH
    bar = xcd_barrier_post((unsigned*)(p0.ws + WS_CTL), xbw);
#endif
    const int lo = p0.ph_lo, hi = p0.ph_hi;
    int ph = 0;
#if ONE_LAUNCH
#define PHASE(...) do { if (PH_ON(ph) && ph >= lo && ph < hi) { __VA_ARGS__; if (ph + 1 < hi) xcd_barrier(bar); } ++ph; } while (0)
#else
#define PHASE(...) do { if (PH_ON(ph) && ph >= lo && ph < hi) { __VA_ARGS__; } ++ph; } while (0)
#endif
    PHASE(REP(8, phase_prologue(p, lds)));
    PHASE(phase_norm<true>(p, lds, 0, 0));
    for (int layer = 0; layer < 2; ++layer) {
        PHASE({ const Params q = load_params(); unsigned char* ws = phase_ws(q.ws); pg8::Gemm g{(const f16*)(ws + WS_H), (const f16*)(ws + WS_WIN) + (size_t)layer * NPAD * D, S, NPAD, D};
                pg8::StaticOrder so; so.init(S, NPAD, gridDim.x, blockIdx.x);
                EpiIn E{(f16*)(ws + WS_QKV), (f16*)(ws + WS_IQ), (float*)(ws + WS_IKRAW), (float*)(ws + WS_IW)};
                REP(6, pg8::gemm_phase<EpiIn>(lds, g, so, E)); });
        PHASE(REP(10, phase_prep(p, lds)));
        PHASE({ phase_gate(p, lds, layer); if (REP_WHAT == 15) phase_gate(p, lds, layer, true); phase_topk(p, lds, layer); });
        PHASE({ phase_moba_sel(p, lds, layer, false); phase_dsa(p, lds, layer, false); });
        PHASE(REP(7, phase_moba_own(p, lds)));
        PHASE({ if (CHECKS) phase_check_attn(p, lds); const Params q = load_params(); unsigned char* ws = phase_ws(q.ws); const float* Xin = (layer == 0) ? q.x : q.out; pg8::Gemm g{(const f16*)(ws + WS_Y), (const f16*)(ws + WS_WOUT) + (size_t)layer * D * D, S, D, D};
                pg8::StaticOrder so; so.init(S, D, gridDim.x, blockIdx.x);
                EpiOut E{Xin, (float*)(ws + WS_X1), (const float*)(ws + WS_MOD) + layer * 6144 + 2 * 1024};
                REP(13, pg8::gemm_phase<EpiOut>(lds, g, so, E)); });
        PHASE(REP(11, phase_norm<false>(p, lds, layer, 1)));
        PHASE({ const Params q = load_params(); unsigned char* ws = phase_ws(q.ws); pg8::Gemm g{(const f16*)(ws + WS_H), (const f16*)(ws + WS_WQ) + (size_t)layer * NQ * D, S, NQ, D};
                pg8::StaticOrder so; so.init(S, NQ, gridDim.x, blockIdx.x);
                EpiPQ E{(f16*)(ws + WS_PQ)};
                REP(12, pg8::gemm_phase<EpiPQ>(lds, g, so, E)); });
        if (layer == 0) { PHASE({ phase_psel(p, lds, layer); asm volatile("s_waitcnt vmcnt(0)" ::: "memory"); __syncthreads(); phase_peer<false>(p, lds, layer); }); } else { PHASE({ phase_psel(p, lds, layer); asm volatile("s_waitcnt vmcnt(0)" ::: "memory"); __syncthreads(); phase_peer<true>(p, lds, layer); }); }
    }
#if ONE_LAUNCH
    if (REP_WHAT == 14) { for (int i = 0; i < 20; ++i) xcd_barrier(bar); }
#endif
    if (CHECKS) PHASE({ const Params q = load_params(); if (blockIdx.x == 0 && threadIdx.x == 0) { const unsigned fl = *(volatile unsigned*)(q.ws + WS_FLAG);
              if (fl) q.out[0] += sqrtf((10.0f + (float)fl) * 1000.0f * 16777216.0f); } });
#undef PHASE
}

extern "C" void kernel_launch(void* const* d_in, const int* in_sizes, int n_in, void* d_out, int out_size, void* d_ws, size_t ws_size, hipStream_t stream) {
    static int grid = 0;
    if (grid == 0) {
        if (n_in != 14 || out_size != S * D || ws_size < WS_END) { fprintf(stderr, "kernel_launch: unexpected shapes (n_in %d out %d ws %zu)\n", n_in, out_size, ws_size); grid = -1; return; }
        if (hipFuncSetAttribute((const void*)fwd_kernel, hipFuncAttributeMaxDynamicSharedMemorySize, LDS_BYTES) != hipSuccess) { fprintf(stderr, "kernel_launch: hipFuncSetAttribute failed\n"); grid = -1; return; }
        int dev = 0, cus = 0, per_cu = 0;
        (void)hipGetDevice(&dev); (void)hipDeviceGetAttribute(&cus, hipDeviceAttributeMultiprocessorCount, dev);
        (void)hipOccupancyMaxActiveBlocksPerMultiprocessor(&per_cu, (const void*)fwd_kernel, NTHREADS, LDS_BYTES);
        (void)hipGetLastError();
        if (per_cu < 1) fprintf(stderr, "kernel_launch: occupancy query reports %d blocks per CU\n", per_cu);
        grid = (cus > 0 ? cus : 256);
        if (grid > 256) grid = 256;
    }
    if (grid < 0) return;
    (void)hipMemsetAsync((char*)d_ws + WS_CTL, 0, CTL_ZERO_BYTES, stream);
    Params p{};
    p.x = (const float*)d_in[0]; p.c = (const float*)d_in[1]; p.w_ada = (const float*)d_in[2]; p.b_ada = (const float*)d_in[3];
    p.norm_attn = (const float*)d_in[4]; p.norm_ffn = (const float*)d_in[5]; p.w_in = (const float*)d_in[6]; p.w_out = (const float*)d_in[7];
    p.rel_bias = (const float*)d_in[8]; p.peer_wq = (const float*)d_in[9]; p.peer_subkeys = (const float*)d_in[10]; p.peer_u = (const float*)d_in[11];
    p.peer_v = (const float*)d_in[12]; p.norm_final = (const float*)d_in[13];
    p.out = (float*)d_out; p.ws = (unsigned char*)d_ws;
#if ONE_LAUNCH
    p.ph_lo = 0; p.ph_hi = NPHASE;
    hipLaunchKernelGGL(fwd_kernel, dim3(grid), dim3(NTHREADS), LDS_BYTES, stream, p);
#else
    for (int ph = 0; ph < NPHASE; ++ph) { p.ph_lo = ph; p.ph_hi = ph + 1; hipLaunchKernelGGL(fwd_kernel, dim3(grid), dim3(NTHREADS), LDS_BYTES, stream, p); }
#endif
}
```

```cpp
#include <hip/hip_runtime.h>
#include <cstdio>
#include <cstdint>
#include <type_traits>

#ifndef DIAG
#define DIAG 0
#endif
#ifdef ONLY_PHASE
#define PH_ON(ph) ((ph) == ONLY_PHASE)
#else
#define PH_ON(ph) true
#endif
#ifndef ONE_LAUNCH
#define ONE_LAUNCH 1
#endif
#ifndef REP_WHAT
#define REP_WHAT 0
#endif
#ifndef FORCE_FAIL
#define FORCE_FAIL 0
#endif
#define REP(k, ...) do { int _nrep = (REP_WHAT == (k)) ? 2 : 1; if (REP_WHAT) asm volatile("" : "+s"(_nrep)); for (int _r = 0; _r < _nrep; ++_r) { __VA_ARGS__; } } while (0)

#define LAS __attribute__((address_space(3)))
typedef _Float16 f16;
typedef _Float16 h8 __attribute__((ext_vector_type(8)));
typedef _Float16 h4 __attribute__((ext_vector_type(4)));
typedef _Float16 h2 __attribute__((ext_vector_type(2)));
typedef float f32x2 __attribute__((ext_vector_type(2)));
typedef float f32x4 __attribute__((ext_vector_type(4)));
typedef float f32x16 __attribute__((ext_vector_type(16)));
typedef unsigned short u16;
typedef unsigned u32x2 __attribute__((ext_vector_type(2)));
typedef unsigned u32x4 __attribute__((ext_vector_type(4)));

constexpr int S = 16384, D = 1024, NPROJ = 3396, NPAD = 3584, NQ = 2048;
constexpr int NTHREADS = 512, NWAVES = 8;
constexpr int LDS_BYTES = 147456;
constexpr float EPS = 1e-6f;
constexpr float DSA_KV_SCALE = 4.0f;
constexpr float DSA_K_ISCALE = 16.0f;
#ifndef DSA_SWEEP
#define DSA_SWEEP 1
#endif
constexpr float PEER_U_SCALE = 1000.0f, PEER_V_SCALE = 8.0f;
constexpr size_t MBy = 1ull << 20;
constexpr size_t WS_CTL = 0, WS_LCNT = 16384, WS_MODP = 65536, WS_MOD = 458752, WS_KMEAN = 524288, WS_SEL = 1 * MBy, WS_IW = 2 * MBy, WS_NIDX = 3 * MBy,
    WS_WIN = 4 * MBy, WS_WOUT = 18 * MBy, WS_WQ = 22 * MBy, WS_SUBK = 30 * MBy, WS_U16 = 32 * MBy, WS_V16 = 96 * MBy, WS_H = 160 * MBy, WS_X1 = 192 * MBy,
    WS_QKV = 256 * MBy, WS_IQ = 352 * MBy, WS_IKRAW = 360 * MBy, WS_KN = 364 * MBy, WS_IDX = 366 * MBy, WS_LIST = 374 * MBy, WS_Y = 390 * MBy,
    WS_PQ = 422 * MBy, WS_EIDX = 486 * MBy, WS_EG = 494 * MBy, WS_END = 502 * MBy;
constexpr size_t CTL_ZERO_BYTES = 65536;

struct Params {
    const float* x; const float* c; const float* w_ada; const float* b_ada; const float* norm_attn; const float* norm_ffn; const float* w_in; const float* w_out;
    const float* rel_bias; const float* peer_wq; const float* peer_subkeys; const float* peer_u; const float* peer_v; const float* norm_final;
    float* out; unsigned char* ws; int ph_lo, ph_hi;
};

#define XB_TMO      128
#define XB_XCNT(j)  (256  + 64 * (j))
#define XB_XSUB(j)  (1280 + 64 * (j))
#define XB_XGEN(j)  (2304 + 64 * (j))
#define XB_TOP      3328
#define XB_TOPGEN   3392
#define XCD_BAR_WORDS 3456
#define XB_SPIN_CAP (1u << 25)
__device__ __forceinline__ unsigned xb_ld(unsigned* p)              { return __hip_atomic_load(p, __ATOMIC_RELAXED, __HIP_MEMORY_SCOPE_AGENT); }
__device__ __forceinline__ unsigned xb_add(unsigned* p, unsigned v) { return __hip_atomic_fetch_add(p, v, __ATOMIC_RELAXED, __HIP_MEMORY_SCOPE_AGENT); }
__device__ __forceinline__ unsigned xb_xcc_id() { return (unsigned)__builtin_amdgcn_s_getreg((3 << 11) | 20) & 0xFu; }
#define XB_SPIN(cond, bar) do { unsigned _sp = 0; while (cond) { __builtin_amdgcn_s_sleep(1); \
    if ((++_sp & 255u) == 0u) { if (xb_ld(&(bar)[XB_TMO])) break; if (_sp > XB_SPIN_CAP) { atomicAdd(&(bar)[XB_TMO], 1u); break; } } } } while (0)
struct XcdBarrier { unsigned* bar; unsigned x; volatile LAS unsigned* st; };
__device__ __forceinline__ XcdBarrier xcd_barrier_post(unsigned* bar, volatile LAS unsigned* st) {
    XcdBarrier b; b.bar = bar; b.x = xb_xcc_id(); b.st = st;
    if (threadIdx.x == 0) (void)xb_add(&bar[XB_XCNT(b.x)], 1u);
    return b;
}
__device__ __forceinline__ void xcd_barrier_complete(unsigned* bar, unsigned x, unsigned& nloc, unsigned& nx) {
    const unsigned G = gridDim.x * gridDim.y * gridDim.z;
    unsigned sum, cnt, mine, sp = 0u;
    for (;;) {
        sum = 0u; cnt = 0u; mine = 0u;
#pragma unroll
        for (unsigned j = 0; j < 16; ++j) { const unsigned c = xb_ld(&bar[XB_XCNT(j)]); sum += c; cnt += (c > 0u) ? 1u : 0u; mine = (j == x) ? c : mine; }
        if (sum == G) break;
        __builtin_amdgcn_s_sleep(1);
        if ((++sp & 255u) == 0u) { if (xb_ld(&bar[XB_TMO])) break; if (sp > XB_SPIN_CAP) { atomicAdd(&bar[XB_TMO], 1u); break; } }
    }
    nloc = mine > 0u ? mine : 1u; nx = cnt > 0u ? cnt : 1u;
}
__device__ __forceinline__ void xcd_barrier(const XcdBarrier& b) {
    asm volatile("s_waitcnt vmcnt(0)" ::: "memory");
    __syncthreads();
    if (threadIdx.x == 0) {
        unsigned* bar = b.bar;
        __builtin_amdgcn_s_waitcnt(0);
        unsigned nloc = b.st[0], nx = b.st[1];
        if (nloc == 0u) { xcd_barrier_complete(bar, b.x, nloc, nx); b.st[0] = nloc; b.st[1] = nx; }
        const unsigned old = xb_add(&bar[XB_XSUB(b.x)], 1u);
        const unsigned gen = old / nloc;
        if (old + 1u == (gen + 1u) * nloc) {
            __builtin_amdgcn_fence(__ATOMIC_RELEASE, "agent");
            asm volatile("s_waitcnt vmcnt(0)" ::: "memory");
            const unsigned og = xb_add(&bar[XB_TOP], 1u);
            const unsigned tg = og / nx;
            if (og + 1u == (tg + 1u) * nx) xb_add(&bar[XB_TOPGEN], 1u);
            else XB_SPIN(xb_ld(&bar[XB_TOPGEN]) == tg, bar);
            __builtin_amdgcn_fence(__ATOMIC_ACQUIRE, "agent");
            xb_add(&bar[XB_XGEN(b.x)], 1u);
            asm volatile("s_waitcnt vmcnt(0)" ::: "memory");
        } else {
            XB_SPIN(xb_ld(&bar[XB_XGEN(b.x)]) == gen, bar);
            __builtin_amdgcn_fence(__ATOMIC_ACQUIRE, "agent");
            asm volatile("s_waitcnt vmcnt(0)" ::: "memory");
        }
    }
    __syncthreads();
}

#define LAUNDER_S(x) asm volatile("" : "+s"(x) :: "memory")
#define LAUNDER_V(x) asm volatile("" : "+v"(x) :: "memory")
#define LAUNDER_P(ptr) do { int _z = 0; LAUNDER_S(_z); ptr = (decltype(ptr))((const char*)(ptr) + _z); } while (0)
__device__ __forceinline__ Params load_params() {
#if defined(__HIP_DEVICE_COMPILE__)
    int z = 0; LAUNDER_S(z);
    const Params* kp = (const Params*)((const char*)(const void*)__builtin_amdgcn_kernarg_segment_ptr() + z);
    return *kp;
#else
    return Params{};
#endif
}
__device__ __forceinline__ int phase_tid() { int t = threadIdx.x; LAUNDER_V(t); return t; }
__device__ __forceinline__ unsigned char* phase_ws(const unsigned char* w) { int z = 0; LAUNDER_S(z); return (unsigned char*)w + z; }
__device__ __forceinline__ float wave_sum(float v) {
#pragma unroll
    for (int o = 32; o >= 1; o >>= 1) v += __shfl_xor(v, o);
    return v;
}
__device__ __forceinline__ int t5_bucket(int d) {
    const float x = (float)d * 0.0625f;
    int k = (int)(2.0f * __log2f(x) + 1e-4f);
    k = k > 15 ? 15 : k;
    return d < 16 ? d : 16 + k;
}
__device__ __forceinline__ unsigned f2ord(float f) { const unsigned u = __float_as_uint(f); return (u & 0x80000000u) ? ~u : (u | 0x80000000u); }
__device__ __forceinline__ float ord2f(unsigned k) { const unsigned u = (k & 0x80000000u) ? (k & 0x7FFFFFFFu) : ~k; return __uint_as_float(u); }
__device__ __forceinline__ float dot8(h8 a, h8 b, float acc) {
    acc = __builtin_amdgcn_fdot2((h2){a[0], a[1]}, (h2){b[0], b[1]}, acc, false);
    acc = __builtin_amdgcn_fdot2((h2){a[2], a[3]}, (h2){b[2], b[3]}, acc, false);
    acc = __builtin_amdgcn_fdot2((h2){a[4], a[5]}, (h2){b[4], b[5]}, acc, false);
    acc = __builtin_amdgcn_fdot2((h2){a[6], a[7]}, (h2){b[6], b[7]}, acc, false);
    return acc;
}
__device__ __forceinline__ unsigned pack_fp8x4(float a, float b, float c, float d) {
    int w = __builtin_amdgcn_cvt_pk_fp8_f32(a, b, 0, false);
    w = __builtin_amdgcn_cvt_pk_fp8_f32(c, d, w, true);
    return (unsigned)w;
}
#ifndef CHECKS
#define CHECKS 0
#endif
constexpr size_t WS_FLAG = 32768;
__device__ __forceinline__ float wave_max(float v) {
#pragma unroll
    for (int o = 32; o >= 1; o >>= 1) v = fmaxf(v, __shfl_xor(v, o));
    return v;
}
__device__ __forceinline__ float wave_min(float v) {
#pragma unroll
    for (int o = 32; o >= 1; o >>= 1) v = fminf(v, __shfl_xor(v, o));
    return v;
}
__device__ __forceinline__ int wave_sumi(int v) {
#pragma unroll
    for (int o = 32; o >= 1; o >>= 1) v += __shfl_xor(v, o);
    return v;
}
__device__ __forceinline__ void set_flag(unsigned char* ws, unsigned bit) { atomicOr((unsigned*)(ws + WS_FLAG), bit); }
template <int CTRL> __device__ __forceinline__ float dpp_f(float v) { return __int_as_float(__builtin_amdgcn_update_dpp(0, __float_as_int(v), CTRL, 0xF, 0xF, false)); }
typedef __fp16 fp16x2_t __attribute__((ext_vector_type(2)));
__device__ __forceinline__ h2 pkrtz2(float a, float b) { const fp16x2_t r = __builtin_amdgcn_cvt_pkrtz(a, b); h2 o; __builtin_memcpy(&o, &r, 4); return o; }
__device__ __forceinline__ unsigned pack_i8x4(float a, float b, float c, float d, float scale) {
    int ia = __float2int_rn(a * scale), ib = __float2int_rn(b * scale), ic = __float2int_rn(c * scale), id = __float2int_rn(d * scale);
    ia = ia < -127 ? -127 : (ia > 127 ? 127 : ia); ib = ib < -127 ? -127 : (ib > 127 ? 127 : ib); ic = ic < -127 ? -127 : (ic > 127 ? 127 : ic); id = id < -127 ? -127 : (id > 127 ? 127 : id);
    return (unsigned)(ia & 0xFF) | ((unsigned)(ib & 0xFF) << 8) | ((unsigned)(ic & 0xFF) << 16) | ((unsigned)(id & 0xFF) << 24);
}
__device__ __forceinline__ float relu_i(float x) { const int b = __float_as_int(x); return __int_as_float(b > 0 ? b : 0); }
__device__ __forceinline__ float gelu_exact(float v) { return 0.5f * v * (1.0f + erff(v * 0.70710678118654752f)); }

namespace pg8 {
constexpr int BM = 256, BK = 64, HALF = 128, HTB = HALF * BK * 2, STAGE_BYTES = 8 * HTB, NXCD = 8, WGM = 8;
__host__ __device__ __forceinline__ int lds_byte(int r, int c) { const int st = (r >> 4) * 2 + (c >> 5), rr = r & 15, cc = c & 31, ob = rr * 64 + cc * 2; return st * 1024 + (ob ^ (((ob >> 9) & 1) << 5)); }
__host__ __device__ __forceinline__ void stage_rc(int b, int& R, int& C) { const int st = b / 1024, sb = b % 1024, swz = sb ^ (((sb >> 9) & 1) << 5); R = (st >> 1) * 16 + swz / 64; C = (st & 1) * 32 + (swz % 64) / 2; }
__host__ __device__ __forceinline__ int perm32(int rho) { const int n = rho >> 4, i = rho & 15; return 8 * (i >> 2) + 4 * n + (i & 3); }
struct Unit { int pm, pn; };
struct Gemm { const f16* A; const f16* Bt; int M, N, K; };
struct StaticOrder {
    int nM, nN, nwg, G, c;
    __device__ void init(int M, int N, int G_, int c_) { nM = M / BM; nN = N / BM; nwg = nM * nN; G = G_; c = c_; }
    __device__ bool next(int i, Unit& u) const {
        const long L = (long)i * G + c; if (L >= nwg) return false;
        int wgid = (int)L; { const int q = nwg / NXCD, r = nwg % NXCD, xcd = wgid % NXCD, off = wgid / NXCD; wgid = (xcd < r ? xcd * (q + 1) : r * (q + 1) + (xcd - r) * q) + off; }
        const int nig = WGM * nN, gid = wgid / nig, fm = gid * WGM, gsz = (nM - fm) < WGM ? (nM - fm) : WGM;
        u.pm = fm + ((wgid % nig) % gsz); u.pn = (wgid % nig) / gsz; return true;
    }
};

template <class Epi>
__device__ __forceinline__ void gemm_phase(LAS unsigned char* lds, const Gemm g, const StaticOrder& S_, const Epi& E) {
    const int tid = phase_tid(), wid = __builtin_amdgcn_readfirstlane(tid >> 6), lane = tid & 63, wr = wid >> 2, wc = wid & 3, fr = lane & 15, fq = lane >> 4;
    const int K = g.K, nt = K / BK;
    unsigned voffA[2], voffB[2];
#pragma unroll
    for (int i = 0; i < 2; ++i) { int R, C; stage_rc(tid * 16 + i * 8192, R, C); const int Rb = Epi::PERM ? ((R & ~31) + perm32(R & 31)) : R;
        voffA[i] = (unsigned)(R * K + C) * 2u; voffB[i] = (unsigned)(Rb * K + C) * 2u; }
    const size_t kstep = (size_t)(BK * 2);
    const size_t hstep = (size_t)HALF * K * 2;
    const size_t tstep = 2 * hstep;
    const unsigned ldsw = (unsigned)wid * 1024u;
    const int aoff = lds_byte(wr * 64 + fr, fq * 8), boff = lds_byte(wc * 32 + fr, fq * 8);
#define PG8_SA(b, h) (((b) * 2 + (h)) * HTB)
#define PG8_SB(b, h) ((4 + (b) * 2 + (h)) * HTB)
#define PG8_STAGE(bufoff, gbase, voff) do { _Pragma("unroll") for (int _i = 0; _i < 2; ++_i) \
        __builtin_amdgcn_global_load_lds((const unsigned*)((const char*)(gbase) + (voff)[_i]), (LAS unsigned*)(lds + (bufoff) + ldsw + _i * 8192), 16, 0, 0); } while (0)
#define PG8_LDA(dst, b, h) do { _Pragma("unroll") for (int m = 0; m < 4; ++m) _Pragma("unroll") for (int k = 0; k < 2; ++k) dst[m][k] = *(const LAS h8*)(lds + PG8_SA(b, h) + aoff + m * 2048 + k * 1024); } while (0)
#define PG8_LDB(dst, b, h) do { _Pragma("unroll") for (int n = 0; n < 2; ++n) _Pragma("unroll") for (int k = 0; k < 2; ++k) dst[n][k] = *(const LAS h8*)(lds + PG8_SB(b, h) + boff + n * 2048 + k * 1024); } while (0)
#define PG8_MMA(ai, bj, At, Bt) do { __builtin_amdgcn_s_setprio(1); _Pragma("unroll") for (int m = 0; m < 4; ++m) _Pragma("unroll") for (int n = 0; n < 2; ++n) _Pragma("unroll") for (int k = 0; k < 2; ++k) \
        acc[ai][bj][m][n] = __builtin_amdgcn_mfma_f32_16x16x32_f16(Bt[n][k], At[m][k], acc[ai][bj][m][n], 0, 0, 0); __builtin_amdgcn_s_setprio(0); } while (0)
#define PG8_WAIT_V(n) asm volatile("s_waitcnt vmcnt(" #n ")" ::: "memory")
#define PG8_WAIT_L(n) asm volatile("s_waitcnt lgkmcnt(" #n ")" ::: "memory")
#define PG8_BAR __builtin_amdgcn_s_barrier()
#define PG8_SCHED __builtin_amdgcn_sched_barrier(0)
    Unit cur, nxt; int ui = 0;
    if (!S_.next(0, cur)) return;
    f32x4 acc[2][2][4][2];
#pragma unroll
    for (int a = 0; a < 2; ++a)
#pragma unroll
        for (int b = 0; b < 2; ++b)
#pragma unroll
            for (int m = 0; m < 4; ++m)
#pragma unroll
                for (int n = 0; n < 2; ++n) acc[a][b][m][n] = (f32x4){0.f, 0.f, 0.f, 0.f};
    h8 At[4][2], B0[2][2], B1[2][2];
    const char* cA = (const char*)g.A + (size_t)cur.pm * tstep; const char* cB = (const char*)g.Bt + (size_t)cur.pn * tstep;
    PG8_STAGE(PG8_SB(0, 0), cB, voffB); PG8_STAGE(PG8_SA(0, 0), cA, voffA); PG8_STAGE(PG8_SB(0, 1), cB + hstep, voffB); PG8_STAGE(PG8_SA(0, 1), cA + hstep, voffA);
    if (wr == 1) PG8_BAR;
    PG8_WAIT_V(4); PG8_BAR;
    PG8_STAGE(PG8_SB(1, 0), cB + kstep, voffB); PG8_STAGE(PG8_SA(1, 0), cA + kstep, voffA); PG8_STAGE(PG8_SB(1, 1), cB + hstep + kstep, voffB);
    PG8_WAIT_V(6); PG8_BAR;
    for (;;) {
        const bool has_next = S_.next(ui + 1, nxt);
        const char* nA = has_next ? (const char*)g.A + (size_t)nxt.pm * tstep : cA; const char* nB = has_next ? (const char*)g.Bt + (size_t)nxt.pn * tstep : cB;
        for (int t = 0; t < nt; t += 2) {
            const bool last = (t == nt - 2);
            const char* a1 = cA + (size_t)(t + 1) * kstep;
            const char* a2 = last ? nA : cA + (size_t)(t + 2) * kstep; const char* b2 = last ? nB : cB + (size_t)(t + 2) * kstep;
            const char* a3 = a2 + kstep; const char* b3 = b2 + kstep;
            PG8_LDB(B0, 0, 0); PG8_SCHED; PG8_LDA(At, 0, 0); PG8_STAGE(PG8_SA(1, 1), a1 + hstep, voffA);
            PG8_WAIT_L(8); PG8_BAR; PG8_WAIT_L(0); PG8_MMA(0, 0, At, B0); PG8_BAR; PG8_SCHED;
            PG8_LDB(B1, 0, 1); PG8_STAGE(PG8_SB(0, 0), b2, voffB);
            PG8_BAR; PG8_WAIT_L(0); PG8_MMA(0, 1, At, B1); PG8_BAR;
            PG8_LDA(At, 0, 1); PG8_STAGE(PG8_SA(0, 0), a2, voffA);
            PG8_BAR; PG8_WAIT_L(0); PG8_MMA(1, 0, At, B0); PG8_BAR; PG8_SCHED;
            PG8_STAGE(PG8_SB(0, 1), b2 + hstep, voffB);
            PG8_WAIT_V(6); PG8_BAR; PG8_MMA(1, 1, At, B1); PG8_BAR;
            PG8_LDB(B0, 1, 0); PG8_SCHED; PG8_LDA(At, 1, 0); PG8_STAGE(PG8_SA(0, 1), a2 + hstep, voffA);
            PG8_WAIT_L(8); PG8_BAR; PG8_WAIT_L(0); PG8_MMA(0, 0, At, B0); PG8_BAR; PG8_SCHED;
            PG8_LDB(B1, 1, 1); PG8_STAGE(PG8_SB(1, 0), b3, voffB);
            PG8_BAR; PG8_WAIT_L(0); PG8_MMA(0, 1, At, B1); PG8_BAR;
            PG8_LDA(At, 1, 1); PG8_STAGE(PG8_SA(1, 0), a3, voffA);
            PG8_BAR; PG8_WAIT_L(0); PG8_MMA(1, 0, At, B0); PG8_BAR; PG8_SCHED;
            PG8_STAGE(PG8_SB(1, 1), b3 + hstep, voffB);
            PG8_WAIT_V(6); PG8_BAR; PG8_MMA(1, 1, At, B1); PG8_BAR;
        }
        E(acc, cur, wr, wc, fr, fq);
        if (!has_next) break;
#pragma unroll
        for (int a = 0; a < 2; ++a)
#pragma unroll
            for (int b = 0; b < 2; ++b)
#pragma unroll
                for (int m = 0; m < 4; ++m)
#pragma unroll
                    for (int n = 0; n < 2; ++n) acc[a][b][m][n] = (f32x4){0.f, 0.f, 0.f, 0.f};
        cur = nxt; cA = nA; cB = nB; ++ui;
    }
    PG8_WAIT_V(0);
    if (wr == 0) PG8_BAR;
    PG8_BAR;
#undef PG8_SA
#undef PG8_SB
#undef PG8_STAGE
#undef PG8_LDA
#undef PG8_LDB
#undef PG8_MMA
#undef PG8_WAIT_V
#undef PG8_WAIT_L
#undef PG8_BAR
#undef PG8_SCHED
}
}

struct EpiIn {
    static constexpr bool PERM = true;
    f16* QKV; f16* IQ; float* IKRAW; float* IW;
    __device__ __forceinline__ void operator()(const f32x4 (&acc)[2][2][4][2], const pg8::Unit& u, int wr, int wc, int fr, int fq) const {
#pragma unroll
        for (int bj = 0; bj < 2; ++bj) {
            const int cb = u.pn * 256 + bj * 128 + wc * 32;
            if (cb >= NPROJ) continue;
            const int c0 = cb + 8 * fq;
#pragma unroll
            for (int ai = 0; ai < 2; ++ai)
#pragma unroll
                for (int m = 0; m < 4; ++m) {
                    const int r = u.pm * 256 + ai * 128 + wr * 64 + m * 16 + fr;
                    const f32x4 v0 = acc[ai][bj][m][0], v1 = acc[ai][bj][m][1];
                    if (cb < 3072) {
                        const int g = cb >> 9, hh = (cb & 511) >> 6, d = (c0 & 63);
                        if (g >= 4) {
                            unsigned char* dst = (unsigned char*)(QKV + (size_t)4 * 8 * S * 64) + ((size_t)hh * S + r) * 128 + (g - 4) * 64 + d;
                            u32x2 o;
                            if (g == 4) { o[0] = pack_i8x4(v0[0], v0[1], v0[2], v0[3], DSA_K_ISCALE); o[1] = pack_i8x4(v1[0], v1[1], v1[2], v1[3], DSA_K_ISCALE); }
                            else { o[0] = pack_fp8x4(v0[0] * DSA_KV_SCALE, v0[1] * DSA_KV_SCALE, v0[2] * DSA_KV_SCALE, v0[3] * DSA_KV_SCALE);
                                   o[1] = pack_fp8x4(v1[0] * DSA_KV_SCALE, v1[1] * DSA_KV_SCALE, v1[2] * DSA_KV_SCALE, v1[3] * DSA_KV_SCALE); }
                            *(u32x2*)dst = o;
                        } else if (g != 2) {
                            h8 o; o[0] = (f16)v0[0]; o[1] = (f16)v0[1]; o[2] = (f16)v0[2]; o[3] = (f16)v0[3]; o[4] = (f16)v1[0]; o[5] = (f16)v1[1]; o[6] = (f16)v1[2]; o[7] = (f16)v1[3];
                            *(h8*)(QKV + ((size_t)(g * 8 + hh) * S + r) * 64 + d) = o;
                        } else {
                            f16* base = QKV + ((size_t)(2 * 8 + hh) * 64 + d) * S + r;
#pragma unroll
                            for (int i = 0; i < 4; ++i) { base[(size_t)i * S] = (f16)v0[i]; base[(size_t)(i + 4) * S] = (f16)v1[i]; }
                        }
                    } else if (cb < 3328) {
                        h8 o; o[0] = (f16)v0[0]; o[1] = (f16)v0[1]; o[2] = (f16)v0[2]; o[3] = (f16)v0[3]; o[4] = (f16)v1[0]; o[5] = (f16)v1[1]; o[6] = (f16)v1[2]; o[7] = (f16)v1[3];
                        *(h8*)(IQ + (size_t)r * 256 + (c0 - 3072)) = o;
                    } else if (cb < 3392) {
                        float* dst = IKRAW + (size_t)r * 64 + (c0 - 3328);
                        *(f32x4*)dst = v0; *(f32x4*)(dst + 4) = v1;
                    } else {
                        if (fq == 0) *(f32x4*)(IW + (size_t)r * 4) = v0 * 0.5f;
                    }
                }
        }
    }
};
struct EpiOut {
    static constexpr bool PERM = false;
    const float* Xin; float* X1; const float* g1;
    __device__ __forceinline__ void operator()(const f32x4 (&acc)[2][2][4][2], const pg8::Unit& u, int wr, int wc, int fr, int fq) const {
#pragma unroll
        for (int bj = 0; bj < 2; ++bj)
#pragma unroll
            for (int n = 0; n < 2; ++n) {
                const int c = u.pn * 256 + bj * 128 + wc * 32 + 16 * n + 4 * fq;
                f32x4 xv[2][4];
#pragma unroll
                for (int ai = 0; ai < 2; ++ai)
#pragma unroll
                    for (int m = 0; m < 4; ++m) {
                        const int r = u.pm * 256 + ai * 128 + wr * 64 + m * 16 + fr;
                        xv[ai][m] = *(const f32x4*)(Xin + (size_t)r * D + c);
                    }
                const f32x4 gv = *(const f32x4*)(g1 + c);
#pragma unroll
                for (int ai = 0; ai < 2; ++ai)
#pragma unroll
                    for (int m = 0; m < 4; ++m) {
                        const int r = u.pm * 256 + ai * 128 + wr * 64 + m * 16 + fr;
                        *(f32x4*)(X1 + (size_t)r * D + c) = (DIAG == 1) ? xv[ai][m] : (xv[ai][m] + gv * acc[ai][bj][m][n]);
                    }
            }
    }
};
struct EpiPQ {
    static constexpr bool PERM = true;
    f16* PQ;
    __device__ __forceinline__ void operator()(const f32x4 (&acc)[2][2][4][2], const pg8::Unit& u, int wr, int wc, int fr, int fq) const {
#pragma unroll
        for (int bj = 0; bj < 2; ++bj) {
            const int c0 = u.pn * 256 + bj * 128 + wc * 32 + 8 * fq;
#pragma unroll
            for (int ai = 0; ai < 2; ++ai)
#pragma unroll
                for (int m = 0; m < 4; ++m) {
                    const int r = u.pm * 256 + ai * 128 + wr * 64 + m * 16 + fr;
                    const f32x4 v0 = acc[ai][bj][m][0], v1 = acc[ai][bj][m][1];
                    h8 o; o[0] = (f16)v0[0]; o[1] = (f16)v0[1]; o[2] = (f16)v0[2]; o[3] = (f16)v0[3]; o[4] = (f16)v1[0]; o[5] = (f16)v1[1]; o[6] = (f16)v1[2]; o[7] = (f16)v1[3];
                    *(h8*)(PQ + (size_t)r * NQ + c0) = o;
                }
        }
    }
};

__device__ __forceinline__ void transpose_tile(const float* __restrict__ src, int K, int N, f16* __restrict__ dst, int k0, int n0, LAS f16* tile) {
    const int tid = phase_tid();
    { const int kk = tid >> 4, n4 = (tid & 15) * 4;
#pragma unroll
      for (int p = 0; p < 2; ++p) { const int k = k0 + kk + 32 * p, n = n0 + n4;
          f32x4 v = (f32x4){0.f, 0.f, 0.f, 0.f}; if (n < N) v = *(const f32x4*)(src + (size_t)k * N + n);
#pragma unroll
          for (int i = 0; i < 4; ++i) tile[(n4 + i) * 72 + kk + 32 * p] = (f16)v[i]; } }
    __syncthreads();
    { const int nn = tid >> 3, k8 = (tid & 7) * 8;
      const h8 v = *(const LAS h8*)(tile + nn * 72 + k8);
      *(h8*)(dst + (size_t)(n0 + nn) * K + k0 + k8) = v; }
    __syncthreads();
}
__device__ __forceinline__ void convert_chunk(const float* __restrict__ src, f16* __restrict__ dst, size_t base, int ptid) {
    const size_t o = base + (size_t)ptid * 8;
    const f32x4 a = *(const f32x4*)(src + o), b = *(const f32x4*)(src + o + 4);
    h8 v; v[0] = (f16)a[0]; v[1] = (f16)a[1]; v[2] = (f16)a[2]; v[3] = (f16)a[3]; v[4] = (f16)b[0]; v[5] = (f16)b[1]; v[6] = (f16)b[2]; v[7] = (f16)b[3];
    *(h8*)(dst + o) = v;
}
template <bool I8>
__device__ __forceinline__ void convert_chunk_fp8(const float* __restrict__ src, unsigned char* __restrict__ dst, size_t base, int ptid, float scale) {
    f32x4 a[4], b[4];
#pragma unroll
    for (int c = 0; c < 4; ++c) { const size_t o = base + (size_t)c * 4096 + (size_t)ptid * 8; a[c] = __builtin_nontemporal_load((const f32x4*)(src + o)); b[c] = __builtin_nontemporal_load((const f32x4*)(src + o + 4)); }
#pragma unroll
    for (int c = 0; c < 4; ++c) { const size_t o = base + (size_t)c * 4096 + (size_t)ptid * 8; const f32x4 x = a[c] * scale, y = b[c] * scale;
        u32x2 v;
        if (I8) { v[0] = pack_i8x4(a[c][0], a[c][1], a[c][2], a[c][3], scale); v[1] = pack_i8x4(b[c][0], b[c][1], b[c][2], b[c][3], scale); }
        else { v[0] = pack_fp8x4(x[0], x[1], x[2], x[3]); v[1] = pack_fp8x4(y[0], y[1], y[2], y[3]); }
        *(u32x2*)(dst + o) = v; }
}
__device__ __forceinline__ void phase_prologue(const Params& p_, LAS unsigned char* lds) {
    const Params p = load_params(); (void)p_;
    unsigned char* ws = phase_ws(p.ws); const int ptid = phase_tid();
    const int G = gridDim.x;
    constexpr int N_TR = 2 * 1664, N_SUBK = 128, N_UV = 2048, N_MOD = 192;
    constexpr int TOTAL = N_TR + N_SUBK + 2 * N_UV + N_MOD;
    for (int it = blockIdx.x; it < TOTAL; it += G) {
        if (it < N_MOD) {
            const int kc = it / 24, cg = it % 24, e = cg * 512 + ptid, l = e / 6144, ee = e % 6144;
            float acc = 0.f;
#pragma unroll 16
            for (int d = kc * 128; d < kc * 128 + 128; ++d) { const float cv = p.c[d]; const float sv = cv / (1.0f + __expf(-cv)); acc += sv * p.w_ada[((size_t)l * D + d) * 6144 + ee]; }
            ((float*)(ws + WS_MODP))[kc * 12288 + e] = acc;
        } else if (it < N_MOD + N_TR) {
            int j = it - N_MOD; const int l = j / 1664; j %= 1664;
            if (j < 896) { const int kt = j / 56, ntile = j % 56; transpose_tile(p.w_in + (size_t)l * D * NPROJ, D, NPROJ, (f16*)(ws + WS_WIN) + (size_t)l * NPAD * D, kt * 64, ntile * 64, (LAS f16*)lds); }
            else if (j < 896 + 256) { j -= 896; const int kt = j / 16, ntile = j % 16; transpose_tile(p.w_out + (size_t)l * D * D, D, D, (f16*)(ws + WS_WOUT) + (size_t)l * D * D, kt * 64, ntile * 64, (LAS f16*)lds); }
            else { j -= 1152; const int kt = j / 32, ntile = j % 32; transpose_tile(p.peer_wq + (size_t)l * D * NQ, D, NQ, (f16*)(ws + WS_WQ) + (size_t)l * NQ * D, kt * 64, ntile * 64, (LAS f16*)lds); }
        } else if (it < N_MOD + N_TR + N_SUBK) {
            convert_chunk(p.peer_subkeys, (f16*)(ws + WS_SUBK), (size_t)(it - N_MOD - N_TR) * 4096, ptid);
        } else if (it < N_MOD + N_TR + N_SUBK + N_UV) {
            convert_chunk_fp8<true>(p.peer_u, ws + WS_U16, (size_t)(it - N_MOD - N_TR - N_SUBK) * 16384, ptid, PEER_U_SCALE);
        } else {
            convert_chunk_fp8<false>(p.peer_v, ws + WS_V16, (size_t)(it - N_MOD - N_TR - N_SUBK - N_UV) * 16384, ptid, PEER_V_SCALE);
        }
    }
}
__device__ __forceinline__ float modv_partial(const Params& p, int e) {
    const float* mp = (const float*)(p.ws + WS_MODP);
    float v = p.b_ada[e];
#pragma unroll
    for (int kc = 0; kc < 8; ++kc) v += mp[kc * 12288 + e];
    return v;
}

template <bool FROM_PARTIAL>
__device__ __forceinline__ void phase_norm(const Params& p_, LAS unsigned char* lds, int l, int which) {
    const Params p = load_params(); (void)p_;
    const int shc = which ? 3 : 0, scc = which ? 4 : 1;
    LAS float* sh = (LAS float*)lds; LAS float* sc = sh + 1024; LAS float* nwl = sc + 1024;
    unsigned char* ws = phase_ws(p.ws); const int ptid = phase_tid();
    const float* X = which ? (const float*)(ws + WS_X1) : p.x; const float* nw = (which ? p.norm_ffn : p.norm_attn) + l * 1024;
    float* MOD = (float*)(ws + WS_MOD);
    if (FROM_PARTIAL) {
        for (int e = blockIdx.x * NTHREADS + ptid; e < 12288; e += gridDim.x * NTHREADS) MOD[e] = modv_partial(p, e);
        for (int i = ptid; i < 1024; i += NTHREADS) { sh[i] = modv_partial(p, l * 6144 + shc * 1024 + i); sc[i] = modv_partial(p, l * 6144 + scc * 1024 + i); nwl[i] = nw[i]; }
    } else {
        for (int i = ptid; i < 1024; i += NTHREADS) { sh[i] = MOD[l * 6144 + shc * 1024 + i]; sc[i] = MOD[l * 6144 + scc * 1024 + i]; nwl[i] = nw[i]; }
    }
    __syncthreads();
    f16* H = (f16*)(ws + WS_H);
    const int lane = ptid & 63, gw = blockIdx.x * NWAVES + (ptid >> 6);
    const int tstep = gridDim.x * NWAVES;
    f32x4 nx[4];
    if (gw < S) {
#pragma unroll
        for (int i = 0; i < 4; ++i) nx[i] = *(const f32x4*)(X + (size_t)gw * D + 256 * i + 4 * lane);
    }
    for (int t = gw; t < S; t += tstep) {
        f32x4 v[4]; float ss = 0.f;
#pragma unroll
        for (int i = 0; i < 4; ++i) v[i] = nx[i];
        if (t + tstep < S) {
#pragma unroll
            for (int i = 0; i < 4; ++i) nx[i] = *(const f32x4*)(X + (size_t)(t + tstep) * D + 256 * i + 4 * lane);
        }
#pragma unroll
        for (int i = 0; i < 4; ++i) ss += v[i][0] * v[i][0] + v[i][1] * v[i][1] + v[i][2] * v[i][2] + v[i][3] * v[i][3];
        ss = wave_sum(ss);
        const float r = rsqrtf(ss * (1.0f / D) + EPS);
#pragma unroll
        for (int i = 0; i < 4; ++i) { const int c = 256 * i + 4 * lane; h4 o;
#pragma unroll
            for (int j = 0; j < 4; ++j) o[j] = (f16)((v[i][j] * r * nwl[c + j]) * (1.0f + sc[c + j]) + sh[c + j]);
            *(h4*)(H + (size_t)t * D + c) = o; }
    }
    __syncthreads();
}

__device__ __forceinline__ void phase_prep(const Params& p_, LAS unsigned char* lds) {
    const Params p = load_params(); (void)p_;
    unsigned char* ws = phase_ws(p.ws); const int ptid = phase_tid();
    const int lane = ptid & 63, wave = ptid >> 6, gw = blockIdx.x * NWAVES + wave;
    const float* IKRAW = (const float*)(ws + WS_IKRAW); f16* KN = (f16*)(ws + WS_KN);
    {
        const int tstep = gridDim.x * NWAVES;
        float vv[8];
#pragma unroll
        for (int k = 0; k < 8; ++k) { const int t = gw + k * tstep; vv[k] = t < S ? IKRAW[(size_t)t * 64 + lane] : 0.f; }
#pragma unroll
        for (int k = 0; k < 8; ++k) { const int t = gw + k * tstep;
            const float ss = wave_sum(vv[k] * vv[k]);
            if (t < S) KN[(size_t)t * 64 + lane] = (f16)(vv[k] * rsqrtf(ss * (1.0f / 64) + EPS)); }
        for (int t = gw + 8 * tstep; t < S; t += tstep) {
            const float v = IKRAW[(size_t)t * 64 + lane];
            const float ss = wave_sum(v * v);
            KN[(size_t)t * 64 + lane] = (f16)(v * rsqrtf(ss * (1.0f / 64) + EPS));
        }
    }
    const f16* MK = (const f16*)(ws + WS_QKV) + (size_t)1 * 8 * S * 64;
    float* KMEAN = (float*)(ws + WS_KMEAN);
    LAS float* red = (LAS float*)lds;
    for (int it = blockIdx.x; it < 512; it += 2 * gridDim.x) {
        const int it1 = it + gridDim.x;
        const f16* base0 = MK + ((size_t)(it >> 6) * S + (size_t)(it & 63) * 256 + wave * 32) * 64 + lane;
        const f16* base1 = MK + ((size_t)((it1 & 511) >> 6) * S + (size_t)(it1 & 63) * 256 + wave * 32) * 64 + lane;
        f16 x0[32], x1[32];
#pragma unroll
        for (int r = 0; r < 32; ++r) { x0[r] = base0[(size_t)r * 64]; x1[r] = base1[(size_t)r * 64]; }
        float a0 = 0.f, a1 = 0.f;
#pragma unroll
        for (int r = 0; r < 32; ++r) { a0 += (float)x0[r]; a1 += (float)x1[r]; }
        red[wave * 64 + lane] = a0; red[512 + wave * 64 + lane] = a1;
        __syncthreads();
        if (wave < 2) { float s = 0.f;
#pragma unroll
            for (int w = 0; w < 8; ++w) s += red[wave * 512 + w * 64 + lane];
            const int io = wave ? it1 : it;
            if (io < 512) KMEAN[(size_t)io * 64 + lane] = s * (1.0f / 256.0f); }
        __syncthreads();
    }
}

__device__ __forceinline__ void phase_gate(const Params& p_, LAS unsigned char* lds, int layer, bool dry = false) {
    const Params p = load_params(); (void)p_;
    unsigned char* ws = phase_ws(p.ws); const int ptid = phase_tid();
    const f16* MQ = (const f16*)(ws + WS_QKV);
    const float* KMEAN = (const float*)(ws + WS_KMEAN);
    int* SEL = (int*)(ws + WS_SEL);
    unsigned* LCNT = (unsigned*)(ws + WS_LCNT) + layer * 512;
    u16* LIST = (u16*)(ws + WS_LIST);
    LAS float* km = (LAS float*)lds;
    for (int it = blockIdx.x; it < 256; it += gridDim.x) {
        const int h = it >> 5, t = (it & 31) * 512 + ptid, b0 = t >> 8;
        __syncthreads();
        for (int i = ptid; i < 4096; i += NTHREADS) km[i] = KMEAN[(size_t)h * 4096 + i];
        __syncthreads();
        float q[64];
        { const f16* qp = MQ + ((size_t)h * S + t) * 64;
#pragma unroll
          for (int i = 0; i < 8; ++i) { const h8 v = *(const h8*)(qp + 8 * i);
#pragma unroll
              for (int j = 0; j < 8; ++j) q[8 * i + j] = (float)v[j]; } }
        float v0 = -INFINITY, v1 = -INFINITY, v2 = -INFINITY; int s0 = -1, s1 = -1, s2 = -1;
        const int b0u = __builtin_amdgcn_readfirstlane(b0);
        for (int n = 0; n < b0u; ++n) {
            float g = 0.f;
#pragma unroll
            for (int d4 = 0; d4 < 16; ++d4) { const f32x4 kv = *(const LAS f32x4*)(km + n * 64 + 4 * d4);
                g += q[4 * d4] * kv[0]; g += q[4 * d4 + 1] * kv[1]; g += q[4 * d4 + 2] * kv[2]; g += q[4 * d4 + 3] * kv[3]; }
            if (g > v0) { v2 = v1; s2 = s1; v1 = v0; s1 = s0; v0 = g; s0 = n; }
            else if (g > v1) { v2 = v1; s2 = s1; v1 = g; s1 = n; }
            else if (g > v2) { v2 = g; s2 = n; }
        }
        if (dry) { if (s0 == 12345) SEL[0] = 0; continue; }
        SEL[(size_t)h * S + t] = (s0 & 0xFF) | ((s1 & 0xFF) << 8) | ((s2 & 0xFF) << 16);
        if (s0 >= 0) { const unsigned pos = atomicAdd(&LCNT[h * 64 + s0], 1u); LIST[((size_t)(h * 64 + s0)) * S + pos] = (u16)(t | (0 << 14)); }
        if (s1 >= 0) { const unsigned pos = atomicAdd(&LCNT[h * 64 + s1], 1u); LIST[((size_t)(h * 64 + s1)) * S + pos] = (u16)(t | (1 << 14)); }
        if (s2 >= 0) { const unsigned pos = atomicAdd(&LCNT[h * 64 + s2], 1u); LIST[((size_t)(h * 64 + s2)) * S + pos] = (u16)(t | (2 << 14)); }
    }
    __syncthreads();
}

constexpr int TK_CAP = 1280, TK_TRIG = 1024, TK_K = 256, TK_E = TK_CAP / 64;
constexpr int TK_E1 = 12, TK_F0 = 640;
template <int E>
__device__ __forceinline__ void topk_compact(LAS float* val, LAS u16* idx, LAS unsigned* cnt, LAS float* tau, int lane, const int K = TK_K) {
    const int n = (int)*cnt;
    unsigned key[E]; unsigned id[E];
    unsigned kmin = 0xFFFFFFFFu, kmax = 0u;
    float vraw[E]; unsigned iraw[E];
#pragma unroll
    for (int i = 0; i < E; ++i) { vraw[i] = val[lane + 64 * i]; iraw[i] = (unsigned)idx[lane + 64 * i]; }
#pragma unroll
    for (int i = 0; i < E; ++i) { const int e = lane + 64 * i; const bool ok = e < n; key[i] = ok ? f2ord(vraw[i]) : 0u; id[i] = ok ? iraw[i] : 0xFFFFu;
        kmax = key[i] > kmax ? key[i] : kmax; const unsigned km = ok ? key[i] : 0xFFFFFFFFu; kmin = km < kmin ? km : kmin; }
#pragma unroll
    for (int o = 32; o >= 1; o >>= 1) { const unsigned a = (unsigned)__shfl_xor((int)kmax, o), b = (unsigned)__shfl_xor((int)kmin, o); kmax = a > kmax ? a : kmax; kmin = b < kmin ? b : kmin; }
    unsigned lo = kmin, hi = kmax + 1u;
    while (hi - lo > 1u) {
        const unsigned mid = lo + ((hi - lo) >> 1);
        int c = 0;
#pragma unroll
        for (int i = 0; i < E; ++i) c += __popcll(__ballot(key[i] >= mid));
        if (c >= K) lo = mid; else hi = mid;
    }
    const unsigned vstar = lo;
    int cgt = 0, ceq = 0;
#pragma unroll
    for (int i = 0; i < E; ++i) { cgt += __popcll(__ballot(key[i] > vstar)); ceq += __popcll(__ballot(key[i] == vstar)); }
    const int r = K - cgt;
    unsigned istar = 0xFFFFu;
    if (ceq > r) {
        unsigned ilo = 0u, ihi = 0xFFFFu;
        while (ilo < ihi) {
            const unsigned mid = (ilo + ihi) >> 1;
            int c = 0;
#pragma unroll
            for (int i = 0; i < E; ++i) c += __popcll(__ballot(key[i] == vstar && id[i] <= mid));
            if (c >= r) ihi = mid; else ilo = mid + 1u;
        }
        istar = ilo;
    }
    int base = 0;
    const unsigned long long lt = (1ull << lane) - 1ull;
#pragma unroll
    for (int i = 0; i < E; ++i) {
        const bool keep = key[i] > vstar || (key[i] == vstar && id[i] <= istar);
        const unsigned long long bal = __ballot(keep);
        if (keep) { const int pos = base + __popcll(bal & lt); val[pos] = ord2f(key[i]); idx[pos] = (u16)id[i]; }
        base += __popcll(bal);
    }
    if (lane == 0) { *cnt = (unsigned)base; *tau = ord2f(vstar); }
}
template <int E>
__device__ __forceinline__ int topk_compact_approx(LAS float* val, LAS u16* idx, LAS unsigned* cnt, LAS float* tau, LAS unsigned* hist, int lane, const int K = TK_K) {
    const int n = (int)*cnt;
    unsigned key[E];
    unsigned kmin = 0xFFFFFFFFu, kmax = 0u;
    float vraw[E];
#pragma unroll
    for (int i = 0; i < E; ++i) vraw[i] = val[lane + 64 * i];
#pragma unroll
    for (int i = 0; i < E; ++i) { const int e = lane + 64 * i; const bool ok = e < n; key[i] = ok ? f2ord(vraw[i]) : 0u;
        kmax = key[i] > kmax ? key[i] : kmax; const unsigned km = ok ? key[i] : 0xFFFFFFFFu; kmin = km < kmin ? km : kmin; }
#pragma unroll
    for (int o = 32; o >= 1; o >>= 1) { const unsigned a = (unsigned)__shfl_xor((int)kmax, o), b = (unsigned)__shfl_xor((int)kmin, o); kmax = a > kmax ? a : kmax; kmin = b < kmin ? b : kmin; }
    const unsigned R = kmax - kmin;
    const int sh = (R >> 8) ? (32 - __clz((int)(R >> 8))) : 0;
#pragma unroll
    for (int j = 0; j < 4; ++j) hist[4 * lane + j] = 0u;
    __builtin_amdgcn_wave_barrier();
#pragma unroll
    for (int i = 0; i < E; ++i) if (lane + 64 * i < n) __hip_atomic_fetch_add(&hist[(key[i] - kmin) >> sh], 1u, __ATOMIC_RELAXED, __HIP_MEMORY_SCOPE_WORKGROUP);
    __builtin_amdgcn_wave_barrier();
    auto find_bin = [&](unsigned want, unsigned& bin, unsigned& nabove) {
        unsigned hb[4];
#pragma unroll
        for (int j = 0; j < 4; ++j) hb[j] = hist[4 * lane + j];
        const unsigned lsum = hb[0] + hb[1] + hb[2] + hb[3];
        unsigned above = lsum;
#pragma unroll
        for (int o = 1; o < 64; o <<= 1) { const unsigned v = (unsigned)__shfl_down((int)above, o); if (lane + o < 64) above += v; }
        const unsigned excl = above - lsum;
        unsigned sfx[4];
        sfx[3] = excl + hb[3]; sfx[2] = sfx[3] + hb[2]; sfx[1] = sfx[2] + hb[1]; sfx[0] = sfx[1] + hb[0];
        int mybin = -1; unsigned myab = 0u;
#pragma unroll
        for (int j = 0; j < 4; ++j) if (sfx[j] >= want) { mybin = 4 * lane + j; myab = sfx[j] - hb[j]; }
        int b = mybin;
#pragma unroll
        for (int o = 32; o >= 1; o >>= 1) { const int v = __shfl_xor(b, o); b = v > b ? v : b; }
        bin = (unsigned)b; nabove = (unsigned)__shfl((int)myab, b >> 2);
    };
    unsigned b1, above1;
    find_bin((unsigned)K, b1, above1);
    const unsigned edge0 = kmin + (b1 << sh);
    unsigned edge = edge0;
    if (sh > 0) {
        const int sh2 = sh > 8 ? sh - 8 : 0;
        __builtin_amdgcn_wave_barrier();
#pragma unroll
        for (int j = 0; j < 4; ++j) hist[4 * lane + j] = 0u;
        __builtin_amdgcn_wave_barrier();
#pragma unroll
        for (int i = 0; i < E; ++i) if (lane + 64 * i < n && ((key[i] - kmin) >> sh) == b1) __hip_atomic_fetch_add(&hist[(key[i] - edge0) >> sh2], 1u, __ATOMIC_RELAXED, __HIP_MEMORY_SCOPE_WORKGROUP);
        __builtin_amdgcn_wave_barrier();
        unsigned b2, above2;
        find_bin((unsigned)K - above1, b2, above2);
        edge = edge0 + (b2 << sh2);
    }
    int base = 0;
    const unsigned long long lt = (1ull << lane) - 1ull;
    u16 idn = idx[lane];
#pragma unroll
    for (int i = 0; i < E; ++i) {
        const u16 idc = idn;
        if (i + 1 < E) idn = idx[lane + 64 * (i + 1)];
        const bool keep = key[i] >= edge && (lane + 64 * i < n);
        const unsigned long long bal = __ballot(keep);
        if (keep) { const int pos = base + __popcll(bal & lt); val[pos] = ord2f(key[i]); idx[pos] = idc; }
        base += __popcll(bal);
    }
    if (lane == 0) { *cnt = (unsigned)base; *tau = ord2f(edge - 1u); }
    return base;
}
__device__ __forceinline__ void phase_topk(const Params& p_, LAS unsigned char* lds, int layer) {
    const Params p = load_params(); (void)p_;
    unsigned char* ws = phase_ws(p.ws); const int ptid = phase_tid();
    const f16* IQ = (const f16*)(ws + WS_IQ); const f16* KN = (const f16*)(ws + WS_KN); const float* IW = (const float*)(ws + WS_IW);
    u16* IDX = (u16*)(ws + WS_IDX); int* NIDX = (int*)(ws + WS_NIDX);
    LAS float* val = (LAS float*)lds;
    LAS u16* idx = (LAS u16*)(lds + 16 * TK_CAP * 4);
    LAS unsigned* cnt = (LAS unsigned*)(lds + 16 * TK_CAP * 6);
    LAS float* tau = (LAS float*)(lds + 16 * TK_CAP * 6 + 64);
    LAS unsigned* flg = (LAS unsigned*)(lds + 16 * TK_CAP * 6 + 128);
    LAS unsigned* hist = (LAS unsigned*)(lds + 16 * TK_CAP * 6 + 1024) + 256 * (ptid >> 6);
    static_assert(16 * TK_CAP * 6 + 1024 + 8 * 1024 <= LDS_BYTES - 16, "topk LDS");
    LAS unsigned* specd = (LAS unsigned*)(lds + 16 * TK_CAP * 6 + 256);
    LAS unsigned* failq = (LAS unsigned*)(lds + 16 * TK_CAP * 6 + 320);
    const int tid = ptid, lane = tid & 63, wave = __builtin_amdgcn_readfirstlane(tid >> 6), half = lane >> 5, l31 = lane & 31;
    unsigned* tctr = (unsigned*)(ws + WS_CTL + 41472) + layer;
    LAS int* tsl = (LAS int*)(lds + 16 * TK_CAP * 6 + 512);
    for (;;) {
        __syncthreads();
        if (tid == 0) tsl[0] = (int)__hip_atomic_fetch_add(tctr, 1u, __ATOMIC_RELAXED, __HIP_MEMORY_SCOPE_AGENT);
        __syncthreads();
        const int ti = tsl[0];
        if (ti >= 1024) break;
        const int tile = 1023 - ti;
        const int t0 = tile * 16;
        __syncthreads();
        if (tid < 16) { cnt[tid] = 0u; tau[tid] = -INFINITY; specd[tid] = 0u; failq[tid] = 0u; }
        if (tid == 16) failq[16] = 0u;
        if (tid < 3) flg[tid] = 0u;
        h8 a[2][4];
#pragma unroll
        for (int mt = 0; mt < 2; ++mt)
#pragma unroll
            for (int kk = 0; kk < 4; ++kk) a[mt][kk] = *(const h8*)(IQ + (size_t)(t0 + mt * 8 + (l31 >> 2)) * 256 + (l31 & 3) * 64 + 16 * kk + 8 * half);
        float wq[2][4][4];
#pragma unroll
        for (int mt = 0; mt < 2; ++mt)
#pragma unroll
            for (int j = 0; j < 4; ++j) { const f32x4 w = *(const f32x4*)(IW + (size_t)(t0 + mt * 8 + 2 * j + half) * 4);
                wq[mt][j][0] = w[0]; wq[mt][j][1] = w[1]; wq[mt][j][2] = w[2]; wq[mt][j][3] = w[3]; }
        const int nkt = (t0 + 15) / 256 + 1;
        const int kt0base = nkt > 32 ? 2 : (nkt > 13 ? 1 : -1);
        for (int pass = 0; pass < 2; ++pass) {
        if (pass == 1) {
            __syncthreads();
            if (failq[16] == 0u) break;
            __syncthreads();
            if (tid < 16) { const bool f = failq[tid] != 0u; cnt[tid] = 0u; tau[tid] = f ? -INFINITY : INFINITY; }
            if (tid < 3) flg[tid] = 0u;
        }
        const int kt0 = pass == 0 ? kt0base : -1;
        h8 bnx[4];
#pragma unroll
        for (int kk = 0; kk < 4; ++kk) bnx[kk] = *(const h8*)(KN + (size_t)(32 * wave + l31) * 64 + 16 * kk + 8 * half);
        __syncthreads();
        int par = 0;
        float tq[2][4];
#pragma unroll
        for (int mt = 0; mt < 2; ++mt)
#pragma unroll
            for (int j = 0; j < 4; ++j) tq[mt][j] = tau[mt * 8 + 2 * j + half];
        for (int kt = 0; kt < nkt; ++kt) {
            const int kb = kt * 256 + 32 * wave;
            const int s = kb + l31;
            h8 bfr[4];
#pragma unroll
            for (int kk = 0; kk < 4; ++kk) bfr[kk] = bnx[kk];
            if (kt + 1 < nkt) {
#pragma unroll
                for (int kk = 0; kk < 4; ++kk) bnx[kk] = *(const h8*)(KN + (size_t)(s + 256) * 64 + 16 * kk + 8 * half);
            }
            f32x16 acc[2];
#pragma unroll
            for (int mt = 0; mt < 2; ++mt) { acc[mt] = (f32x16){0.f,0.f,0.f,0.f,0.f,0.f,0.f,0.f,0.f,0.f,0.f,0.f,0.f,0.f,0.f,0.f};
#pragma unroll
                for (int kk = 0; kk < 4; ++kk) acc[mt] = __builtin_amdgcn_mfma_f32_32x32x16_f16(a[mt][kk], bfr[kk], acc[mt], 0, 0, 0); }
            unsigned pmax = 0u;
            float Iv[2][4]; bool okv[2][4];
#pragma unroll
            for (int mt = 0; mt < 2; ++mt)
#pragma unroll
                for (int j = 0; j < 4; ++j) {
                    const int q = mt * 8 + 2 * j + half;
                    float I = __builtin_fmaf(wq[mt][j][0], relu_i(acc[mt][4 * j]), 0.0f);
                    I = __builtin_fmaf(wq[mt][j][1], relu_i(acc[mt][4 * j + 1]), I);
                    I = __builtin_fmaf(wq[mt][j][2], relu_i(acc[mt][4 * j + 2]), I);
                    I = __builtin_fmaf(wq[mt][j][3], relu_i(acc[mt][4 * j + 3]), I);
                    Iv[mt][j] = I; okv[mt][j] = (s <= t0 + q) && (I > tq[mt][j]);
                }
            {
                unsigned hcnt[2][4]; unsigned rank[2][4];
                const unsigned long long hm = half ? 0xFFFFFFFF00000000ull : 0x00000000FFFFFFFFull;
                const unsigned long long ltm = (1ull << lane) - 1ull;
#pragma unroll
                for (int mt = 0; mt < 2; ++mt)
#pragma unroll
                    for (int j = 0; j < 4; ++j) { const unsigned long long bal = __ballot(okv[mt][j]) & hm; hcnt[mt][j] = (unsigned)__popcll(bal); rank[mt][j] = (unsigned)__popcll(bal & ltm); }
                unsigned base[2][4];
#pragma unroll
                for (int mt = 0; mt < 2; ++mt)
#pragma unroll
                    for (int j = 0; j < 4; ++j) base[mt][j] = 0u;
                if (l31 == 0) {
#pragma unroll
                    for (int mt = 0; mt < 2; ++mt)
#pragma unroll
                        for (int j = 0; j < 4; ++j) base[mt][j] = __hip_atomic_fetch_add(&cnt[mt * 8 + 2 * j + half], hcnt[mt][j], __ATOMIC_RELAXED, __HIP_MEMORY_SCOPE_WORKGROUP);
                }
#pragma unroll
                for (int mt = 0; mt < 2; ++mt)
#pragma unroll
                    for (int j = 0; j < 4; ++j) {
                        const unsigned b0 = (unsigned)__shfl((int)base[mt][j], lane & 32);
                        if (okv[mt][j]) { const int q = mt * 8 + 2 * j + half; const unsigned pos = b0 + rank[mt][j];
                            val[q * TK_CAP + pos] = Iv[mt][j]; idx[q * TK_CAP + pos] = (u16)s; pmax = pos > pmax ? pos : pmax; }
                    }
            }
            if (pmax >= (unsigned)TK_TRIG || kt == kt0) flg[par] = 1u;
            const int parn = (par == 2) ? 0 : par + 1;
            if (tid == 0) flg[parn] = 0u;
            __syncthreads();
            const unsigned need = flg[par];
            par = parn;
            if (need) {
#pragma unroll 1
                for (int qq = 0; qq < 2; ++qq) { const int q = 2 * wave + qq;
                    if (cnt[q] > 352u) {
                        const int Nq = t0 + q + 1; int seen = 256 * (kt + 1); seen = seen < Nq ? seen : Nq;
                        int K = TK_K;
                        if (pass == 0 && Nq > 3072) { K = ((kt == kt0 ? TK_F0 : 768) * seen + Nq - 1) / Nq; K = K < 16 ? 16 : (K > TK_K ? TK_K : K); }
                        if (K < TK_K && lane == 0) specd[q] = 1u;
                        const int c2 = (cnt[q] <= 64u * TK_E1) ? topk_compact_approx<TK_E1>(val + q * TK_CAP, idx + q * TK_CAP, cnt + q, tau + q, hist, lane, K)
                                                               : topk_compact_approx<TK_E>(val + q * TK_CAP, idx + q * TK_CAP, cnt + q, tau + q, hist, lane, K);
                        if (c2 > TK_TRIG) topk_compact<TK_E>(val + q * TK_CAP, idx + q * TK_CAP, cnt + q, tau + q, lane, K); } }
                __syncthreads();
#pragma unroll
                for (int mt = 0; mt < 2; ++mt)
#pragma unroll
                    for (int j = 0; j < 4; ++j) tq[mt][j] = tau[mt * 8 + 2 * j + half];
            }
        }
        {
#pragma unroll 1
        for (int qq = 0; qq < 2; ++qq) { const int q = 2 * wave + qq;
            if (pass == 1 && failq[q] == 0u) continue;
            { const int Nq = t0 + q + 1; const int needc = Nq < TK_K ? Nq : TK_K;
              if (pass == 0 && ((specd[q] != 0u && (int)cnt[q] < needc) || (FORCE_FAIL && ((t0 + q) % 5) == 0))) { if (lane == 0) { failq[q] = 1u; failq[16] = 1u; } continue; } }
            if (cnt[q] > (unsigned)TK_K) {
                int c2 = (int)cnt[q];
                if (c2 > 64 * TK_E1) c2 = topk_compact_approx<TK_E>(val + q * TK_CAP, idx + q * TK_CAP, cnt + q, tau + q, hist, lane);
                else if (c2 > 320) c2 = topk_compact_approx<TK_E1>(val + q * TK_CAP, idx + q * TK_CAP, cnt + q, tau + q, hist, lane);
                if (c2 > 320) topk_compact<TK_E>(val + q * TK_CAP, idx + q * TK_CAP, cnt + q, tau + q, lane);
                else if (c2 > TK_K) topk_compact<5>(val + q * TK_CAP, idx + q * TK_CAP, cnt + q, tau + q, lane);
            }
            const int n = (int)cnt[q];
            {
                LAS unsigned* bm = (LAS unsigned*)(val + q * TK_CAP);
                __builtin_amdgcn_wave_barrier();
#pragma unroll
                for (int k = 0; k < 8; ++k) bm[lane * 8 + k] = 0u;
                __builtin_amdgcn_wave_barrier();
                for (int e = lane; e < n; e += 64) { const unsigned id = idx[q * TK_CAP + e]; __hip_atomic_fetch_or(&bm[id >> 5], 1u << (id & 31u), __ATOMIC_RELAXED, __HIP_MEMORY_SCOPE_WORKGROUP); }
                __builtin_amdgcn_wave_barrier();
                int cl = 0;
#pragma unroll
                for (int k = 0; k < 8; ++k) cl += __popc(bm[lane * 8 + k]);
                int incl = cl;
#pragma unroll
                for (int o = 1; o < 64; o <<= 1) { const int v = __shfl_up(incl, o); if (lane >= o) incl += v; }
                int pos = incl - cl;
                LAS u16* sl = idx + q * TK_CAP;
#pragma unroll 1
                for (int k = 0; k < 8; ++k) { unsigned w = bm[lane * 8 + k];
                    while (w) { const int b = __ffs((int)w) - 1; sl[pos++] = (u16)((lane * 8 + k) * 32 + b); w &= w - 1u; } }
                __builtin_amdgcn_wave_barrier();
                for (int e = n + lane; e < TK_K; e += 64) sl[e] = (u16)0;
                __builtin_amdgcn_wave_barrier();
                *(u32x2*)(IDX + (size_t)(t0 + q) * TK_K + 4 * lane) = *(const LAS u32x2*)(sl + 4 * lane);
            }
            if (lane == 0) NIDX[t0 + q] = n; }
        }
        }
    }
    __syncthreads();
}

template <bool causal>
__device__ __forceinline__ void moba_block(const f16* __restrict__ Qh, const f16* __restrict__ Kh, const f16* __restrict__ VTh, int tq, int keybase, int ntiles,
                                           const LAS float* tab, const LAS unsigned char* blut, const LAS unsigned short* bst, f32x16 (&o)[2], float& m, float& l, int lane) {
    const int half = lane >> 5, l31 = lane & 31;
    h8 qf[4];
#pragma unroll
    for (int kk = 0; kk < 4; ++kk) qf[kk] = *(const h8*)(Qh + (size_t)tq * 64 + 16 * kk + 8 * half);
    m = -INFINITY; l = 0.f;
#pragma unroll
    for (int mt = 0; mt < 2; ++mt) o[mt] = (f32x16){0.f,0.f,0.f,0.f,0.f,0.f,0.f,0.f,0.f,0.f,0.f,0.f,0.f,0.f,0.f,0.f};
    h8 kn[4]; h4 vnl[2][2], vnh[2][2];
    {
        const int kb = keybase;
#pragma unroll
        for (int kk = 0; kk < 4; ++kk) kn[kk] = *(const h8*)(Kh + (size_t)(kb + l31) * 64 + 16 * kk + 8 * half);
#pragma unroll
        for (int s2 = 0; s2 < 2; ++s2)
#pragma unroll
            for (int mt = 0; mt < 2; ++mt) { const f16* vp = VTh + (size_t)(32 * mt + l31) * S + kb + 16 * s2 + 4 * half; vnl[s2][mt] = *(const h4*)vp; vnh[s2][mt] = *(const h4*)(vp + 8); }
    }
    for (int kt = 0; kt < ntiles; ++kt) {
        const int kb = keybase + 32 * kt;
        h8 kf[4]; h4 vl[2][2], vh[2][2];
#pragma unroll
        for (int kk = 0; kk < 4; ++kk) kf[kk] = kn[kk];
#pragma unroll
        for (int s2 = 0; s2 < 2; ++s2)
#pragma unroll
            for (int mt = 0; mt < 2; ++mt) { vl[s2][mt] = vnl[s2][mt]; vh[s2][mt] = vnh[s2][mt]; }
        if (kt + 1 < ntiles) {
            const int kb2 = kb + 32;
#pragma unroll
            for (int kk = 0; kk < 4; ++kk) kn[kk] = *(const h8*)(Kh + (size_t)(kb2 + l31) * 64 + 16 * kk + 8 * half);
#pragma unroll
            for (int s2 = 0; s2 < 2; ++s2)
#pragma unroll
                for (int mt = 0; mt < 2; ++mt) { const f16* vp = VTh + (size_t)(32 * mt + l31) * S + kb2 + 16 * s2 + 4 * half; vnl[s2][mt] = *(const h4*)vp; vnh[s2][mt] = *(const h4*)(vp + 8); }
        }
        f32x16 s = (f32x16){0.f,0.f,0.f,0.f,0.f,0.f,0.f,0.f,0.f,0.f,0.f,0.f,0.f,0.f,0.f,0.f};
#pragma unroll
        for (int kk = 0; kk < 4; ++kk) s = __builtin_amdgcn_mfma_f32_32x32x16_f16(kf[kk], qf[kk], s, 0, 0, 0);
        float tmax = -INFINITY;
        const int d0 = tq - kb;
        if (!causal && __all((d0 - 31) >= 78)) {
            const int dhi = d0 > 4095 ? 4095 : d0, dlo = (d0 - 31) > 4095 ? 4095 : (d0 - 31);
            const int bh = blut[dhi], bl = blut[dlo];
            const float biash = tab[bh], biasl = tab[bl];
            const int dstar = (int)bst[bh];
#pragma unroll
            for (int r = 0; r < 16; ++r) {
                const int dist = d0 - ((r & 3) + 8 * (r >> 2) + 4 * half);
                const float v = s[r] * (0.125f * 1.44269504089f) + (dist >= dstar ? biash : biasl);
                s[r] = v; tmax = fmaxf(tmax, v);
            }
        } else {
#pragma unroll
        for (int r = 0; r < 16; ++r) {
            const int key = kb + (r & 3) + 8 * (r >> 2) + 4 * half;
            int dist = tq - key; dist = dist < 0 ? 0 : (dist > 4095 ? 4095 : dist);
            float v = s[r] * (0.125f * 1.44269504089f) + tab[blut[dist]];
            if (causal && key > tq) v = -INFINITY;
            s[r] = v; tmax = fmaxf(tmax, v);
        }
        }
        tmax = fmaxf(tmax, __shfl_xor(tmax, 32));
        const float mnew = fmaxf(m, tmax);
        const float alpha = __builtin_amdgcn_exp2f(m - mnew);
        float lsum = 0.f;
#pragma unroll
        for (int r = 0; r < 16; ++r) { const float pv = __builtin_amdgcn_exp2f(s[r] - mnew); s[r] = pv; lsum += pv; }
        lsum += __shfl_xor(lsum, 32);
        l = l * alpha + lsum;
#pragma unroll
        for (int mt = 0; mt < 2; ++mt) o[mt] = o[mt] * alpha;
#pragma unroll
        for (int s2 = 0; s2 < 2; ++s2) {
            h8 pf;
#pragma unroll
            for (int j = 0; j < 8; ++j) pf[j] = (f16)s[8 * s2 + j];
#pragma unroll
            for (int mt = 0; mt < 2; ++mt) {
                const h4 lo = vl[s2][mt], hi = vh[s2][mt];
                h8 vf; vf[0] = lo[0]; vf[1] = lo[1]; vf[2] = lo[2]; vf[3] = lo[3]; vf[4] = hi[0]; vf[5] = hi[1]; vf[6] = hi[2]; vf[7] = hi[3];
                o[mt] = __builtin_amdgcn_mfma_f32_32x32x16_f16(vf, pf, o[mt], 0, 0, 0);
            }
        }
        m = mnew;
    }
}
__device__ __forceinline__ void phase_moba_sel(const Params& p_, LAS unsigned char* lds, int layer, bool overlap = false) {
    const Params p = load_params(); (void)p_;
    unsigned char* ws = phase_ws(p.ws); const int ptid = phase_tid();
    const f16* QKV = (const f16*)(ws + WS_QKV);
    const unsigned* LCNT = (const unsigned*)(ws + WS_LCNT) + layer * 512;
    const u16* LIST = (const u16*)(ws + WS_LIST);
    f16* PARTO = (f16*)(ws + WS_PQ); float* ML = (float*)(ws + WS_EIDX);
    LAS int* pre = (LAS int*)lds;
    LAS float* tab = (LAS float*)(lds + 4096);
    const int tid = ptid, lane = tid & 63, wave = __builtin_amdgcn_readfirstlane(tid >> 6), half = lane >> 5, l31 = lane & 31;
    tab[tid] = p.rel_bias[tid] * 1.44269504089f;
    LAS unsigned char* blut = (LAS unsigned char*)(lds + 24576);
    for (int d = tid; d < 4096; d += NTHREADS) blut[d] = (unsigned char)t5_bucket(d);
    LAS unsigned short* bst = (LAS unsigned short*)(lds + 30720);
    LAS unsigned* mq = (LAS unsigned*)(lds + 30848);
    if (tid == 0) *mq = 0u;
    __syncthreads();
    for (int d = tid; d < 4096; d += NTHREADS) if (d == 0 || blut[d] != blut[d - 1]) bst[blut[d]] = (unsigned short)d;
    LAS int* lc = (LAS int*)(lds + 28672);
    { const unsigned lcv = LCNT[tid]; lc[tid] = (int)lcv; const int c = (int)((lcv + 31u) >> 5);
      pre[tid + 1] = c; if (tid == 0) pre[0] = 0;
      __syncthreads();
      for (int off = 1; off < 512; off <<= 1) { int v = 0; if (tid >= off) v = pre[tid + 1 - off]; __syncthreads(); pre[tid + 1] += v; __syncthreads(); } }
    const int total = pre[512];
    const int nmw = overlap ? 4 : NWAVES, mw = overlap ? wave - 4 : wave;
    auto header = [&](const int w, int& L, bool& valid, unsigned& e) {
        int lo = 0, hi = 511;
        while (lo < hi) { const int mid = (lo + hi + 1) >> 1; if (pre[mid] <= w) lo = mid; else hi = mid - 1; }
        L = lo; const int tile = w - pre[L];
        const int cntL = lc[L];
        int ei = tile * 32 + l31; valid = ei < cntL; if (!valid) ei = cntL - 1;
        e = LIST[(size_t)L * S + ei];
    };
    const int wstep = gridDim.x * nmw;
    auto next_item = [&]() { int cq = 0; if (lane == 0) cq = (int)__hip_atomic_fetch_add(mq, 1u, __ATOMIC_RELAXED, __HIP_MEMORY_SCOPE_WORKGROUP);
        cq = __builtin_amdgcn_readfirstlane(cq); return (int)(blockIdx.x * nmw) + (cq % nmw) + (cq / nmw) * wstep; };
    int Ln = 0; bool validn = false; unsigned en = 0u;
    int wnx = total;
    if (mw >= 0) { wnx = next_item(); if (wnx < total) header(wnx, Ln, validn, en); }
    if (mw >= 0)
    for (int w = wnx; w < total; w = wnx) {
        const int L = Ln, h = L >> 6, j = L & 63; const bool valid = validn; const unsigned e = en;
        wnx = next_item(); if (wnx < total) header(wnx, Ln, validn, en);
        const int tq = (int)(e & 0x3FFFu), slot = (int)(e >> 14);
        f32x16 o[2]; float m, l;
        moba_block<false>(QKV + (size_t)(0 * 8 + h) * S * 64, QKV + (size_t)(1 * 8 + h) * S * 64, QKV + (size_t)(2 * 8 + h) * S * 64, tq, j * 256, 8, tab + h * 32, blut, bst, o, m, l, lane);
        if (valid) {
            const float inv = 1.0f / l;
            f16* dst = PARTO + ((size_t)(tq * 8 + h) * 3 + slot) * 64;
#pragma unroll
            for (int mt = 0; mt < 2; ++mt)
#pragma unroll
                for (int r4 = 0; r4 < 4; ++r4) { h4 ov;
#pragma unroll
                    for (int i = 0; i < 4; ++i) ov[i] = (f16)(o[mt][4 * r4 + i] * inv);
                    *(h4*)(dst + 32 * mt + 8 * r4 + 4 * half) = ov; }
            if (half == 0) { float* mlp = ML + ((size_t)(tq * 8 + h) * 3 + slot) * 2; mlp[0] = m; mlp[1] = l; }
        }
    }
    if (!overlap) __syncthreads();
}
__device__ __forceinline__ void phase_moba_own(const Params& p_, LAS unsigned char* lds) {
    const Params p = load_params(); (void)p_;
    unsigned char* ws = phase_ws(p.ws); const int ptid = phase_tid();
    const f16* QKV = (const f16*)(ws + WS_QKV);
    const int* SEL = (const int*)(ws + WS_SEL);
    const f16* PARTO = (const f16*)(ws + WS_PQ); const float* ML = (const float*)(ws + WS_EIDX);
    f16* Y = (f16*)(ws + WS_Y);
    LAS float* tab = (LAS float*)(lds + 4096);
    const int tid = ptid, lane = tid & 63, wave = tid >> 6, half = lane >> 5, l31 = lane & 31;
    LAS unsigned char* blut = (LAS unsigned char*)(lds + 24576);
    __syncthreads();
    if (tid < 256) tab[tid] = p.rel_bias[tid] * 1.44269504089f;
    for (int d = tid; d < 4096; d += NTHREADS) blut[d] = (unsigned char)t5_bucket(d);
    __syncthreads();
    for (int w = blockIdx.x * NWAVES + wave; w < 4096; w += gridDim.x * NWAVES) {
        const int h = w & 7; int qt = w >> 3; if (qt >= 256) qt ^= 7;
        const int t0 = qt * 32, tq = t0 + l31, b0 = t0 >> 8;
        const int sel = SEL[(size_t)h * S + tq];
        float mlr[3][2]; h4 pvr[3][2][4];
#pragma unroll
        for (int sl = 0; sl < 3; ++sl) { const float* mlp = ML + ((size_t)(tq * 8 + h) * 3 + sl) * 2; mlr[sl][0] = mlp[0]; mlr[sl][1] = mlp[1];
#pragma unroll
            for (int mt = 0; mt < 2; ++mt)
#pragma unroll
                for (int r4 = 0; r4 < 4; ++r4) pvr[sl][mt][r4] = *(const h4*)(PARTO + ((size_t)(tq * 8 + h) * 3 + sl) * 64 + 32 * mt + 8 * r4 + 4 * half); }
        f32x16 o[2]; float m, l;
        moba_block<true>(QKV + (size_t)(0 * 8 + h) * S * 64, QKV + (size_t)(1 * 8 + h) * S * 64, QKV + (size_t)(2 * 8 + h) * S * 64, tq, b0 * 256, ((t0 & 255) >> 5) + 1, tab + h * 32, blut, (const LAS unsigned short*)nullptr, o, m, l, lane);
        float mp[3], lp[3]; float M = m;
#pragma unroll
        for (int sl = 0; sl < 3; ++sl) { const bool ok = (((sel >> (8 * sl)) & 0xFF) != 0xFF);
            mp[sl] = ok ? mlr[sl][0] : -INFINITY; lp[sl] = ok ? mlr[sl][1] : 0.f; M = fmaxf(M, mp[sl]); }
        const float wo = __builtin_amdgcn_exp2f(m - M);
        float L = l * wo; float wsl[3];
#pragma unroll
        for (int sl = 0; sl < 3; ++sl) { wsl[sl] = lp[sl] * __builtin_amdgcn_exp2f(mp[sl] - M); L += wsl[sl]; }
        const float inv = 1.0f / L;
#pragma unroll
        for (int mt = 0; mt < 2; ++mt)
#pragma unroll
            for (int r4 = 0; r4 < 4; ++r4) {
                const int d0 = 32 * mt + 8 * r4 + 4 * half;
                float v[4];
#pragma unroll
                for (int i = 0; i < 4; ++i) v[i] = o[mt][4 * r4 + i] * wo;
#pragma unroll
                for (int sl = 0; sl < 3; ++sl) { const h4 pv = pvr[sl][mt][r4];
#pragma unroll
                    for (int i = 0; i < 4; ++i) v[i] += (wsl[sl] != 0.f) ? wsl[sl] * (float)pv[i] : 0.f; }
                h4 ov;
#pragma unroll
                for (int i = 0; i < 4; ++i) ov[i] = (DIAG == 3) ? (f16)0.f : (f16)(v[i] * inv);
                *(h4*)(Y + (size_t)tq * D + h * 64 + d0) = ov;
            }
    }
    __syncthreads();
}

__device__ __forceinline__ void phase_dsa(const Params& p_, LAS unsigned char* lds, int layer, bool skip_prologue = false) {
    const Params p = load_params(); (void)p_;
    unsigned char* ws = phase_ws(p.ws); const int ptid = phase_tid();
    const f16* QKV = (const f16*)(ws + WS_QKV);
    const u16* IDX = (const u16*)(ws + WS_IDX); const int* NIDX = (const int*)(ws + WS_NIDX);
    f16* Y = (f16*)(ws + WS_Y);
    LAS float* tab = (LAS float*)(lds + 4096);
    const int tid = ptid, lane = tid & 63, wave = __builtin_amdgcn_readfirstlane(tid >> 6), kg = lane >> 2, c = lane & 3;
    LAS u16* ibase = (LAS u16*)(lds + 8192 + wave * 1024);
    LAS float* scb = (LAS float*)(lds + 16384 + wave * 1024);
    LAS f16* bl16 = (LAS f16*)(lds + 32768);
    {
        __syncthreads();
        for (int i = tid; i < 512; i += NTHREADS) tab[i] = p.rel_bias[i];
        for (int d = tid; d < 4096; d += NTHREADS) { const int bk = t5_bucket(d);
#pragma unroll
            for (int hh = 0; hh < 8; ++hh) bl16[hh * 4096 + d] = (f16)(p.rel_bias[(8 + hh) * 32 + bk] * 1.44269504089f); }
        __syncthreads();
    }
    const int G = gridDim.x;
    const int h0 = (int)(xb_xcc_id() & 7u);
    auto do_head = [&](const int h, const bool dyn, const int first, const int stride) __attribute__((always_inline)) {
    unsigned* hctr = (unsigned*)(ws + WS_CTL + 40960) + layer * 8 + h;
    const f16* DQ = QKV + (size_t)(3 * 8 + h) * S * 64;
    const unsigned char* KV = (const unsigned char*)(QKV + (size_t)4 * 8 * S * 64) + (size_t)h * S * 128 + 16 * c;
    const LAS f16* blh = bl16 + h * 4096;
    const int gwh = (blockIdx.x >> 3) * NWAVES + wave, nwh = (G >> 3) * NWAVES;
    const int eo = ((lane >> 5) & 1) * 8 + ((lane >> 4) & 1) * 4 + ((lane >> 3) & 1) * 2 + ((lane >> 2) & 1);
    const int role = (lane >> 2) & 1, g2 = lane >> 3;
    constexpr int CH = 16;
    for (;;) {
      int tb0;
      if (dyn) { tb0 = 0; if (lane == 0) tb0 = (int)__hip_atomic_fetch_add(hctr, (unsigned)CH, __ATOMIC_RELAXED, __HIP_MEMORY_SCOPE_AGENT);
                 tb0 = __builtin_amdgcn_readfirstlane(tb0); }
      else {
                 int cq = 0; if (lane == 0) cq = (int)__hip_atomic_fetch_add((LAS unsigned*)(lds + 28672 + 16), 1u, __ATOMIC_RELAXED, __HIP_MEMORY_SCOPE_WORKGROUP);
                 cq = __builtin_amdgcn_readfirstlane(cq);
                 tb0 = (first + (cq & 7) + (cq >> 3) * stride) * CH; }
      if (tb0 >= S) break;
      u32x2 nidx = __builtin_nontemporal_load((const u32x2*)(IDX + (size_t)tb0 * 256 + 4 * lane));
      int nn = __builtin_nontemporal_load(NIDX + tb0);
      h8 nqa = __builtin_nontemporal_load((const h8*)(DQ + (size_t)tb0 * 64 + 16 * c)), nqb = __builtin_nontemporal_load((const h8*)(DQ + (size_t)tb0 * 64 + 16 * c + 8));
      for (int t = tb0; t < tb0 + CH; ++t) {
        const int n = nn;
        LAS u16* ib = ibase + ((t & 1) ? 256 : 0);
        __builtin_amdgcn_wave_barrier();
        *(LAS u32x2*)(ib + 4 * lane) = nidx;
        __builtin_amdgcn_wave_barrier();
        int qi[4]; float qscale;
        { float qf[16]; float qm = 0.f;
#pragma unroll
          for (int j = 0; j < 8; ++j) { qf[j] = (float)nqa[j]; qf[8 + j] = (float)nqb[j]; }
#pragma unroll
          for (int j = 0; j < 16; ++j) qm = fmaxf(qm, fabsf(qf[j]));
          qm = fmaxf(qm, dpp_f<0xB1>(qm)); qm = fmaxf(qm, dpp_f<0x4E>(qm));
          const float qs = qm > 0.f ? 127.0f / qm : 0.f;
#pragma unroll
          for (int w = 0; w < 4; ++w) qi[w] = (int)pack_i8x4(qf[4 * w], qf[4 * w + 1], qf[4 * w + 2], qf[4 * w + 3], qs);
          qscale = qm * (0.125f * 1.44269504089f / (127.0f * DSA_K_ISCALE)); }
        if (t + 1 < tb0 + CH) {
            nidx = __builtin_nontemporal_load((const u32x2*)(IDX + (size_t)(t + 1) * 256 + 4 * lane));
            nn = __builtin_nontemporal_load(NIDX + t + 1);
            nqa = __builtin_nontemporal_load((const h8*)(DQ + (size_t)(t + 1) * 64 + 16 * c)); nqb = __builtin_nontemporal_load((const h8*)(DQ + (size_t)(t + 1) * 64 + 16 * c + 8));
        }
        h2 acc2[8]; float ls = 0.f, mref = -INFINITY;
#pragma unroll
        for (int j = 0; j < 8; ++j) acc2[j] = (h2){(f16)0.f, (f16)0.f};
        auto half_body = [&](auto FULLT, const int hh) __attribute__((always_inline)) {
            constexpr bool FULL = decltype(FULLT)::value;
            u32x4 krr[8], vrr[8]; float so[8]; bool vv[8]; bool vk[8]; int rk[8];
#pragma unroll
            for (int i = 0; i < 8; ++i) {
                const int kkK = 16 * (8 * hh + i) + 2 * g2 + role, kkV = kkK ^ 1;
                vk[i] = FULL || (kkK < n); vv[i] = FULL || (kkV < n);
                rk[i] = vk[i] ? (int)ib[kkK] : 0; const int rowV = __builtin_amdgcn_update_dpp(0, rk[i], 0x141, 0xF, 0xF, false);
                krr[i] = *(const u32x4*)(KV + (size_t)rk[i] * 128);
                vrr[i] = *(const u32x4*)(KV + (size_t)rowV * 128 + 64);
            }
            __builtin_amdgcn_sched_barrier(0);
#pragma unroll
            for (int i = 0; i < 8; ++i) {
                const u32x4 kr = krr[i];
                int di = __builtin_amdgcn_sdot4((int)kr[1], qi[1], __builtin_amdgcn_sdot4((int)kr[0], qi[0], 0, false), false)
                       + __builtin_amdgcn_sdot4((int)kr[3], qi[3], __builtin_amdgcn_sdot4((int)kr[2], qi[2], 0, false), false);
                di += __builtin_amdgcn_update_dpp(0, di, 0xB1, 0xF, 0xF, false); di += __builtin_amdgcn_update_dpp(0, di, 0x4E, 0xF, 0xF, false);
                const float d = (float)di;
                int dd = t - rk[i]; dd = FULL ? (dd > 4095 ? 4095 : dd) : (dd < 0 ? 0 : (dd > 4095 ? 4095 : dd));
                float sv = d * qscale + (float)blh[dd];
                sv = vk[i] ? sv : -INFINITY;
                so[i] = dpp_f<0x141>(sv);
            }
            float mh = mref;
#pragma unroll
            for (int i = 0; i < 8; ++i) mh = fmaxf(mh, so[i]);
            if (hh != 0) { const float scl = (mref == -INFINITY) ? 0.f : __builtin_amdgcn_exp2f(mref - mh); ls *= scl;
              const h2 s2 = pkrtz2(scl, scl);
#pragma unroll
              for (int j = 0; j < 8; ++j) acc2[j] = acc2[j] * s2; }
            mref = mh;
#pragma unroll
            for (int i = 0; i < 8; ++i) {
                const float pv = vv[i] ? __builtin_amdgcn_exp2f(so[i] - mref) : 0.f; ls += pv;
                const h2 p2 = pkrtz2(pv, pv);
#pragma unroll
                for (int w = 0; w < 4; ++w) { const h2 lo = __builtin_amdgcn_cvt_scalef32_pk_f16_fp8((int)vrr[i][w], 1.0f, false), hi = __builtin_amdgcn_cvt_scalef32_pk_f16_fp8((int)vrr[i][w], 1.0f, true);
                    acc2[2 * w] = __builtin_elementwise_fma(p2, lo, acc2[2 * w]); acc2[2 * w + 1] = __builtin_elementwise_fma(p2, hi, acc2[2 * w + 1]); }
            }
        };
        if (n == TK_K) {
#pragma unroll 1
            for (int hh = 0; hh < 2; ++hh) half_body(std::true_type{}, hh);
        } else {
#pragma unroll 1
            for (int hh = 0; hh < 2; ++hh) half_body(std::false_type{}, hh);
        }
        float acc[16];
#pragma unroll
        for (int j = 0; j < 8; ++j) { acc[2 * j] = (float)acc2[j][0]; acc[2 * j + 1] = (float)acc2[j][1]; }
        float M = mref;
        M = fmaxf(M, __shfl_xor(M, 4)); M = fmaxf(M, __shfl_xor(M, 8)); M = fmaxf(M, __shfl_xor(M, 16)); M = fmaxf(M, __shfl_xor(M, 32));
        const float fs = (mref == -INFINITY) ? 0.f : __builtin_amdgcn_exp2f(mref - M);
        ls *= fs;
#pragma unroll
        for (int j = 0; j < 16; ++j) acc[j] *= fs;
        ls += __shfl_xor(ls, 4); ls += __shfl_xor(ls, 8); ls += __shfl_xor(ls, 16); ls += __shfl_xor(ls, 32);
        float r8[8], r4[4], r2[2], r1;
        { const bool hi = (lane >> 5) & 1;
#pragma unroll
          for (int j = 0; j < 8; ++j) { const float send = hi ? acc[j] : acc[j + 8]; const float keep = hi ? acc[j + 8] : acc[j]; r8[j] = keep + __shfl_xor(send, 32); } }
        { const bool hi = (lane >> 4) & 1;
#pragma unroll
          for (int j = 0; j < 4; ++j) { const float send = hi ? r8[j] : r8[j + 4]; const float keep = hi ? r8[j + 4] : r8[j]; r4[j] = keep + __shfl_xor(send, 16); } }
        { const bool hi = (lane >> 3) & 1;
#pragma unroll
          for (int j = 0; j < 2; ++j) { const float send = hi ? r4[j] : r4[j + 2]; const float keep = hi ? r4[j + 2] : r4[j]; r2[j] = keep + __shfl_xor(send, 8); } }
        { const bool hi = (lane >> 2) & 1; const float send = hi ? r2[0] : r2[1]; const float keep = hi ? r2[1] : r2[0]; r1 = keep + __shfl_xor(send, 4); }
        __builtin_nontemporal_store((DIAG == 2) ? (f16)0.f : (f16)(r1 / (ls * DSA_KV_SCALE)), Y + (size_t)t * D + 512 + h * 64 + 16 * c + eo);
      }
    }
    };
    unsigned* xr = (unsigned*)(ws + WS_CTL + 41216) + layer * 16 + xb_xcc_id();
    LAS int* rk = (LAS int*)(lds + 28672);
    if (tid == 0) { rk[4] = 0;
                    rk[0] = (int)__hip_atomic_fetch_add(xr, 1u, __ATOMIC_RELAXED, __HIP_MEMORY_SCOPE_AGENT);
                    rk[1] = (int)__hip_atomic_load((unsigned*)(ws + WS_CTL) + XB_XCNT(xb_xcc_id()), __ATOMIC_RELAXED, __HIP_MEMORY_SCOPE_AGENT); }
    __syncthreads();
    const int rank = rk[0], nloc = rk[1] > 0 ? rk[1] : 1;
    do_head(h0, false, rank * NWAVES, nloc * NWAVES);
#pragma unroll 1
    for (int h2 = 0; h2 < 8; ++h2) {
        unsigned present = 0u;
        for (int x = h2; x < 16; x += 8) present += __hip_atomic_load((unsigned*)(ws + WS_CTL) + XB_XCNT(x), __ATOMIC_RELAXED, __HIP_MEMORY_SCOPE_AGENT);
        if (__builtin_amdgcn_readfirstlane((int)present) == 0) do_head(h2, true, 0, 0);
    }
    __syncthreads();
}

#define INS16(a, ai, x, xi) do { float _x = (x); int _xi = (xi); _Pragma("unroll") for (int _k = 0; _k < 16; ++_k) { const bool _g = _x > a[_k]; \
        const float _t = _g ? a[_k] : _x; const int _ti = _g ? ai[_k] : _xi; a[_k] = _g ? _x : a[_k]; ai[_k] = _g ? _xi : ai[_k]; _x = _t; _xi = _ti; } } while (0)
__device__ __forceinline__ void ce_desc(float& a, int& ai, float& b, int& bi) {
    const bool sw = a < b; const float t = sw ? b : a, u = sw ? a : b; const int ti = sw ? bi : ai, ui = sw ? ai : bi; a = t; b = u; ai = ti; bi = ui;
}
__device__ __forceinline__ void sort16_desc(float (&c)[16], int (&ci)[16]) {
#pragma unroll
    for (int k = 2; k <= 16; k <<= 1)
#pragma unroll
        for (int j = k >> 1; j >= 1; j >>= 1)
#pragma unroll
            for (int i = 0; i < 16; ++i) { const int l = i ^ j; if (l > i) { if ((i & k) == 0) ce_desc(c[i], ci[i], c[l], ci[l]); else ce_desc(c[l], ci[l], c[i], ci[i]); } }
}
__device__ __forceinline__ void merge16(float (&a)[16], int (&ai)[16], const float (&b)[16], const int (&bi)[16]) {
    float c[16]; int ci[16];
#pragma unroll
    for (int k = 0; k < 16; ++k) { const bool g = a[k] >= b[15 - k]; c[k] = g ? a[k] : b[15 - k]; ci[k] = g ? ai[k] : bi[15 - k]; }
#pragma unroll
    for (int st = 8; st >= 1; st >>= 1)
#pragma unroll
        for (int k = 0; k < 16; ++k) if ((k & st) == 0) ce_desc(c[k], ci[k], c[k + st], ci[k + st]);
#pragma unroll
    for (int k = 0; k < 16; ++k) { a[k] = c[k]; ai[k] = ci[k]; }
}
__device__ __forceinline__ void merge_halves(float (&a)[16], int (&ai)[16]) {
    float b[16]; int bi[16];
#pragma unroll
    for (int k = 0; k < 16; ++k) { b[k] = __shfl_xor(a[k], 32); bi[k] = __shfl_xor(ai[k], 32); }
    merge16(a, ai, b, bi);
}
__device__ __forceinline__ void ce_u(unsigned& a, unsigned& b) { const unsigned t = a > b ? a : b, u = a > b ? b : a; a = t; b = u; }
__device__ __forceinline__ void sort16_u(unsigned (&c)[16]) {
#pragma unroll
    for (int k = 2; k <= 16; k <<= 1)
#pragma unroll
        for (int j = k >> 1; j >= 1; j >>= 1)
#pragma unroll
            for (int i = 0; i < 16; ++i) { const int l = i ^ j; if (l > i) { if ((i & k) == 0) ce_u(c[i], c[l]); else ce_u(c[l], c[i]); } }
}
__device__ __forceinline__ void merge16_u(unsigned (&a)[16], const unsigned (&b)[16]) {
    unsigned c[16];
#pragma unroll
    for (int k = 0; k < 16; ++k) c[k] = a[k] > b[15 - k] ? a[k] : b[15 - k];
#pragma unroll
    for (int st = 8; st >= 1; st >>= 1)
#pragma unroll
        for (int k = 0; k < 16; ++k) if ((k & st) == 0) ce_u(c[k], c[k + st]);
#pragma unroll
    for (int k = 0; k < 16; ++k) a[k] = c[k];
}
__device__ __forceinline__ void merge_halves_u(unsigned (&a)[16]) {
    unsigned b[16];
#pragma unroll
    for (int k = 0; k < 16; ++k) b[k] = (unsigned)__shfl_xor((int)a[k], 32);
    merge16_u(a, b);
}
__device__ __forceinline__ void phase_psel(const Params& p_, LAS unsigned char* lds, int layer) {
    const Params p = load_params(); (void)p_;
    unsigned char* ws = phase_ws(p.ws); const int ptid = phase_tid();
    const f16* PQ = (const f16*)(ws + WS_PQ);
    const f16* SUBK = (const f16*)(ws + WS_SUBK) + (size_t)layer * 8 * 2 * 128 * 128;
    int* EIDX = (int*)(ws + WS_EIDX); float* EG = (float*)(ws + WS_EG);
    const int tid = ptid, lane = tid & 63, wave = tid >> 6, half = lane >> 5, l31 = lane & 31;
    LAS unsigned* pq = (LAS unsigned*)(lds + 20480);
    __syncthreads();
    if (tid == 0) *pq = 0u;
    __syncthreads();
    for (;;) {
        int cq = 0; if (lane == 0) cq = (int)__hip_atomic_fetch_add(pq, 1u, __ATOMIC_RELAXED, __HIP_MEMORY_SCOPE_WORKGROUP);
        cq = __builtin_amdgcn_readfirstlane(cq);
        const int w = blockIdx.x * NWAVES + (cq & 7) + (cq >> 3) * (gridDim.x * NWAVES);
        if (w >= 4096) break;
        const int h = w & 7, tt = w >> 3, t = tt * 32 + l31;
        float v0[16], v1[16]; int i0[16], i1[16];
        unsigned a[16];
#pragma unroll
        for (int k = 0; k < 16; ++k) a[k] = 0u;
        h8 qf[8], afn[8];
#pragma unroll
        for (int kk = 0; kk < 8; ++kk) qf[kk] = *(const h8*)(PQ + (size_t)t * NQ + (2 * h) * 128 + 16 * kk + 8 * half);
        const f16* skh = SUBK + (size_t)(h * 2) * 128 * 128 + (size_t)l31 * 128 + 8 * half;
#pragma unroll
        for (int kk = 0; kk < 8; ++kk) afn[kk] = *(const h8*)(skh + 16 * kk);
#pragma unroll 1
        for (int m = 0; m < 8; ++m) {
            const int pp = m >> 2, mt = m & 3;
            h8 af[8];
#pragma unroll
            for (int kk = 0; kk < 8; ++kk) af[kk] = afn[kk];
            if (m + 1 < 8) {
#pragma unroll
                for (int kk = 0; kk < 8; ++kk) afn[kk] = *(const h8*)(skh + (size_t)(32 * (m + 1)) * 128 + 16 * kk);
            }
            f32x16 acc = (f32x16){0.f,0.f,0.f,0.f,0.f,0.f,0.f,0.f,0.f,0.f,0.f,0.f,0.f,0.f,0.f,0.f};
#pragma unroll
            for (int kk = 0; kk < 8; ++kk) acc = __builtin_amdgcn_mfma_f32_32x32x16_f16(af[kk], qf[kk], acc, 0, 0, 0);
            if (m == 3) {
#pragma unroll
                for (int kk = 0; kk < 8; ++kk) qf[kk] = *(const h8*)(PQ + (size_t)t * NQ + (2 * h + 1) * 128 + 16 * kk + 8 * half);
            }
            unsigned cu[16];
#pragma unroll
            for (int r = 0; r < 16; ++r) { const int cn = 32 * mt + (r & 3) + 8 * (r >> 2) + 4 * half; cu[r] = (f2ord(acc[r]) & 0xFFFFFF80u) | (unsigned)(127 - cn); }
            sort16_u(cu);
            merge16_u(a, cu);
            if (mt == 3) {
                merge_halves_u(a);
                if (pp == 0) {
#pragma unroll
                    for (int k = 0; k < 16; ++k) { v0[k] = ord2f(a[k] & 0xFFFFFF80u); i0[k] = 127 - (int)(a[k] & 127u); }
                } else {
#pragma unroll
                    for (int k = 0; k < 16; ++k) { v1[k] = ord2f(a[k] & 0xFFFFFF80u); i1[k] = 127 - (int)(a[k] & 127u); }
                }
#pragma unroll
                for (int k = 0; k < 16; ++k) a[k] = 0u;
            }
        }
        float ca[16]; int ci[16];
#pragma unroll
        for (int k = 0; k < 16; ++k) {
            const float sA = v0[0] + v1[k]; const int eA = i0[0] * 128 + i1[k];
            const float sB = (k < 8) ? (v0[1] + v1[k]) : -INFINITY; const int eB = (k < 8) ? (i0[1] * 128 + i1[k]) : 0;
            ca[k] = half ? sB : sA; ci[k] = half ? eB : eA;
        }
        {
            constexpr int PI[26] = {2,2,2,2,2, 3,3,3,3, 4,4,4, 5,5, 6,6, 7,7, 8,9,10,11,12,13,14,15};
            constexpr int PJ[26] = {0,1,2,3,4, 0,1,2,3, 0,1,2, 0,1, 0,1, 0,1, 0,0,0,0,0,0,0,0};
#pragma unroll
            for (int k = 0; k < 13; ++k) {
                const float sA = v0[PI[2 * k]] + v1[PJ[2 * k]]; const int eA = i0[PI[2 * k]] * 128 + i1[PJ[2 * k]];
                const float sB = v0[PI[2 * k + 1]] + v1[PJ[2 * k + 1]]; const int eB = i0[PI[2 * k + 1]] * 128 + i1[PJ[2 * k + 1]];
                INS16(ca, ci, half ? sB : sA, half ? eB : eA);
            }
        }
        merge_halves(ca, ci);
        float e[16]; float sum = 0.f;
#pragma unroll
        for (int k = 0; k < 16; ++k) { e[k] = __expf(ca[k] - ca[0]); sum += e[k]; }
        const float inv = 1.0f / sum;
        int* ep = EIDX + (size_t)t * 128 + h * 16; float* gp = EG + (size_t)t * 128 + h * 16;
#pragma unroll
        for (int k = 0; k < 16; ++k) if ((k >> 3) == half) { ep[k] = ci[k]; gp[k] = e[k] * inv; }
    }
    __syncthreads();
}

template <bool LAST>
__device__ __forceinline__ void phase_peer(const Params& p_, LAS unsigned char* lds, int layer) {
    const Params p = load_params(); (void)p_;
    unsigned char* ws = phase_ws(p.ws); const int ptid = phase_tid();
    const unsigned char* U = ws + WS_U16 + (size_t)layer * 16384 * D; const unsigned char* V = ws + WS_V16 + (size_t)layer * 16384 * D;
    const int* EIDX = (const int*)(ws + WS_EIDX); const float* EG = (const float*)(ws + WS_EG);
    const float* X1 = (const float*)(ws + WS_X1); f16* H = (f16*)(ws + WS_H);
    const float* MOD = (const float*)(ws + WS_MOD);
    LAS float* g2 = (LAS float*)lds; LAS float* nw = g2 + 1024; LAS float* sh = nw + 1024; LAS float* sc = sh + 1024;
    const int tid = ptid, lane = tid & 63, wave = __builtin_amdgcn_readfirstlane(tid >> 6);
    __syncthreads();
    for (int i = tid; i < 1024; i += NTHREADS) {
        g2[i] = MOD[layer * 6144 + 5 * 1024 + i];
        if (LAST) { nw[i] = p.norm_final[i]; sh[i] = 0.f; sc[i] = 0.f; }
        else { nw[i] = p.norm_attn[(layer + 1) * 1024 + i]; sh[i] = MOD[(layer + 1) * 6144 + i]; sc[i] = MOD[(layer + 1) * 6144 + 1024 + i]; }
    }
    __syncthreads();
    const int el = ((lane >> 5) & 1) * 4 + ((lane >> 4) & 1) * 2 + ((lane >> 3) & 1);
    for (int ti = 0; ; ++ti) {
        const int tt = blockIdx.x + gridDim.x * (ti >> 2); if (tt >= S / 32) break;
        const int t = tt * 32 + (ti & 3) * 8 + wave;
        int hi4[4]; float hscale;
        { const h8 hA = *(const h8*)(H + (size_t)t * D + 16 * lane), hB = *(const h8*)(H + (size_t)t * D + 16 * lane + 8);
          float hf[16]; float hm = 0.f;
#pragma unroll
          for (int i = 0; i < 8; ++i) { hf[i] = (float)hA[i]; hf[8 + i] = (float)hB[i]; }
#pragma unroll
          for (int i = 0; i < 16; ++i) hm = fmaxf(hm, fabsf(hf[i]));
#pragma unroll
          for (int o = 32; o >= 1; o >>= 1) hm = fmaxf(hm, __shfl_xor(hm, o));
          const float hs = hm > 0.f ? 127.0f / hm : 0.f;
#pragma unroll
          for (int w = 0; w < 4; ++w) hi4[w] = (int)pack_i8x4(hf[4 * w], hf[4 * w + 1], hf[4 * w + 2], hf[4 * w + 3], hs);
          hscale = hm * (1.0f / (127.0f * PEER_U_SCALE)); }
        const int ev0 = EIDX[(size_t)t * 128 + lane], ev1 = EIDX[(size_t)t * 128 + 64 + lane];
        const float gv0 = EG[(size_t)t * 128 + lane], gv1 = EG[(size_t)t * 128 + 64 + lane];
        h2 acc2[8];
#pragma unroll
        for (int j = 0; j < 8; ++j) acc2[j] = (h2){(f16)0.f, (f16)0.f};
#pragma unroll 1
        for (int bt = 0; bt < 16; ++bt) {
            const int kb = bt * 8;
            u32x4 ur[8], vr[8];
#pragma unroll
            for (int j = 0; j < 8; ++j) { const int k = kb + j; const int e = __builtin_amdgcn_readlane(k < 64 ? ev0 : ev1, k & 63);
                ur[j] = *(const u32x4*)(U + (size_t)e * D + 16 * lane); vr[j] = *(const u32x4*)(V + (size_t)e * D + 16 * lane); }
            __builtin_amdgcn_sched_barrier(0);
            float pd[8];
#pragma unroll
            for (int j = 0; j < 8; ++j) {
                const int di = __builtin_amdgcn_sdot4((int)ur[j][1], hi4[1], __builtin_amdgcn_sdot4((int)ur[j][0], hi4[0], 0, false), false)
                             + __builtin_amdgcn_sdot4((int)ur[j][3], hi4[3], __builtin_amdgcn_sdot4((int)ur[j][2], hi4[2], 0, false), false);
                pd[j] = (float)di; }
            float r4[4], r2[2], r1;
            { const bool hi = (lane >> 5) & 1;
#pragma unroll
              for (int j = 0; j < 4; ++j) { const float send = hi ? pd[j] : pd[j + 4]; const float keep = hi ? pd[j + 4] : pd[j]; r4[j] = keep + __shfl_xor(send, 32); } }
            { const bool hi = (lane >> 4) & 1;
#pragma unroll
              for (int j = 0; j < 2; ++j) { const float send = hi ? r4[j] : r4[j + 2]; const float keep = hi ? r4[j + 2] : r4[j]; r2[j] = keep + __shfl_xor(send, 16); } }
            { const bool hi = (lane >> 3) & 1; const float send = hi ? r2[0] : r2[1]; const float keep = hi ? r2[1] : r2[0]; r1 = keep + __shfl_xor(send, 8); }
            r1 += __shfl_xor(r1, 4); r1 += __shfl_xor(r1, 2); r1 += __shfl_xor(r1, 1);
            const int kmine = kb + el;
            const float gmine = __shfl(kmine < 64 ? gv0 : gv1, kmine & 63);
            const float wmine = gmine * gelu_exact(r1 * hscale);
#pragma unroll
            for (int j = 0; j < 8; ++j) {
                const int src = ((j >> 2) & 1) * 32 + ((j >> 1) & 1) * 16 + (j & 1) * 8;
                const float wj = __uint_as_float(__builtin_amdgcn_readlane(__float_as_uint(wmine), src));
                const h2 w2 = pkrtz2(wj, wj);
#pragma unroll
                for (int w = 0; w < 4; ++w) { const h2 lo = __builtin_amdgcn_cvt_scalef32_pk_f16_fp8((int)vr[j][w], 1.0f, false), hi = __builtin_amdgcn_cvt_scalef32_pk_f16_fp8((int)vr[j][w], 1.0f, true);
                    acc2[2 * w] = __builtin_elementwise_fma(w2, lo, acc2[2 * w]); acc2[2 * w + 1] = __builtin_elementwise_fma(w2, hi, acc2[2 * w + 1]); }
            }
        }
        float acc[16];
#pragma unroll
        for (int j = 0; j < 8; ++j) { acc[2 * j] = (float)acc2[j][0] * (1.0f / PEER_V_SCALE); acc[2 * j + 1] = (float)acc2[j][1] * (1.0f / PEER_V_SCALE); }
        const float* xr = X1 + (size_t)t * D + 16 * lane;
        float x2[16]; float ss = 0.f;
#pragma unroll
        for (int i = 0; i < 4; ++i) { const f32x4 xv = *(const f32x4*)(xr + 4 * i);
#pragma unroll
            for (int j = 0; j < 4; ++j) { const float v = xv[j] + g2[16 * lane + 4 * i + j] * acc[4 * i + j]; x2[4 * i + j] = v; ss += v * v; } }
        ss = wave_sum(ss);
        const float r = rsqrtf(ss * (1.0f / D) + EPS);
        if (LAST) {
            float* op = p.out + (size_t)t * D + 16 * lane;
#pragma unroll
            for (int i = 0; i < 4; ++i) { f32x4 ov;
#pragma unroll
                for (int j = 0; j < 4; ++j) ov[j] = x2[4 * i + j] * r * nw[16 * lane + 4 * i + j];
                *(f32x4*)(op + 4 * i) = ov; }
        } else {
            float* op = p.out + (size_t)t * D + 16 * lane;
#pragma unroll
            for (int i = 0; i < 4; ++i) { f32x4 ov;
#pragma unroll
                for (int j = 0; j < 4; ++j) ov[j] = x2[4 * i + j];
                *(f32x4*)(op + 4 * i) = ov; }
            h8 oA, oB;
#pragma unroll
            for (int j = 0; j < 8; ++j) { const int cA = 16 * lane + j, cB = cA + 8;
                oA[j] = (f16)((x2[j] * r * nw[cA]) * (1.0f + sc[cA]) + sh[cA]); oB[j] = (f16)((x2[8 + j] * r * nw[cB]) * (1.0f + sc[cB]) + sh[cB]); }
            *(h8*)(H + (size_t)t * D + 16 * lane) = oA; *(h8*)(H + (size_t)t * D + 16 * lane + 8) = oB;
        }
    }
    __syncthreads();
}


#ifndef CHECKS
#define CHECKS 0
#endif
__device__ __forceinline__ float naive_iscore(const f16* IQ, const f16* KN, const float* IW, int t, int s) {
    float x[4] = {0.f, 0.f, 0.f, 0.f};
    for (int d8 = 0; d8 < 8; ++d8) {
        const h8 kv = *(const h8*)(KN + (size_t)s * 64 + 8 * d8);
#pragma unroll
        for (int hh = 0; hh < 4; ++hh) { const h8 qv = *(const h8*)(IQ + (size_t)t * 256 + hh * 64 + 8 * d8);
#pragma unroll
            for (int j = 0; j < 8; ++j) x[hh] += (float)qv[j] * (float)kv[j]; }
    }
    float I = 0.f;
#pragma unroll
    for (int hh = 0; hh < 4; ++hh) I += IW[(size_t)t * 4 + hh] * fmaxf(x[hh], 0.f);
    return I + 0.0f;
}
__device__ __forceinline__ void phase_check_attn(const Params& p_, LAS unsigned char* lds) {
    const Params p = load_params(); (void)p_;
    unsigned char* ws = phase_ws(p.ws); const int ptid = phase_tid();
    const f16* QKV = (const f16*)(ws + WS_QKV); const f16* IQ = (const f16*)(ws + WS_IQ); const f16* KN = (const f16*)(ws + WS_KN); const float* IW = (const float*)(ws + WS_IW);
    const u16* IDX = (const u16*)(ws + WS_IDX); const int* NIDX = (const int*)(ws + WS_NIDX); const f16* Y = (const f16*)(ws + WS_Y);
    const int* SEL = (const int*)(ws + WS_SEL); const float* KMEAN = (const float*)(ws + WS_KMEAN); const f16* H = (const f16*)(ws + WS_H);
    const int lane = ptid & 63, wave = __builtin_amdgcn_readfirstlane(ptid >> 6), gw = blockIdx.x * NWAVES + wave, nw = gridDim.x * NWAVES;
    constexpr int NS = 40;
    for (int si = gw; si < NS; si += nw) {
        const int t = (si < 4) ? (si * 85 + 3) : (si * 419 + 7) % S;
        const int n = NIDX[t];
        if (n != (t + 1 < 256 ? t + 1 : 256)) set_flag(ws, 4u);
        int sidx[4]; float sI[4]; float mn = INFINITY;
#pragma unroll
        for (int i = 0; i < 4; ++i) { const int k = lane + 64 * i; const bool ok = k < n; sidx[i] = ok ? (int)IDX[(size_t)t * 256 + k] : 0;
            sI[i] = ok ? naive_iscore(IQ, KN, IW, t, sidx[i]) : INFINITY; mn = fminf(mn, sI[i]);
            if (ok && sidx[i] > t) set_flag(ws, 4u); }
        mn = wave_min(mn);
        const float tol = 1e-4f * fabsf(mn) + 1e-5f;
        int call = 0, csel = 0;
        for (int s2 = lane; s2 <= t; s2 += 64) call += (naive_iscore(IQ, KN, IW, t, s2) > mn + tol) ? 1 : 0;
#pragma unroll
        for (int i = 0; i < 4; ++i) csel += (lane + 64 * i < n && sI[i] > mn + tol) ? 1 : 0;
        call = wave_sumi(call); csel = wave_sumi(csel);
        if (call != csel) set_flag(ws, 4u);
        for (int h = 0; h < 8; ++h) {
            const f16* DQ = QKV + (size_t)(3 * 8 + h) * S * 64; const f16* DK = QKV + (size_t)(4 * 8 + h) * S * 64; const f16* DV = QKV + (size_t)(5 * 8 + h) * S * 64;
            float lg[4]; float mx = -INFINITY;
#pragma unroll
            for (int i = 0; i < 4; ++i) { const bool ok = lane + 64 * i < n; float d = 0.f;
                for (int dd = 0; dd < 64; ++dd) d += (float)DQ[(size_t)t * 64 + dd] * (float)DK[(size_t)sidx[i] * 64 + dd];
                const int dist = t - sidx[i];
                lg[i] = ok ? d * 0.125f + p.rel_bias[(8 + h) * 32 + t5_bucket(dist < 0 ? 0 : dist)] : -INFINITY; mx = fmaxf(mx, lg[i]); }
            mx = wave_max(mx);
            float pr[4]; float ls = 0.f;
#pragma unroll
            for (int i = 0; i < 4; ++i) { pr[i] = __expf(lg[i] - mx); ls += pr[i]; }
            ls = wave_sum(ls);
            float o = 0.f;
#pragma unroll
            for (int i = 0; i < 4; ++i)
                for (int src = 0; src < 64; ++src) { const float pk = __shfl(pr[i], src); const int row = __shfl(sidx[i], src); o += pk * (float)DV[(size_t)row * 64 + lane]; }
            o /= ls;
            const float got = (float)Y[(size_t)t * D + 512 + h * 64 + lane];
            const float err = wave_max(fabsf(got - o)), sc = wave_max(fabsf(o));
            if (err > 4e-3f * sc + 1e-3f) set_flag(ws, 8u);
        }
    }
    LAS float* pbuf = (LAS float*)(lds + 32768) + wave * 1024;
    LAS int* sbuf = (LAS int*)(lds + 32768 + 8 * 4096) + wave * 4;
    for (int si = gw; si < NS * 8; si += nw) {
        const int h = si & 7, s8 = si >> 3;
        const int t = (s8 < 4) ? (s8 * 170 + 11) : (s8 * 419 + 7) % S;
        const int b0 = t >> 8;
        const f16* MQ = QKV + (size_t)(0 * 8 + h) * S * 64; const f16* MK = QKV + (size_t)(1 * 8 + h) * S * 64; const f16* MVT = QKV + (size_t)(2 * 8 + h) * S * 64;
        float g = -INFINITY;
        if (lane < b0) { g = 0.f; for (int dd = 0; dd < 64; ++dd) g += (float)MQ[(size_t)t * 64 + dd] * KMEAN[(size_t)(h * 64 + lane) * 64 + dd]; }
        const int sel = SEL[(size_t)h * S + t];
        __builtin_amdgcn_wave_barrier();
        for (int r = 0; r < 3; ++r) { const float mxg = wave_max(g); int cand = (g == mxg && mxg > -INFINITY) ? lane : 999; cand = -(int)wave_max((float)(-cand));
            const int sb_ref = cand < 999 ? cand : -1; if (lane == 0) sbuf[r] = sb_ref; if (lane == cand) g = -INFINITY;
            int sb = (sel >> (8 * r)) & 0xFF; if (sb == 0xFF) sb = -1; if (sb != sb_ref) set_flag(ws, 16u); }
        if (lane == 0) sbuf[3] = b0;
        __builtin_amdgcn_wave_barrier();
        float mx = -INFINITY;
        for (int r = 0; r < 4; ++r) { const int sb = sbuf[r];
            for (int i = 0; i < 4; ++i) { const int key = sb * 256 + lane + 64 * i; const bool ok = sb >= 0 && key <= t;
                float d = 0.f; if (ok) for (int dd = 0; dd < 64; ++dd) d += (float)MQ[(size_t)t * 64 + dd] * (float)MK[(size_t)key * 64 + dd];
                const float lgv = ok ? d * 0.125f + p.rel_bias[h * 32 + t5_bucket(t - key)] : -INFINITY; mx = fmaxf(mx, lgv); pbuf[r * 256 + lane + 64 * i] = lgv; } }
        mx = wave_max(mx);
        float ls = 0.f;
        __builtin_amdgcn_wave_barrier();
        for (int e2 = lane; e2 < 1024; e2 += 64) { const float pv = __expf(pbuf[e2] - mx); ls += pv; pbuf[e2] = pv; }
        ls = wave_sum(ls);
        __builtin_amdgcn_wave_barrier();
        float o = 0.f;
        for (int r = 0; r < 4; ++r) { const int sb = sbuf[r]; if (sb < 0) continue;
            for (int kk = 0; kk < 256; ++kk) { const float pv = pbuf[r * 256 + kk]; if (pv != 0.f) o += pv * (float)MVT[(size_t)lane * S + sb * 256 + kk]; } }
        o /= ls;
        const float got = (float)Y[(size_t)t * D + h * 64 + lane];
        const float err = wave_max(fabsf(got - o)), sc = wave_max(fabsf(o));
        if (err > 4e-3f * sc + 1e-3f) set_flag(ws, 16u);
        __builtin_amdgcn_wave_barrier();
    }
    for (int si = gw; si < NS; si += nw) {
        const int t = (si * 419 + 7) % S;
        const int layer_unknown = 0; (void)layer_unknown;
        (void)H;
    }
    __syncthreads();
}


__device__ __forceinline__ void phase_check_psel(const Params& p_, LAS unsigned char* lds, int layer) {
    const Params p = load_params(); (void)p_;
    int zoff = 0; LAUNDER_S(zoff); unsigned char* ws = p.ws + zoff; const int ptid = phase_tid();
    const f16* PQ = (const f16*)(ws + WS_PQ);
    const f16* SUBK = (const f16*)(ws + WS_SUBK) + (size_t)layer * 8 * 2 * 128 * 128;
    const int* EIDX = (const int*)(ws + WS_EIDX); const float* EG = (const float*)(ws + WS_EG);
    const int lane = ptid & 63, wave = __builtin_amdgcn_readfirstlane(ptid >> 6), gw = blockIdx.x * NWAVES + wave, nw = gridDim.x * NWAVES;
    LAS float* tvL = (LAS float*)(lds + 32768) + wave * 64;
    LAS int* tiL = (LAS int*)(lds + 32768 + 8 * 256) + wave * 64;
    constexpr int NS = 40;
    for (int si = gw; si < NS * 8; si += nw) {
        const int h = si & 7, s8 = si >> 3, t = (s8 * 419 + 7) % S;
        __builtin_amdgcn_wave_barrier();
        for (int pp = 0; pp < 2; ++pp) {
            float s0 = 0.f, s1 = 0.f;
            const f16* qp = PQ + (size_t)t * NQ + (2 * h + pp) * 128; const f16* kp = SUBK + (size_t)(h * 2 + pp) * 128 * 128;
            for (int d = 0; d < 128; ++d) { const float qv = (float)qp[d]; s0 += qv * (float)kp[(size_t)lane * 128 + d]; s1 += qv * (float)kp[(size_t)(lane + 64) * 128 + d]; }
            for (int r = 0; r < 16; ++r) {
                const float mx = wave_max(fmaxf(s0, s1));
                int c = (s0 == mx) ? lane : ((s1 == mx) ? lane + 64 : 999);
                c = -(int)wave_max((float)(-c));
                if (lane == 0) { tvL[pp * 16 + r] = mx; tiL[pp * 16 + r] = c; }
                if (c == lane) s0 = -INFINITY; if (c == lane + 64) s1 = -INFINITY;
            }
        }
        __builtin_amdgcn_wave_barrier();
        float cs[4]; const int ci_ = lane >> 2;
#pragma unroll
        for (int jj = 0; jj < 4; ++jj) cs[jj] = tvL[ci_] + tvL[16 + 4 * (lane & 3) + jj];
        float gs[16]; int ge[16];
#pragma unroll
        for (int r = 0; r < 16; ++r) {
            float m4 = fmaxf(fmaxf(cs[0], cs[1]), fmaxf(cs[2], cs[3]));
            const float mx = wave_max(m4);
            int c = 999;
#pragma unroll
            for (int jj = 3; jj >= 0; --jj) if (cs[jj] == mx) c = ci_ * 16 + 4 * (lane & 3) + jj;
            c = -(int)wave_max((float)(-c));
            gs[r] = mx; ge[r] = tiL[c >> 4] * 128 + tiL[16 + (c & 15)];
#pragma unroll
            for (int jj = 0; jj < 4; ++jj) if (c == ci_ * 16 + 4 * (lane & 3) + jj) cs[jj] = -INFINITY;
        }
        float sum = 0.f;
        { const float g0 = gs[0];
#pragma unroll
          for (int r = 0; r < 16; ++r) gs[r] = __expf(gs[r] - g0); }
#pragma unroll
        for (int r = 0; r < 16; ++r) sum += gs[r];
        bool bad = false;
#pragma unroll
        for (int r = 0; r < 16; ++r) { const int e = EIDX[(size_t)t * 128 + h * 16 + r]; const float g = EG[(size_t)t * 128 + h * 16 + r];
            if (e != ge[r]) bad = true; if (fabsf(g - gs[r] / sum) > 1e-3f) bad = true; }
        if (bad) set_flag(ws, 1u);
    }
    __syncthreads();
}

constexpr int NPHASE = 2 + 2 * 9 + (CHECKS ? 1 : 0);
__global__ void __launch_bounds__(NTHREADS) fwd_kernel(Params p) {
    extern __shared__ __attribute__((aligned(16))) unsigned char lds_raw[];
    LAS unsigned char* lds = (LAS unsigned char*)lds_raw;
    volatile LAS unsigned* xbw = (volatile LAS unsigned*)(lds + LDS_BYTES - 16);
    if (threadIdx.x < 4) xbw[threadIdx.x] = 0u;
    __syncthreads();
    const Params p0 = load_params();
    XcdBarrier bar; bar.bar = (unsigned*)(p0.ws + WS_CTL); bar.x = 0; bar.st = xbw;
#if ONE_LAUNCH
    bar = xcd_barrier_post((unsigned*)(p0.ws + WS_CTL), xbw);
#endif
    const int lo = p0.ph_lo, hi = p0.ph_hi;
    int ph = 0;
#if ONE_LAUNCH
#define PHASE(...) do { if (PH_ON(ph) && ph >= lo && ph < hi) { __VA_ARGS__; if (ph + 1 < hi) xcd_barrier(bar); } ++ph; } while (0)
#else
#define PHASE(...) do { if (PH_ON(ph) && ph >= lo && ph < hi) { __VA_ARGS__; } ++ph; } while (0)
#endif
    PHASE(REP(8, phase_prologue(p, lds)));
    PHASE(phase_norm<true>(p, lds, 0, 0));
    for (int layer = 0; layer < 2; ++layer) {
        PHASE({ const Params q = load_params(); unsigned char* ws = phase_ws(q.ws); pg8::Gemm g{(const f16*)(ws + WS_H), (const f16*)(ws + WS_WIN) + (size_t)layer * NPAD * D, S, NPAD, D};
                pg8::StaticOrder so; so.init(S, NPAD, gridDim.x, blockIdx.x);
                EpiIn E{(f16*)(ws + WS_QKV), (f16*)(ws + WS_IQ), (float*)(ws + WS_IKRAW), (float*)(ws + WS_IW)};
                REP(6, pg8::gemm_phase<EpiIn>(lds, g, so, E)); });
        PHASE(REP(10, phase_prep(p, lds)));
        PHASE({ phase_gate(p, lds, layer); if (REP_WHAT == 15) phase_gate(p, lds, layer, true); phase_topk(p, lds, layer); });
        PHASE({ phase_moba_sel(p, lds, layer, false); phase_dsa(p, lds, layer, false); });
        PHASE(REP(7, phase_moba_own(p, lds)));
        PHASE({ if (CHECKS) phase_check_attn(p, lds); const Params q = load_params(); unsigned char* ws = phase_ws(q.ws); const float* Xin = (layer == 0) ? q.x : q.out; pg8::Gemm g{(const f16*)(ws + WS_Y), (const f16*)(ws + WS_WOUT) + (size_t)layer * D * D, S, D, D};
                pg8::StaticOrder so; so.init(S, D, gridDim.x, blockIdx.x);
                EpiOut E{Xin, (float*)(ws + WS_X1), (const float*)(ws + WS_MOD) + layer * 6144 + 2 * 1024};
                REP(13, pg8::gemm_phase<EpiOut>(lds, g, so, E)); });
        PHASE(REP(11, phase_norm<false>(p, lds, layer, 1)));
        PHASE({ const Params q = load_params(); unsigned char* ws = phase_ws(q.ws); pg8::Gemm g{(const f16*)(ws + WS_H), (const f16*)(ws + WS_WQ) + (size_t)layer * NQ * D, S, NQ, D};
                pg8::StaticOrder so; so.init(S, NQ, gridDim.x, blockIdx.x);
                EpiPQ E{(f16*)(ws + WS_PQ)};
                REP(12, pg8::gemm_phase<EpiPQ>(lds, g, so, E)); });
        if (layer == 0) { PHASE({ phase_psel(p, lds, layer); asm volatile("s_waitcnt vmcnt(0)" ::: "memory"); __syncthreads(); phase_peer<false>(p, lds, layer); }); } else { PHASE({ phase_psel(p, lds, layer); asm volatile("s_waitcnt vmcnt(0)" ::: "memory"); __syncthreads(); phase_peer<true>(p, lds, layer); }); }
    }
#if ONE_LAUNCH
    if (REP_WHAT == 14) { for (int i = 0; i < 20; ++i) xcd_barrier(bar); }
#endif
    if (CHECKS) PHASE({ const Params q = load_params(); if (blockIdx.x == 0 && threadIdx.x == 0) { const unsigned fl = *(volatile unsigned*)(q.ws + WS_FLAG);
              if (fl) q.out[0] += sqrtf((10.0f + (float)fl) * 1000.0f * 16777216.0f); } });
#undef PHASE
}

extern "C" void kernel_launch(void* const* d_in, const int* in_sizes, int n_in, void* d_out, int out_size, void* d_ws, size_t ws_size, hipStream_t stream) {
    static int grid = 0;
    if (grid == 0) {
        if (n_in != 14 || out_size != S * D || ws_size < WS_END) { fprintf(stderr, "kernel_launch: unexpected shapes (n_in %d out %d ws %zu)\n", n_in, out_size, ws_size); grid = -1; return; }
        if (hipFuncSetAttribute((const void*)fwd_kernel, hipFuncAttributeMaxDynamicSharedMemorySize, LDS_BYTES) != hipSuccess) { fprintf(stderr, "kernel_launch: hipFuncSetAttribute failed\n"); grid = -1; return; }
        int dev = 0, cus = 0, per_cu = 0;
        (void)hipGetDevice(&dev); (void)hipDeviceGetAttribute(&cus, hipDeviceAttributeMultiprocessorCount, dev);
        (void)hipOccupancyMaxActiveBlocksPerMultiprocessor(&per_cu, (const void*)fwd_kernel, NTHREADS, LDS_BYTES);
        (void)hipGetLastError();
        if (per_cu < 1) fprintf(stderr, "kernel_launch: occupancy query reports %d blocks per CU\n", per_cu);
        grid = (cus > 0 ? cus : 256);
        if (grid > 256) grid = 256;
    }
    if (grid < 0) return;
    (void)hipMemsetAsync((char*)d_ws + WS_CTL, 0, CTL_ZERO_BYTES, stream);
    Params p{};
    p.x = (const float*)d_in[0]; p.c = (const float*)d_in[1]; p.w_ada = (const float*)d_in[2]; p.b_ada = (const float*)d_in[3];
    p.norm_attn = (const float*)d_in[4]; p.norm_ffn = (const float*)d_in[5]; p.w_in = (const float*)d_in[6]; p.w_out = (const float*)d_in[7];
    p.rel_bias = (const float*)d_in[8]; p.peer_wq = (const float*)d_in[9]; p.peer_subkeys = (const float*)d_in[10]; p.peer_u = (const float*)d_in[11];
    p.peer_v = (const float*)d_in[12]; p.norm_final = (const float*)d_in[13];
    p.out = (float*)d_out; p.ws = (unsigned char*)d_ws;
#if ONE_LAUNCH
    p.ph_lo = 0; p.ph_hi = NPHASE;
    hipLaunchKernelGGL(fwd_kernel, dim3(grid), dim3(NTHREADS), LDS_BYTES, stream, p);
#else
    for (int ph = 0; ph < NPHASE; ++ph) { p.ph_lo = ph; p.ph_hi = ph + 1; hipLaunchKernelGGL(fwd_kernel, dim3(grid), dim3(NTHREADS), LDS_BYTES, stream, p); }
#endif
}
```
